# Optimizing an MI355X kernel written in HIP

```python
import math
import jax
import jax.numpy as jnp
from jax import lax
import numpy as np

D_MODEL = 2048
BATCH = 2
SEQ = 8192
DEPTH = 4

N_MIXERS = 3
HEAD_DIM = 128
ROPE_THETA = 10000.0
NORM_EPS = 1e-6
D_FF = 4 * D_MODEL
BAND_BLOCK = 128

NSA_HEADS = D_MODEL // HEAD_DIM
NSA_KV_GROUPS = 4
NSA_REP = NSA_HEADS // NSA_KV_GROUPS
NSA_KV_WIDTH = NSA_KV_GROUPS * HEAD_DIM
CMP_BLOCK = 32
CMP_STRIDE = 16
CMP_HIDDEN = 4 * HEAD_DIM
SEL_BLOCK = 64
SEL_TOPK = 16
NSA_WINDOW = 512
NSA_Q_CHUNK = 64
FORCED_BONUS = 1e9
NSA_IN_WIDTH = NSA_HEADS * HEAD_DIM + 6 * NSA_KV_WIDTH + 3 * NSA_HEADS

DIL_HEADS = D_MODEL // HEAD_DIM
DIL_PATTERNS = ((128, 1), (512, 4), (2048, 16))
DIL_IN_WIDTH = len(DIL_PATTERNS) * 3 * DIL_HEADS * HEAD_DIM

D_RNN = 2688
RNN_BLOCKS = 16
RNN_BLOCK_DIM = D_RNN // RNN_BLOCKS
CONV_WIDTH = 4
LRU_C = 8.0

kernel_name = 'hybrid_nsa_dilated_rglru_adaln'

F32 = jnp.float32


def rmsnorm(x, gain):
    x32 = x.astype(F32)
    return x32 * lax.rsqrt(jnp.mean(x32 * x32, axis=-1, keepdims=True) + NORM_EPS) * gain.astype(F32)


def modulate(x, gain, shift, scale):
    return (rmsnorm(x, gain) * (1.0 + scale.astype(F32)) + shift.astype(F32)).astype(x.dtype)


def rope_tables(seq):
    inv_freq = ROPE_THETA ** (-jnp.arange(0, HEAD_DIM, 2, dtype=F32) / HEAD_DIM)
    ang = jnp.arange(seq, dtype=F32)[:, None] * inv_freq[None, :]
    return jnp.cos(ang), jnp.sin(ang)


def rope(t, cos, sin):
    t1, t2 = jnp.split(t, 2, axis=-1)
    return jnp.concatenate([t1 * cos - t2 * sin, t1 * sin + t2 * cos], axis=-1)


def banded_attention(q, k, v, window, block):
    q, k, v = q.astype(F32), k.astype(F32), v.astype(F32)
    N, G, R, L, dh = q.shape
    blk = min(block, L)
    nb = -(-L // blk)
    lp = nb * blk
    nw = -(-window // blk)
    q = jnp.pad(q, ((0, 0), (0, 0), (0, 0), (0, lp - L), (0, 0)))
    kv_pad = ((0, 0), (0, 0), (nw * blk, lp - L), (0, 0))
    kb = jnp.pad(k, kv_pad).reshape(N, G, nb + nw, blk, dh)
    vb = jnp.pad(v, kv_pad).reshape(N, G, nb + nw, blk, dh)
    kw = jnp.concatenate([kb[:, :, s:s + nb] for s in range(nw + 1)], axis=3)
    vw = jnp.concatenate([vb[:, :, s:s + nb] for s in range(nw + 1)], axis=3)
    qb = q.reshape(N, G, R, nb, blk, dh)
    s = jnp.einsum('ngrbqd,ngbkd->ngrbqk', qb, kw) / math.sqrt(dh)
    qpos = jnp.arange(nb)[:, None] * blk + jnp.arange(blk)[None, :]
    kpos = jnp.arange(nb)[:, None] * blk - nw * blk + jnp.arange((nw + 1) * blk)[None, :]
    diff = qpos[:, :, None] - kpos[:, None, :]
    mask = (diff >= 0) & (diff <= window) & (kpos[:, None, :] >= 0)
    s = jnp.where(mask, s, -jnp.inf)
    m = jnp.max(s, axis=-1, keepdims=True)
    p = jnp.exp(s - m)
    l = jnp.sum(p, axis=-1, keepdims=True)
    out = jnp.einsum('ngrbqk,ngbkd->ngrbqd', p, vw) / l
    lse = (m + jnp.log(l))[..., 0]
    out = out.reshape(N, G, R, lp, dh)[:, :, :, :L]
    lse = lse.reshape(N, G, R, lp)[:, :, :, :L]
    return out, lse


def nsa_mixer(h, w_in, cmp_pe, cmp_w1, cmp_w2, w_out, cos, sin):
    B, S, _ = h.shape
    G, R, dh = NSA_KV_GROUPS, NSA_REP, HEAD_DIM
    scale = 1.0 / math.sqrt(dh)
    hq = NSA_HEADS * dh
    proj = (h @ w_in).astype(F32)
    q = proj[..., :hq].reshape(B, S, G, R, dh).transpose(0, 2, 3, 1, 4)
    kv = proj[..., hq:hq + 6 * NSA_KV_WIDTH].reshape(B, S, 6, G, dh).transpose(2, 0, 3, 1, 4)
    k_cmp, v_cmp, k_sel, v_sel, k_win, v_win = kv[0], kv[1], kv[2], kv[3], kv[4], kv[5]
    gates = jax.nn.sigmoid(proj[..., hq + 6 * NSA_KV_WIDTH:]).reshape(B, S, G, R, 3)
    gates = gates.transpose(4, 0, 2, 3, 1)[..., None]
    q_rot = rope(q, cos, sin)
    k_sel = rope(k_sel, cos, sin)
    k_win = rope(k_win, cos, sin)

    ratio = CMP_BLOCK // CMP_STRIDE
    n_cmp = S // CMP_STRIDE - ratio + 1

    def compress(t, pe, w1, w2):
        pieces = t.reshape(B, G, S // CMP_STRIDE, CMP_STRIDE, dh)
        blocks = jnp.concatenate([pieces[:, :, j:j + n_cmp] for j in range(ratio)], axis=3) + pe.astype(F32)
        flat = blocks.reshape(B, G, n_cmp, CMP_BLOCK * dh)
        return jax.nn.gelu(flat @ w1.astype(F32)) @ w2.astype(F32)

    k_c = compress(k_cmp, cmp_pe[0], cmp_w1[0], cmp_w2[0])
    v_c = compress(v_cmp, cmp_pe[1], cmp_w1[1], cmp_w2[1])
    cmp_start = jnp.arange(n_cmp) * CMP_STRIDE
    cmp_end = cmp_start + CMP_BLOCK - 1

    n_sb = S // SEL_BLOCK
    n_top = min(SEL_TOPK, n_sb)
    sel_ids = jnp.arange(n_sb)
    sel_start = sel_ids * SEL_BLOCK
    overlap = ((cmp_start[:, None] < sel_start[None, :] + SEL_BLOCK)
               & (cmp_start[:, None] + CMP_BLOCK > sel_start[None, :])).astype(F32)
    k_sb = k_sel.reshape(B, G, n_sb, SEL_BLOCK, dh)
    v_sb = v_sel.reshape(B, G, n_sb, SEL_BLOCK, dh)
    gather_blocks = jax.vmap(jax.vmap(lambda blocks, ix: blocks[ix]))

    def chunk(ci):
        start = ci * NSA_Q_CHUNK
        qc = lax.dynamic_slice_in_dim(q, start, NSA_Q_CHUNK, axis=3)
        qrc = lax.dynamic_slice_in_dim(q_rot, start, NSA_Q_CHUNK, axis=3)
        t = start + jnp.arange(NSA_Q_CHUNK)
        s = jnp.einsum('bgrqd,bgnd->bgrqn', qc, k_c) * scale
        s = jnp.where(cmp_end[None, :] <= t[:, None], s, -jnp.inf)
        m = jnp.max(s, axis=-1, keepdims=True)
        m = jnp.where(jnp.isfinite(m), m, 0.0)
        p = jnp.exp(s - m)
        l = jnp.sum(p, axis=-1, keepdims=True)
        p = p / jnp.where(l > 0, l, 1.0)
        o_c = jnp.einsum('bgrqn,bgnd->bgrqd', p, v_c)
        imp = jnp.einsum('bgrqn,nj->bgqj', p, overlap)
        cur = t // SEL_BLOCK
        avail = sel_ids[None, :] <= cur[:, None]
        forced = (sel_ids[None, :] == 0) | (sel_ids[None, :] == cur[:, None]) | (sel_ids[None, :] == cur[:, None] - 1)
        score = jnp.where(avail, imp + FORCED_BONUS * forced, -jnp.inf)
        _, idx = lax.top_k(score, n_top)
        ks = gather_blocks(k_sb, idx)
        vs = gather_blocks(v_sb, idx)
        ss = jnp.einsum('bgrqd,bgqnkd->bgrqnk', qrc, ks) * scale
        kpos = idx[..., None] * SEL_BLOCK + jnp.arange(SEL_BLOCK)
        ok = kpos <= t[:, None, None]
        ss = jnp.where(ok[:, :, None], ss, -jnp.inf)
        ps = jax.nn.softmax(ss.reshape(ss.shape[:4] + (-1,)), axis=-1).reshape(ss.shape)
        o_s = jnp.einsum('bgrqnk,bgqnkd->bgrqd', ps, vs)
        return o_c, o_s

    o_cmp, o_sel = lax.map(chunk, jnp.arange(S // NSA_Q_CHUNK))
    o_cmp = jnp.moveaxis(o_cmp, 0, 3).reshape(B, G, R, S, dh)
    o_sel = jnp.moveaxis(o_sel, 0, 3).reshape(B, G, R, S, dh)
    o_win, _ = banded_attention(q_rot, k_win, v_win, NSA_WINDOW - 1, BAND_BLOCK)
    o = gates[0] * o_cmp + gates[1] * o_sel + gates[2] * o_win
    o = o.transpose(0, 3, 1, 2, 4).reshape(B, S, hq).astype(h.dtype)
    return o @ w_out


def dilated_mixer(h, w_in, w_out, cos, sin):
    B, S, _ = h.shape
    H, dh = DIL_HEADS, HEAD_DIM
    proj = (h @ w_in).astype(F32).reshape(B, S, len(DIL_PATTERNS), 3, H, dh).transpose(2, 3, 0, 4, 1, 5)
    outs, lses = [], []
    for g, (window, dil) in enumerate(DIL_PATTERNS):
        L = S // dil

        def to_residue(t):
            return t.reshape(B, H, L, dil, dh).transpose(0, 1, 3, 2, 4).reshape(B, H * dil, L, dh)

        q = to_residue(rope(proj[g, 0], cos, sin))[:, :, None]
        k = to_residue(rope(proj[g, 1], cos, sin))
        v = to_residue(proj[g, 2])
        o, lse = banded_attention(q, k, v, window // dil, BAND_BLOCK)
        outs.append(o.reshape(B, H, dil, L, dh).transpose(0, 1, 3, 2, 4).reshape(B, H, S, dh))
        lses.append(lse.reshape(B, H, dil, L).transpose(0, 1, 3, 2).reshape(B, H, S))
    wts = jax.nn.softmax(jnp.stack(lses), axis=0)[..., None]
    o = jnp.sum(wts * jnp.stack(outs), axis=0)
    o = o.transpose(0, 2, 1, 3).reshape(B, S, H * dh).astype(h.dtype)
    return o @ w_out


def rglru_mixer(h, w_in, conv_w, conv_b, w_gate, b_gate, lru_lambda, w_out):
    B, S, _ = h.shape
    proj = (h @ w_in).astype(F32)
    y = jax.nn.gelu(proj[..., :D_RNN])
    xr = proj[..., D_RNN:]
    xp = jnp.pad(xr, ((0, 0), (CONV_WIDTH - 1, 0), (0, 0)))
    x = conv_b.astype(F32) + xp[:, 0:S] * conv_w[0].astype(F32)
    for j in range(1, CONV_WIDTH):
        x = x + xp[:, j:j + S] * conv_w[j].astype(F32)
    xb = x.reshape(B, S, RNN_BLOCKS, RNN_BLOCK_DIM)
    gl = jnp.einsum('bsnc,gncd->gbsnd', xb, w_gate.astype(F32)).reshape(2, B, S, D_RNN)
    gl = gl + b_gate.astype(F32)[:, None, None, :]
    r = jax.nn.sigmoid(gl[0])
    i = jax.nn.sigmoid(gl[1])
    log_a = -LRU_C * r * jax.nn.softplus(-lru_lambda.astype(F32))
    a = jnp.exp(log_a)
    b = jnp.sqrt(-jnp.expm1(2.0 * log_a)) * (i * x)

    def combine(left, right):
        a1, b1 = left
        a2, b2 = right
        return a1 * a2, a2 * b1 + b2

    hs = lax.associative_scan(combine, (a, b), axis=1)[1]
    return (hs * y).astype(h.dtype) @ w_out


def sqrelu_mlp(h, w1, w2):
    return jnp.square(jax.nn.relu(h @ w1)) @ w2


def setup_inputs(seed: int = 0) -> dict:
    key = jax.random.key(seed)
    keys = iter(jax.random.split(key, 128))

    def normal(shape, scale):
        return jax.random.normal(next(keys), shape, F32) * scale

    D = D_MODEL
    inp = {'x': normal((BATCH, SEQ, D), 1.0), 'c': normal((BATCH, D), 1.0)}
    for li in range(DEPTH):
        p = 'l%d_' % li
        inp[p + 'w_ada'] = normal((D, 6 * D), 0.5 * D ** -0.5)
        inp[p + 'b_ada'] = normal((6 * D,), 0.02)
        inp[p + 'norm1'] = 1.0 + normal((D,), 0.02)
        kind = li % N_MIXERS
        if kind == 0:
            inp[p + 'w_in'] = normal((D, NSA_IN_WIDTH), D ** -0.5)
            inp[p + 'cmp_pe'] = normal((2, CMP_BLOCK, HEAD_DIM), 0.1)
            inp[p + 'cmp_w1'] = normal((2, CMP_BLOCK * HEAD_DIM, CMP_HIDDEN), (CMP_BLOCK * HEAD_DIM) ** -0.5)
            inp[p + 'cmp_w2'] = normal((2, CMP_HIDDEN, HEAD_DIM), CMP_HIDDEN ** -0.5)
            inp[p + 'w_out'] = normal((NSA_HEADS * HEAD_DIM, D), (NSA_HEADS * HEAD_DIM) ** -0.5)
        elif kind == 1:
            inp[p + 'w_in'] = normal((D, DIL_IN_WIDTH), D ** -0.5)
            inp[p + 'w_out'] = normal((DIL_HEADS * HEAD_DIM, D), (DIL_HEADS * HEAD_DIM) ** -0.5)
        else:
            inp[p + 'w_in'] = normal((D, 2 * D_RNN), D ** -0.5)
            inp[p + 'conv_w'] = normal((CONV_WIDTH, D_RNN), CONV_WIDTH ** -0.5)
            inp[p + 'conv_b'] = normal((D_RNN,), 0.02)
            inp[p + 'w_gate'] = normal((2, RNN_BLOCKS, RNN_BLOCK_DIM, RNN_BLOCK_DIM), RNN_BLOCK_DIM ** -0.5)
            inp[p + 'b_gate'] = normal((2, D_RNN), 0.02)
            u = jax.random.uniform(next(keys), (D_RNN,), F32, minval=0.9, maxval=0.999)
            a0 = u ** (1.0 / LRU_C)
            inp[p + 'lambda'] = jnp.log(a0) - jnp.log1p(-a0)
            inp[p + 'w_out'] = normal((D_RNN, D), D_RNN ** -0.5)
        inp[p + 'norm2'] = 1.0 + normal((D,), 0.02)
        inp[p + 'w_ff1'] = normal((D, D_FF), D ** -0.5)
        inp[p + 'w_ff2'] = normal((D_FF, D), D_FF ** -0.5)
    inp['norm_f'] = 1.0 + normal((D,), 0.02)
    return inp


def reference(x, c,
              l0_w_ada, l0_b_ada, l0_norm1, l0_w_in, l0_cmp_pe, l0_cmp_w1, l0_cmp_w2, l0_w_out, l0_norm2, l0_w_ff1, l0_w_ff2,
              l1_w_ada, l1_b_ada, l1_norm1, l1_w_in, l1_w_out, l1_norm2, l1_w_ff1, l1_w_ff2,
              l2_w_ada, l2_b_ada, l2_norm1, l2_w_in, l2_conv_w, l2_conv_b, l2_w_gate, l2_b_gate, l2_lambda, l2_w_out, l2_norm2, l2_w_ff1, l2_w_ff2,
              l3_w_ada, l3_b_ada, l3_norm1, l3_w_in, l3_cmp_pe, l3_cmp_w1, l3_cmp_w2, l3_w_out, l3_norm2, l3_w_ff1, l3_w_ff2,
              norm_f):
    S = x.shape[1]
    cos, sin = rope_tables(S)
    layers = (
        (l0_w_ada, l0_b_ada, l0_norm1, l0_norm2, l0_w_ff1, l0_w_ff2, (l0_w_in, l0_cmp_pe, l0_cmp_w1, l0_cmp_w2, l0_w_out)),
        (l1_w_ada, l1_b_ada, l1_norm1, l1_norm2, l1_w_ff1, l1_w_ff2, (l1_w_in, l1_w_out)),
        (l2_w_ada, l2_b_ada, l2_norm1, l2_norm2, l2_w_ff1, l2_w_ff2,
         (l2_w_in, l2_conv_w, l2_conv_b, l2_w_gate, l2_b_gate, l2_lambda, l2_w_out)),
        (l3_w_ada, l3_b_ada, l3_norm1, l3_norm2, l3_w_ff1, l3_w_ff2, (l3_w_in, l3_cmp_pe, l3_cmp_w1, l3_cmp_w2, l3_w_out)),
    )
    cond = jax.nn.silu(c)
    for li in range(DEPTH):
        w_ada, b_ada, n1, n2, ff1, ff2, mix = layers[li]
        mod = (cond @ w_ada + b_ada)[:, None, :]
        sh1, sc1, g1, sh2, sc2, g2 = jnp.split(mod, 6, axis=-1)
        hn = modulate(x, n1, sh1, sc1)
        kind = li % N_MIXERS
        if kind == 0:
            y = nsa_mixer(hn, *mix, cos, sin)
        elif kind == 1:
            y = dilated_mixer(hn, *mix, cos, sin)
        else:
            y = rglru_mixer(hn, *mix)
        x = x + g1 * y
        x = x + g2 * sqrelu_mlp(modulate(x, n2, sh2, sc2), ff1, ff2)
    return rmsnorm(x, norm_f).astype(x.dtype)
```

```cpp
#include <hip/hip_runtime.h>
#include <cstdio>
#include <cstdint>

#define GAS __attribute__((address_space(1)))
#define LAS __attribute__((address_space(3)))
typedef unsigned short bf16;
typedef float f32x4 __attribute__((ext_vector_type(4)));
typedef float f32x2 __attribute__((ext_vector_type(2)));
typedef unsigned u32x4 __attribute__((ext_vector_type(4)));
typedef unsigned u32x2 __attribute__((ext_vector_type(2)));
#define LDS_WAIT() asm volatile("s_waitcnt lgkmcnt(0)" ::: "memory")
__device__ __forceinline__ int fresh_s(int v) { asm volatile("" : "+s"(v)); return v; }
__device__ __forceinline__ int lane_id_asm() { int l; asm volatile("v_mbcnt_lo_u32_b32 %0, -1, 0\n\tv_mbcnt_hi_u32_b32 %0, -1, %0" : "=v"(l)); return l; }

namespace pg8 {
#define PG8_LAS __attribute__((address_space(3)))
typedef unsigned short bf16_t;
typedef short bf16x8 __attribute__((ext_vector_type(8)));
constexpr int BM = 256, BK = 64, HALF = 128, HTB = HALF * BK * 2, STAGE_BYTES = 8 * HTB, NXCD = 8, WGM = 8;
__host__ __device__ __forceinline__ int lds_byte(int r, int c) { const int st = (r >> 4) * 2 + (c >> 5), rr = r & 15, cc = c & 31, ob = rr * 64 + cc * 2; return st * 1024 + (ob ^ (((ob >> 9) & 1) << 5)); }
__host__ __device__ __forceinline__ void stage_rc(int b, int& R, int& C) { const int st = b / 1024, sb = b % 1024, swz = sb ^ (((sb >> 9) & 1) << 5); R = (st >> 1) * 16 + swz / 64; C = (st & 1) * 32 + (swz % 64) / 2; }
__host__ __device__ __forceinline__ int perm32(int rho) { const int n = rho >> 4, i = rho & 15; return 8 * (i >> 2) + 4 * n + (i & 3); }
struct Unit { int pm, pn; };
struct Gemm { const bf16_t* A; const bf16_t* Bt; int M, N, K; int dshA, dshB; };
__device__ __forceinline__ long rowbase(int p, int dsh) { const int i0 = p * 256; if (dsh == 0) return i0; const int b = i0 >> 13, rem = i0 & 8191, sh = 13 - dsh; return (long)(b << 13) + ((rem & ((1 << sh) - 1)) << dsh) + (rem >> sh); }
struct StaticOrder {
    int nM, nN, nwg, G, c;
    __host__ __device__ void init(int M, int N, int G_, int c_) { nM = M / BM; nN = N / BM; nwg = nM * nN; G = G_; c = c_; }
    __host__ __device__ bool next(int i, Unit& u) const {
        const long L = (long)i * G + c; if (L >= nwg) return false;
        int wgid = (int)L; { const int q = nwg / NXCD, r = nwg % NXCD, xcd = wgid % NXCD, off = wgid / NXCD; wgid = (xcd < r ? xcd * (q + 1) : r * (q + 1) + (xcd - r) * q) + off; }
        const int nig = WGM * nN, gid = wgid / nig, fm = gid * WGM, gsz = (nM - fm) < WGM ? (nM - fm) : WGM;
        u.pm = fm + ((wgid % nig) % gsz); u.pn = (wgid % nig) / gsz; return true;
    }
    __device__ __forceinline__ void a_ready(const Unit&) const {}
    __device__ __forceinline__ void done(const Unit&) const {}
    __device__ __forceinline__ void krange(const Unit&, int K, int& kbeg, int& nt) const { kbeg = 0; nt = K / BK; }
};
struct GateOrder : StaticOrder {
    __device__ __forceinline__ void krange(const Unit& u, int K, int& kbeg, int& nt) const {
        const int c0 = u.pn * 128, nb0 = c0 / 168, nb1 = (c0 + 127) / 168;
        kbeg = (nb0 * 168) & ~127; int kend = ((nb1 + 1) * 168 + 127) & ~127; if (kend > K) kend = K;
        nt = (kend - kbeg) / BK; }
};
__device__ __forceinline__ unsigned cvt_pk_bf16(float lo, float hi) { unsigned r; asm volatile("v_cvt_pk_bf16_f32 %0, %1, %2" : "=v"(r) : "v"(lo), "v"(hi)); return r; }

template <class Epi, class Sched, bool ALIGN_EPI = false, bool SP2 = false>
__device__ __forceinline__ void gemm_phase(PG8_LAS unsigned char* lds, const Gemm g, const Sched& S, const Epi& E, int wid_in) {
    int wid = wid_in; asm volatile("" : "+s"(wid));
    const int lane = lane_id_asm(), tid = wid * 64 + lane, wr = wid >> 2, wc = wid & 3, fr = lane & 15, fq = lane >> 4;
    const int K = g.K;
    unsigned voffA[2], voffB[2];
#pragma unroll
    for (int i = 0; i < 2; ++i) { int R, C; stage_rc(tid * 16 + i * 8192, R, C); const int Rb = Epi::PERM ? ((R & ~31) + perm32(R & 31)) : R;
        voffA[i] = (unsigned)((R << g.dshA) * K + C) * 2u; voffB[i] = (unsigned)((Rb << g.dshB) * K + C) * 2u; }
    const size_t kstep = (size_t)(BK * 2);
    const size_t hstepA = (size_t)(HALF << g.dshA) * K * 2, hstepB = (size_t)(HALF << g.dshB) * K * 2;
#define PG8_BASEA(u) ((const char*)g.A + (size_t)rowbase((u).pm, g.dshA) * K * 2)
#define PG8_BASEB(u) ((const char*)g.Bt + (size_t)rowbase((u).pn, g.dshB) * K * 2)
    const unsigned ldsw = (unsigned)wid * 1024u;
    const int aoff = lds_byte(wr * 64 + fr, fq * 8), boff = lds_byte(wc * 32 + fr, fq * 8);
#define PG8_SA(b, h) (((b) * 2 + (h)) * HTB)
#define PG8_SB(b, h) ((4 + (b) * 2 + (h)) * HTB)
#define PG8_STAGE(bufoff, gbase, voff) do { _Pragma("unroll") for (int _i = 0; _i < 2; ++_i) \
        __builtin_amdgcn_global_load_lds((const unsigned*)((const char*)(gbase) + (voff)[_i]), (PG8_LAS unsigned*)(lds + (bufoff) + ldsw + _i * 8192), 16, 0, 0); } while (0)
#define PG8_LDA(dst, b, h) do { _Pragma("unroll") for (int m = 0; m < 4; ++m) _Pragma("unroll") for (int k = 0; k < 2; ++k) dst[m][k] = *(const PG8_LAS bf16x8*)(lds + PG8_SA(b, h) + aoff + m * 2048 + k * 1024); } while (0)
#define PG8_LDB(dst, b, h) do { _Pragma("unroll") for (int n = 0; n < 2; ++n) _Pragma("unroll") for (int k = 0; k < 2; ++k) dst[n][k] = *(const PG8_LAS bf16x8*)(lds + PG8_SB(b, h) + boff + n * 2048 + k * 1024); } while (0)
#define PG8_MMA(ai, bj, At, Bt) do { __builtin_amdgcn_s_setprio(1); _Pragma("unroll") for (int m = 0; m < 4; ++m) _Pragma("unroll") for (int n = 0; n < 2; ++n) _Pragma("unroll") for (int k = 0; k < 2; ++k) \
        acc[ai][bj][m][n] = __builtin_amdgcn_mfma_f32_16x16x32_bf16(Bt[n][k], At[m][k], acc[ai][bj][m][n], 0, 0, 0); __builtin_amdgcn_s_setprio(0); } while (0)
#define PG8_WAIT_V(n) asm volatile("s_waitcnt vmcnt(" #n ")" ::: "memory")
#define PG8_WAIT_L(n) asm volatile("s_waitcnt lgkmcnt(" #n ")" ::: "memory")
#define PG8_BAR __builtin_amdgcn_s_barrier()
#define PG8_SCHED __builtin_amdgcn_sched_barrier(0)
    Unit cur, nxt; int ui = 0;
    if (!S.next(0, cur)) return;
    f32x4 acc[2][2][4][2];
#pragma unroll
    for (int a = 0; a < 2; ++a)
#pragma unroll
        for (int b = 0; b < 2; ++b)
#pragma unroll
            for (int m = 0; m < 4; ++m)
#pragma unroll
                for (int n = 0; n < 2; ++n) acc[a][b][m][n] = (f32x4){0.f, 0.f, 0.f, 0.f};
    bf16x8 At[4][2], B0[2][2], B1[2][2];
    int kb_cur, nt; S.krange(cur, K, kb_cur, nt);
    const char* cA = PG8_BASEA(cur) + (size_t)kb_cur * 2; const char* cB = PG8_BASEB(cur) + (size_t)kb_cur * 2;
    S.a_ready(cur);
    if constexpr (SP2) {
        PG8_STAGE(PG8_SB(0, 0), cB, voffB); PG8_STAGE(PG8_SB(0, 1), cB + hstepB, voffB); PG8_STAGE(PG8_SA(0, 0), cA, voffA); PG8_STAGE(PG8_SA(0, 1), cA + hstepA, voffA);
        if (wr == 1) PG8_BAR;
        PG8_WAIT_V(2); PG8_BAR;
        PG8_STAGE(PG8_SB(1, 0), cB + kstep, voffB); PG8_STAGE(PG8_SA(1, 0), cA + kstep, voffA); PG8_STAGE(PG8_SB(1, 1), cB + hstepB + kstep, voffB);
        PG8_WAIT_V(6); PG8_BAR;
    } else {
        PG8_STAGE(PG8_SB(0, 0), cB, voffB); PG8_STAGE(PG8_SA(0, 0), cA, voffA); PG8_STAGE(PG8_SB(0, 1), cB + hstepB, voffB); PG8_STAGE(PG8_SA(0, 1), cA + hstepA, voffA);
        if (wr == 1) PG8_BAR;
        PG8_WAIT_V(4); PG8_BAR;
        PG8_STAGE(PG8_SB(1, 0), cB + kstep, voffB); PG8_STAGE(PG8_SA(1, 0), cA + kstep, voffA); PG8_STAGE(PG8_SB(1, 1), cB + hstepB + kstep, voffB);
        PG8_WAIT_V(6); PG8_BAR;
    }
    for (;;) {
        const bool has_next = S.next(ui + 1, nxt);
        int kb_nxt = 0, nt_nxt = nt; if (has_next) S.krange(nxt, K, kb_nxt, nt_nxt);
        const char* nA = has_next ? PG8_BASEA(nxt) + (size_t)kb_nxt * 2 : cA; const char* nB = has_next ? PG8_BASEB(nxt) + (size_t)kb_nxt * 2 : cB;
        for (int t = 0; t < nt; t += 2) {
            const bool last = (t == nt - 2);
            const char* a1 = cA + (size_t)(t + 1) * kstep;
            const char* a2 = last ? nA : cA + (size_t)(t + 2) * kstep; const char* b2 = last ? nB : cB + (size_t)(t + 2) * kstep;
            const char* a3 = a2 + kstep; const char* b3 = b2 + kstep;
            if (last && has_next) S.a_ready(nxt);
            if constexpr (SP2) {
            PG8_LDB(B0, 0, 0); PG8_LDB(B1, 0, 1); PG8_SCHED; PG8_LDA(At, 0, 0); PG8_STAGE(PG8_SA(1, 1), a1 + hstepA, voffA);
            PG8_WAIT_V(8); PG8_WAIT_L(0); PG8_BAR; PG8_MMA(0, 0, At, B0); PG8_MMA(0, 1, At, B1); PG8_BAR; PG8_SCHED;
            PG8_LDA(At, 0, 1); PG8_STAGE(PG8_SB(0, 0), b2, voffB); PG8_STAGE(PG8_SB(0, 1), b2 + hstepB, voffB); PG8_STAGE(PG8_SA(0, 0), a2, voffA);
            PG8_WAIT_V(8); PG8_WAIT_L(0); PG8_BAR; PG8_MMA(1, 0, At, B0); PG8_MMA(1, 1, At, B1); PG8_BAR; PG8_SCHED;
            PG8_LDB(B0, 1, 0); PG8_LDB(B1, 1, 1); PG8_SCHED; PG8_LDA(At, 1, 0); PG8_STAGE(PG8_SA(0, 1), a2 + hstepA, voffA);
            PG8_WAIT_V(8); PG8_WAIT_L(0); PG8_BAR; PG8_MMA(0, 0, At, B0); PG8_MMA(0, 1, At, B1); PG8_BAR; PG8_SCHED;
            PG8_LDA(At, 1, 1); PG8_STAGE(PG8_SB(1, 0), b3, voffB); PG8_STAGE(PG8_SB(1, 1), b3 + hstepB, voffB); PG8_STAGE(PG8_SA(1, 0), a3, voffA);
            PG8_WAIT_V(8); PG8_WAIT_L(0); PG8_BAR; PG8_MMA(1, 0, At, B0); PG8_MMA(1, 1, At, B1); PG8_BAR; PG8_SCHED;
            } else {
            PG8_LDB(B0, 0, 0); PG8_SCHED; PG8_LDA(At, 0, 0); PG8_STAGE(PG8_SA(1, 1), a1 + hstepA, voffA);
            PG8_WAIT_L(8); PG8_BAR; PG8_WAIT_L(0); PG8_MMA(0, 0, At, B0); PG8_BAR; PG8_SCHED;
            PG8_LDB(B1, 0, 1); PG8_STAGE(PG8_SB(0, 0), b2, voffB);
            PG8_BAR; PG8_WAIT_L(0); PG8_MMA(0, 1, At, B1); PG8_BAR;
            PG8_LDA(At, 0, 1); PG8_STAGE(PG8_SA(0, 0), a2, voffA);
            PG8_BAR; PG8_WAIT_L(0); PG8_MMA(1, 0, At, B0); PG8_BAR; PG8_SCHED;
            PG8_STAGE(PG8_SB(0, 1), b2 + hstepB, voffB);
            PG8_WAIT_V(6); PG8_BAR; PG8_MMA(1, 1, At, B1); PG8_BAR;
            PG8_LDB(B0, 1, 0); PG8_SCHED; PG8_LDA(At, 1, 0); PG8_STAGE(PG8_SA(0, 1), a2 + hstepA, voffA);
            PG8_WAIT_L(8); PG8_BAR; PG8_WAIT_L(0); PG8_MMA(0, 0, At, B0); PG8_BAR; PG8_SCHED;
            PG8_LDB(B1, 1, 1); PG8_STAGE(PG8_SB(1, 0), b3, voffB);
            PG8_BAR; PG8_WAIT_L(0); PG8_MMA(0, 1, At, B1); PG8_BAR;
            PG8_LDA(At, 1, 1); PG8_STAGE(PG8_SA(1, 0), a3, voffA);
            PG8_BAR; PG8_WAIT_L(0); PG8_MMA(1, 0, At, B0); PG8_BAR; PG8_SCHED;
            PG8_STAGE(PG8_SB(1, 1), b3 + hstepB, voffB);
            PG8_WAIT_V(6); PG8_BAR; PG8_MMA(1, 1, At, B1); PG8_BAR;
            }
        }
        if constexpr (ALIGN_EPI) { if (wr == 0) PG8_BAR; }
        E(acc, cur, wr, wc, fr, fq); S.done(cur);
        if (!has_next) break;
#pragma unroll
        for (int a = 0; a < 2; ++a)
#pragma unroll
            for (int b = 0; b < 2; ++b)
#pragma unroll
                for (int m = 0; m < 4; ++m)
#pragma unroll
                    for (int n = 0; n < 2; ++n) acc[a][b][m][n] = (f32x4){0.f, 0.f, 0.f, 0.f};
        cur = nxt; cA = nA; cB = nB; nt = nt_nxt; ++ui;
        if constexpr (ALIGN_EPI) { if (wr == 1) PG8_BAR; }
    }
    PG8_WAIT_V(0);
    if constexpr (!ALIGN_EPI) { if (wr == 0) PG8_BAR; }
    PG8_BAR;
#undef PG8_BASEA
#undef PG8_BASEB
#undef PG8_SA
#undef PG8_SB
#undef PG8_STAGE
#undef PG8_LDA
#undef PG8_LDB
#undef PG8_MMA
#undef PG8_WAIT_V
#undef PG8_WAIT_L
#undef PG8_BAR
#undef PG8_SCHED
}
}

#define XB_TMO      128
#define XB_XCNT(j)  (256  + 64 * (j))
#define XB_XSUB(j)  (1280 + 64 * (j))
#define XB_XGEN(j)  (2304 + 64 * (j))
#define XB_TOP      3328
#define XB_TOPGEN   3392
#define XCD_BAR_WORDS 3456
#define XB_SPIN_CAP (1u << 22)
__device__ __forceinline__ unsigned xb_ld(unsigned* p)              { return __hip_atomic_load(p, __ATOMIC_RELAXED, __HIP_MEMORY_SCOPE_AGENT); }
__device__ __forceinline__ unsigned xb_add(unsigned* p, unsigned v) { return __hip_atomic_fetch_add(p, v, __ATOMIC_RELAXED, __HIP_MEMORY_SCOPE_AGENT); }
__device__ __forceinline__ unsigned xb_xcc_id() { return (unsigned)__builtin_amdgcn_s_getreg((3 << 11) | 20) & 0xFu; }
#define XB_SPIN(cond, bar) do { unsigned _sp = 0; while (cond) { __builtin_amdgcn_s_sleep(1); \
    if ((++_sp & 255u) == 0u) { if (xb_ld(&(bar)[XB_TMO])) break; if (_sp > XB_SPIN_CAP) { atomicAdd(&(bar)[XB_TMO], 1u); break; } } } } while (0)
struct XcdBarrier { unsigned* bar; unsigned x; volatile LAS unsigned* st; int wave; };
__device__ __forceinline__ XcdBarrier xcd_barrier_post(unsigned* bar, volatile LAS unsigned* st) {
    XcdBarrier b; b.bar = bar; b.x = xb_xcc_id(); b.st = st;
    if (threadIdx.x == 0) (void)xb_add(&bar[XB_XCNT(b.x)], 1u);
    return b;
}
__device__ __forceinline__ void xcd_barrier_complete(unsigned* bar, unsigned x, unsigned& nloc, unsigned& nx) {
    const unsigned G = gridDim.x * gridDim.y * gridDim.z;
    unsigned sum, cnt, mine, sp = 0u;
    for (;;) {
        sum = 0u; cnt = 0u; mine = 0u;
#pragma unroll
        for (unsigned j = 0; j < 16; ++j) { const unsigned c = xb_ld(&bar[XB_XCNT(j)]); sum += c; cnt += (c > 0u) ? 1u : 0u; mine = (j == x) ? c : mine; }
        if (sum == G) break;
        __builtin_amdgcn_s_sleep(1);
        if ((++sp & 255u) == 0u) { if (xb_ld(&bar[XB_TMO])) break; if (sp > XB_SPIN_CAP) { atomicAdd(&bar[XB_TMO], 1u); break; } }
    }
    nloc = mine > 0u ? mine : 1u; nx = cnt > 0u ? cnt : 1u;
}
__device__ __forceinline__ void xcd_barrier(const XcdBarrier& b) {
    asm volatile("s_waitcnt vmcnt(0)" ::: "memory");
    __syncthreads();
    if (b.wave == 0 && lane_id_asm() == 0) {
        unsigned* bar = b.bar; unsigned bx = b.x;
        asm volatile("" : "+s"(bar), "+s"(bx));
        __builtin_amdgcn_s_waitcnt(0);
        unsigned nloc = b.st[0], nx = b.st[1];
        if (nloc == 0u) { xcd_barrier_complete(bar, bx, nloc, nx); b.st[0] = nloc; b.st[1] = nx; }
        const unsigned old = xb_add(&bar[XB_XSUB(bx)], 1u);
        const unsigned gen = old / nloc;
        if (old + 1u == (gen + 1u) * nloc) {
            __builtin_amdgcn_fence(__ATOMIC_RELEASE, "agent");
            asm volatile("s_waitcnt vmcnt(0)" ::: "memory");
            const unsigned og = xb_add(&bar[XB_TOP], 1u);
            const unsigned tg = og / nx;
            if (og + 1u == (tg + 1u) * nx) xb_add(&bar[XB_TOPGEN], 1u);
            else XB_SPIN(xb_ld(&bar[XB_TOPGEN]) == tg, bar);
            __builtin_amdgcn_fence(__ATOMIC_ACQUIRE, "agent");
            xb_add(&bar[XB_XGEN(bx)], 1u);
            asm volatile("s_waitcnt vmcnt(0)" ::: "memory");
        } else {
            XB_SPIN(xb_ld(&bar[XB_XGEN(bx)]) == gen, bar);
            __builtin_amdgcn_fence(__ATOMIC_ACQUIRE, "agent");
            asm volatile("s_waitcnt vmcnt(0)" ::: "memory");
        }
    }
    __syncthreads();
}

constexpr int D = 2048, SEQ = 8192, M = 16384, DFF = 8192;
constexpr int NSA_N = 5376;
constexpr int NSA_N1 = 4096;
constexpr int DIL_N = 18432;
constexpr int DRNN = 2688, RG_N = 5632;
constexpr int RG_XOFF = 2816;
constexpr int NWAVES = 8, NTHREADS = 512;
constexpr int LDV = M + 64;
constexpr float ATT_SCALE = 0.08838834764831845f;
constexpr float NORM_EPS = 1e-6f;

constexpr int IN_X = 0, IN_C = 1, IN_NORMF = 45;
__host__ __device__ __forceinline__ constexpr int layer_base(int li) { return li == 0 ? 2 : li == 1 ? 13 : li == 2 ? 21 : 34; }
__host__ __device__ __forceinline__ constexpr int ff_off(int li) { return li == 1 ? 5 : li == 2 ? 10 : 8; }
__host__ __device__ __forceinline__ constexpr int wout_off(int li) { return li == 1 ? 4 : li == 2 ? 9 : 7; }

constexpr size_t MiB = 1u << 20;
constexpr size_t WS_CTL = 0, CTL_ZERO_BYTES = 1 * MiB;
constexpr size_t WS_MODP = 1 * MiB;
constexpr size_t WS_MOD = 4 * MiB;
constexpr size_t WS_COS = 5 * MiB, WS_SIN = 7 * MiB;
constexpr size_t WS_BPEP = 9 * MiB;
constexpr size_t WS_BPE = 9 * MiB + 512 * 1024;
constexpr size_t WS_LSP = 9 * MiB + 768 * 1024;
constexpr size_t WS_W = 10 * MiB;
constexpr size_t WE_NSA_WIN = 0, WE_NSA_W1 = 11010048, WE_NSA_WOUT = 11010048 + 4194304, WE_NSA_SZ = 19398656;
constexpr size_t WE_DIL = 2 * WE_NSA_SZ, WE_DIL_WOUT = WE_DIL + 37748736;
constexpr size_t WE_RG = WE_DIL + 41943040, WE_RG_WG = WE_RG + 11534336, WE_RG_WOUT = WE_RG_WG + 14450688;
constexpr size_t WE_FF = WE_RG + 31490048;
constexpr size_t WE_END = WE_FF + 4 * (size_t)33554432;
static_assert(WE_END == 246448128, "weight map");
constexpr size_t WS_HN = 482 * MiB;
constexpr size_t WS_ATT = 546 * MiB;
constexpr size_t WS_XR = 630 * MiB;
constexpr size_t WS_BIG = 694 * MiB;
static_assert(WS_W + WE_END * 2 <= WS_HN, "ws map");
constexpr size_t NS_Q = WS_BIG, NS_QR = NS_Q + 64 * MiB, NS_PK = NS_QR + 64 * MiB, NS_PV = NS_PK + 16 * MiB, NS_KS = NS_PV + 16 * MiB, NS_KW = NS_KS + 16 * MiB,
                 NS_VT = NS_KW + 16 * MiB  , NS_GT = NS_VT + 34 * MiB, NS_HC = NS_GT + 4 * MiB, NS_KC = NS_HC + 32 * MiB  ,
                 NS_VCT = NS_KC + 1 * MiB  , NS_END = NS_VCT + 1 * MiB;
constexpr size_t RG_YX = WS_BIG, RG_X = RG_YX + 176 * MiB, RG_A = RG_X + 84 * MiB, RG_B = RG_A + 168 * MiB, RG_CA = RG_B + 168 * MiB, RG_CB = RG_CA + 3 * MiB;
constexpr size_t DL_QK = WS_BIG, DL_VT = WS_BIG + 384 * MiB, DL_VT_STRIDE = 66 * MiB, DL_ML = WS_BIG + 582 * MiB;
constexpr size_t WS_END = WS_BIG + 610 * MiB;
static_assert(RG_CB + 3 * MiB <= WS_END && NS_END <= WS_END && DL_ML + 2 * MiB <= WS_END && WS_END <= (size_t)1396 * MiB, "ws map");

constexpr int RING_BYTES = 147456, MISC_OFF = RING_BYTES + 320, LDS_BYTES = 163840;

struct Params { const float* in[46]; float* out; unsigned char* ws; };

__device__ __forceinline__ float lo_bf(unsigned w) { return __uint_as_float(w << 16); }
__device__ __forceinline__ float hi_bf(unsigned w) { return __uint_as_float(w & 0xffff0000u); }
__device__ __forceinline__ unsigned pk2(float lo, float hi) { return pg8::cvt_pk_bf16(lo, hi); }
__device__ __forceinline__ float wave_sum(float v) {
#pragma unroll
    for (int o = 1; o < 64; o <<= 1) v += __shfl_xor(v, o);
    return v;
}
__device__ __forceinline__ float wave_max(float v) {
#pragma unroll
    for (int o = 1; o < 64; o <<= 1) v = fmaxf(v, __shfl_xor(v, o));
    return v;
}
__device__ __forceinline__ float sigmoidf_(float x) { return 1.0f / (1.0f + __expf(-x)); }
__device__ __forceinline__ float gelu_tanh(float x) { const float u = 0.7978845608028654f * (x + 0.044715f * x * x * x); const float e = __expf(2.0f * u); return 0.5f * x * (2.0f - 2.0f / (e + 1.0f)); }
__device__ __forceinline__ int sigma_d(int pos) { return (pos & 1) * 64 + (pos >> 1); }
__device__ __forceinline__ void store8_bf16(bf16* p, const f32x4 v0, const f32x4 v1) {
    u32x4 w; w.x = pk2(v0[0], v0[1]); w.y = pk2(v0[2], v0[3]); w.z = pk2(v1[0], v1[1]); w.w = pk2(v1[2], v1[3]); *(u32x4*)p = w; }
__device__ __forceinline__ void rope8(f32x4& v0, f32x4& v1, const float* cosr, const float* sinr, int i0) {
    const f32x4 cs = *(const f32x4*)(cosr + i0), sn = *(const f32x4*)(sinr + i0);
    const f32x4 a = v0, b = v1;
    v0[0] = a[0] * cs[0] - a[1] * sn[0]; v0[1] = a[0] * sn[0] + a[1] * cs[0];
    v0[2] = a[2] * cs[1] - a[3] * sn[1]; v0[3] = a[2] * sn[1] + a[3] * cs[1];
    v1[0] = b[0] * cs[2] - b[1] * sn[2]; v1[1] = b[0] * sn[2] + b[1] * cs[2];
    v1[2] = b[2] * cs[3] - b[3] * sn[3]; v1[3] = b[2] * sn[3] + b[3] * cs[3];
}

__device__ __forceinline__ void rope8v(f32x4& v0, f32x4& v1, const f32x4 cs, const f32x4 sn) {
    const f32x4 a = v0, b = v1;
    v0[0] = a[0] * cs[0] - a[1] * sn[0]; v0[1] = a[0] * sn[0] + a[1] * cs[0];
    v0[2] = a[2] * cs[1] - a[3] * sn[1]; v0[3] = a[2] * sn[1] + a[3] * cs[1];
    v1[0] = b[0] * cs[2] - b[1] * sn[2]; v1[1] = b[0] * sn[2] + b[1] * cs[2];
    v1[2] = b[2] * cs[3] - b[3] * sn[3]; v1[3] = b[2] * sn[3] + b[3] * cs[3];
}
#define EPI_LOOP_ROWS for (int ai = 0; ai < 2; ++ai) _Pragma("unroll") for (int m = 0; m < 4; ++m)
struct EpiNsaIn {
    static constexpr bool PERM = true, AFTER_DRAIN = false;
    bf16 *Q, *QR, *PK, *PV, *KS, *KW; float* GT; const float *COS, *SIN;
    __device__ __forceinline__ void operator()(const f32x4 (&acc)[2][2][4][2], const pg8::Unit& u, int wr, int wc, int fr, int fq) const {
        const int pn = u.pn, row0 = u.pm * 256 + wr * 64 + fr, cl = wc * 32 + 8 * fq;
        const bool rot = pn < 8 || pn >= 12;
#pragma unroll
        for (int ai = 0; ai < 2; ++ai) {
            f32x4 cs[4], sn[4];
            if (rot) {
#pragma unroll
                for (int m = 0; m < 4; ++m) { const int t = (row0 + ai * 128 + m * 16) & (SEQ - 1); cs[m] = *(const f32x4*)(COS + (size_t)t * 64 + (cl >> 1)); sn[m] = *(const f32x4*)(SIN + (size_t)t * 64 + (cl >> 1)); } }
#pragma unroll
            for (int m = 0; m < 4; ++m) {
                const int row = row0 + ai * 128 + m * 16, t = row & (SEQ - 1), b = row >> 13;
#pragma unroll
                for (int bj = 0; bj < 2; ++bj) {
                    f32x4 v0 = acc[ai][bj][m][0], v1 = acc[ai][bj][m][1];
                    const int hh = (pn & 1) * 2 + bj;
                    if (pn < 8) {
                        const size_t o = (size_t)row * 2048 + pn * 256 + bj * 128 + cl;
                        store8_bf16(Q + o, v0, v1);
                        rope8v(v0, v1, cs[m], sn[m]);
                        store8_bf16(QR + o, v0, v1);
                    } else if (pn < 12) {
                        bf16* P = pn < 10 ? PK : PV;
                        const size_t o = ((size_t)((b * 4 + hh) * 512 + (t >> 4))) * 2048 + (t & 15) * 128 + cl;
                        store8_bf16(P + o, v0, v1);
                    } else {
                        bf16* P = pn < 14 ? KS : KW;
                        rope8v(v0, v1, cs[m], sn[m]);
                        store8_bf16(P + (size_t)row * 512 + hh * 128 + cl, v0, v1);
                    }
                }
            }
        }
    }
};
struct EpiGates {
    static constexpr bool PERM = true, AFTER_DRAIN = false;
    float* GT;
    __device__ __forceinline__ void operator()(const f32x4 (&acc)[2][2][4][2], const pg8::Unit& u, int wr, int wc, int fr, int fq) const {
        const int row0 = u.pm * 256 + wr * 64 + fr, cl = wc * 32 + 8 * fq;
        if (cl < 48) {
#pragma unroll
            EPI_LOOP_ROWS { const int row = row0 + ai * 128 + m * 16; const f32x4 v0 = acc[ai][0][m][0], v1 = acc[ai][0][m][1];
#pragma unroll
                for (int e = 0; e < 4; ++e) { GT[(size_t)row * 48 + cl + e] = sigmoidf_(v0[e]); GT[(size_t)row * 48 + cl + 4 + e] = sigmoidf_(v1[e]); } }
        }
    }
};
struct EpiDilQK {
    static constexpr bool PERM = true, AFTER_DRAIN = false;
    bf16* O; const float *COS, *SIN; int dsh;
    __device__ __forceinline__ void operator()(const f32x4 (&acc)[2][2][4][2], const pg8::Unit& u, int wr, int wc, int fr, int fq) const {
        const int pn = u.pn, row0 = u.pm * 256 + wr * 64 + fr, cl = wc * 32 + 8 * fq, sh = 13 - dsh;
#pragma unroll
        for (int ai = 0; ai < 2; ++ai) {
            f32x4 cs[4], sn[4];
#pragma unroll
            for (int m = 0; m < 4; ++m) { const int row = row0 + ai * 128 + m * 16, rem = row & (SEQ - 1), t = ((rem & ((1 << sh) - 1)) << dsh) + (rem >> sh);
                cs[m] = *(const f32x4*)(COS + (size_t)t * 64 + (cl >> 1)); sn[m] = *(const f32x4*)(SIN + (size_t)t * 64 + (cl >> 1)); }
#pragma unroll
            for (int m = 0; m < 4; ++m) { const int row = row0 + ai * 128 + m * 16;
#pragma unroll
                for (int bj = 0; bj < 2; ++bj) {
                    f32x4 v0 = acc[ai][bj][m][0], v1 = acc[ai][bj][m][1];
                    rope8v(v0, v1, cs[m], sn[m]);
                    store8_bf16(O + (size_t)row * 4096 + pn * 256 + bj * 128 + cl, v0, v1);
                } }
        }
    }
};
template <int ACT> struct EpiBf16 {
    static constexpr bool PERM = true, AFTER_DRAIN = false;
    bf16* O; int ldc; int act_tiles;
    __device__ __forceinline__ void operator()(const f32x4 (&acc)[2][2][4][2], const pg8::Unit& u, int wr, int wc, int fr, int fq) const {
        const int pn = u.pn, row0 = u.pm * 256 + wr * 64 + fr, cl = wc * 32 + 8 * fq;
        const bool act = pn < act_tiles;
#pragma unroll
        EPI_LOOP_ROWS {
            const int row = row0 + ai * 128 + m * 16;
#pragma unroll
            for (int bj = 0; bj < 2; ++bj) {
                f32x4 v0 = acc[ai][bj][m][0], v1 = acc[ai][bj][m][1];
                if (ACT == 1) {
#pragma unroll
                    for (int e = 0; e < 4; ++e) { const float a = fmaxf(v0[e], 0.f), c = fmaxf(v1[e], 0.f); v0[e] = a * a; v1[e] = c * c; }
                }
                if (ACT == 2) { if (act) {
#pragma unroll
                    for (int e = 0; e < 4; ++e) { v0[e] = gelu_tanh(v0[e]); v1[e] = gelu_tanh(v1[e]); } } }
                store8_bf16(O + (size_t)row * ldc + pn * 256 + bj * 128 + cl, v0, v1);
            }
        }
    }
};
struct EpiF32 {
    static constexpr bool PERM = false, AFTER_DRAIN = false;
    float* C; int ldc;
    __device__ __forceinline__ void operator()(const f32x4 (&acc)[2][2][4][2], const pg8::Unit& u, int wr, int wc, int fr, int fq) const {
        const int row0 = u.pm * 256 + wr * 64 + fr, col0 = u.pn * 256 + wc * 32 + 4 * fq;
#pragma unroll
        EPI_LOOP_ROWS {
            float* rowp = C + (size_t)(row0 + ai * 128 + m * 16) * ldc + col0;
#pragma unroll
            for (int bj = 0; bj < 2; ++bj)
#pragma unroll
                for (int n = 0; n < 2; ++n) *(f32x4*)(rowp + bj * 128 + n * 16) = acc[ai][bj][m][n];
        }
    }
};
struct EpiRes {
    static constexpr bool PERM = true, AFTER_DRAIN = false;
    const float* xin32; const bf16* xin16; bf16* out; const float* gate;
    __device__ __forceinline__ void operator()(const f32x4 (&acc)[2][2][4][2], const pg8::Unit& u, int wr, int wc, int fr, int fq) const {
        const int row0 = u.pm * 256 + wr * 64 + fr, cl = wc * 32 + 8 * fq, b = (u.pm * 256) >> 13;
        f32x4 g0[2], g1[2];
#pragma unroll
        for (int bj = 0; bj < 2; ++bj) { const float* gp = gate + (size_t)b * 12288 + u.pn * 256 + bj * 128 + cl; g0[bj] = *(const f32x4*)gp; g1[bj] = *(const f32x4*)(gp + 4); }
#pragma unroll
        for (int ai = 0; ai < 2; ++ai) {
            f32x4 x0[4][2], x1[4][2];
#pragma unroll
            for (int m = 0; m < 4; ++m)
#pragma unroll
                for (int bj = 0; bj < 2; ++bj) { const size_t o = (size_t)(row0 + ai * 128 + m * 16) * D + u.pn * 256 + bj * 128 + cl;
                    if (xin32) { x0[m][bj] = *(const f32x4*)(xin32 + o); x1[m][bj] = *(const f32x4*)(xin32 + o + 4); }
                    else { const u32x4 w = *(const u32x4*)(xin16 + o); x0[m][bj] = (f32x4){lo_bf(w.x), hi_bf(w.x), lo_bf(w.y), hi_bf(w.y)}; x1[m][bj] = (f32x4){lo_bf(w.z), hi_bf(w.z), lo_bf(w.w), hi_bf(w.w)}; } }
#pragma unroll
            for (int m = 0; m < 4; ++m)
#pragma unroll
                for (int bj = 0; bj < 2; ++bj) store8_bf16(out + (size_t)(row0 + ai * 128 + m * 16) * D + u.pn * 256 + bj * 128 + cl, x0[m][bj] + g0[bj] * acc[ai][bj][m][0], x1[m][bj] + g1[bj] * acc[ai][bj][m][1]);
        }
    }
};
struct EpiRgGate {
    static constexpr bool PERM = true, AFTER_DRAIN = false;
    const bf16* X; const float *bgate, *LSP; unsigned* AB;
    __device__ __forceinline__ void operator()(const f32x4 (&acc)[2][2][4][2], const pg8::Unit& u, int wr, int wc, int fr, int fq) const {
        const int row0 = u.pm * 256 + wr * 64 + fr, ch0 = u.pn * 128 + wc * 32 + 8 * fq;
        u32x4 xw[2][4];
#pragma unroll
        for (int ai = 0; ai < 2; ++ai)
#pragma unroll
            for (int m = 0; m < 4; ++m) xw[ai][m] = *(const u32x4*)(X + (size_t)(row0 + ai * 128 + m * 16) * DRNN + ch0);
        const f32x4 br0 = *(const f32x4*)(bgate + ch0), br1 = *(const f32x4*)(bgate + ch0 + 4);
        const f32x4 bi0 = *(const f32x4*)(bgate + DRNN + ch0), bi1 = *(const f32x4*)(bgate + DRNN + ch0 + 4);
        const f32x4 ls0 = *(const f32x4*)(LSP + ch0), ls1 = *(const f32x4*)(LSP + ch0 + 4);
#pragma unroll
        EPI_LOOP_ROWS {
            const size_t o = (size_t)(row0 + ai * 128 + m * 16) * DRNN + ch0;
            const u32x4 xv = xw[ai][m];
            const f32x4 x0 = (f32x4){lo_bf(xv.x), hi_bf(xv.x), lo_bf(xv.y), hi_bf(xv.y)}, x1 = (f32x4){lo_bf(xv.z), hi_bf(xv.z), lo_bf(xv.w), hi_bf(xv.w)};
            const f32x4 r0 = acc[ai][0][m][0] + br0, r1 = acc[ai][0][m][1] + br1, i0 = acc[ai][1][m][0] + bi0, i1 = acc[ai][1][m][1] + bi1;
            u32x4 w0, w1;
#pragma unroll
            for (int e = 0; e < 4; ++e) {
                float la = ls0[e] * sigmoidf_(r0[e]); float bb = sqrtf(fmaxf(-expm1f(2.0f * la), 0.f)) * (sigmoidf_(i0[e]) * x0[e]); w0[e] = pk2(la * 1.4426950408889634f, bb);
                la = ls1[e] * sigmoidf_(r1[e]); bb = sqrtf(fmaxf(-expm1f(2.0f * la), 0.f)) * (sigmoidf_(i1[e]) * x1[e]); w1[e] = pk2(la * 1.4426950408889634f, bb);
            }
            *(u32x4*)(AB + o) = w0; *(u32x4*)(AB + o + 4) = w1;
        }
    }
};

__device__ __forceinline__ const float* inp(const Params& P, int i) { i = __builtin_amdgcn_readfirstlane(i); asm volatile("" : "+s"(i)); return P.in[i]; }
enum { MAP_ID = 0, MAP_NSA = 1, MAP_DIL = 2, MAP_RG = 3 };
struct Job { const float* W; int ldw, K; bf16* WT; int ldt, n_begin, n_rows, map, srcoff; };
__device__ __forceinline__ int srccol(int map, int n, int srcoff) {
    if (map == MAP_ID) return n + srcoff;
    if (map == MAP_NSA) {
        if (n < 2048) return (n & ~127) + sigma_d(n & 127);
        if (n < 3072) return n;
        if (n < 3584) return (n & ~127) + sigma_d(n & 127);
        if (n < 4096) return ((n + 512) & ~127) + sigma_d(n & 127);
        if (n < 4144) return 5120 + (n - 4096);
        if (n < 4352) return -1;
        if (n < 4864) return n - 768;
        return n - 256;
    }
    if (map == MAP_DIL) { const int j = (n >> 11) % 3; return j < 2 ? (n & ~127) + sigma_d(n & 127) : n; }
    if (n < DRNN) return n; if (n < RG_XOFF) return -1; if (n < RG_XOFF + DRNN) return n - (RG_XOFF - DRNN); return -1;
}
__device__ __forceinline__ bool is_sigma(int map, int n) {
    if (map == MAP_NSA) return n < 2048 || (n >= 3072 && n < 4096);
    if (map == MAP_DIL) return ((n >> 11) % 3) < 2;
    return false;
}
__device__ __forceinline__ void conv_item(const Job& J, int item, LAS float* scr, int lane) {
    const int nblk = J.n_rows / 32, kb = item / nblk, nb = item % nblk, k0 = 64 * kb, n0 = J.n_begin + 32 * nb, nl0 = n0 - J.n_begin;
    const int ks = lane >> 3, c4 = lane & 7;
    const bool sig = is_sigma(J.map, nl0);
    const int dl0 = sig ? 8 * (c4 & 3) + (c4 >> 2) : 4 * c4, dstep = sig ? 2 : 1;
    const int sc4 = srccol(J.map, nl0 + dl0, J.srcoff);
    f32x4 v[8];
#pragma unroll
    for (int i = 0; i < 8; ++i) v[i] = sc4 >= 0 ? *(const f32x4*)(J.W + (size_t)(k0 + 8 * i + ks) * J.ldw + sc4) : (f32x4){0.f, 0.f, 0.f, 0.f};
#pragma unroll
    for (int i = 0; i < 8; ++i) { LAS float* d = scr + (8 * i + ks) * 33 + dl0; d[0] = v[i][0]; d[dstep] = v[i][1]; d[2 * dstep] = v[i][2]; d[3 * dstep] = v[i][3]; }
    LDS_WAIT();
    const int c = lane & 7;
#pragma unroll
    for (int j = 0; j < 4; ++j) { const int n = (lane >> 3) + 8 * j; const LAS float* sp = scr + (8 * c) * 33 + n;
        u32x4 o; o.x = pk2(sp[0 * 33], sp[1 * 33]); o.y = pk2(sp[2 * 33], sp[3 * 33]); o.z = pk2(sp[4 * 33], sp[5 * 33]); o.w = pk2(sp[6 * 33], sp[7 * 33]);
        *(u32x4*)(J.WT + (size_t)(n0 + n) * J.ldt + k0 + 8 * c) = o; }
    LDS_WAIT();
}
constexpr int NJOBS = 24;
__device__ __forceinline__ Job get_job(const Params& P, int jid) {
    bf16* WB = (bf16*)(P.ws + WS_W);
    Job J; J.srcoff = 0; J.map = MAP_ID; J.n_begin = 0;
    if (jid < 12) {
        const int slot = jid / 6, r = jid % 6, bi = slot == 0 ? 2 : 34; bf16* base = WB + (size_t)slot * WE_NSA_SZ;
        if (r == 0) { J.W = inp(P, bi + 3); J.ldw = 5168; J.K = 2048; J.WT = base + WE_NSA_WIN; J.ldt = 2048; J.n_rows = NSA_N; J.map = MAP_NSA; }
        else if (r < 5) { const int kv = (r - 1) >> 1, half = (r - 1) & 1;
            J.W = inp(P, bi + 5) + (size_t)kv * 4096 * 512 + (size_t)half * 2048 * 512; J.ldw = 512; J.K = 2048;
            J.WT = base + WE_NSA_W1 + (size_t)kv * 1024 * 2048; J.ldt = 2048; J.n_begin = half * 512; J.n_rows = 512; }
        else { J.W = inp(P, bi + 7); J.ldw = 2048; J.K = 2048; J.WT = base + WE_NSA_WOUT; J.ldt = 2048; J.n_rows = 2048; }
    } else if (jid == 12) { J.W = inp(P, 13 + 3); J.ldw = DIL_N; J.K = 2048; J.WT = WB + WE_DIL; J.ldt = 2048; J.n_rows = DIL_N; J.map = MAP_DIL; }
    else if (jid == 13) { J.W = inp(P, 13 + 4); J.ldw = 2048; J.K = 2048; J.WT = WB + WE_DIL_WOUT; J.ldt = 2048; J.n_rows = 2048; }
    else if (jid == 14) { J.W = inp(P, 21 + 3); J.ldw = 2 * DRNN; J.K = 2048; J.WT = WB + WE_RG; J.ldt = 2048; J.n_rows = RG_N; J.map = MAP_RG; }
    else if (jid == 15) { J.W = inp(P, 21 + 9); J.ldw = 2048; J.K = DRNN; J.WT = WB + WE_RG_WOUT; J.ldt = DRNN; J.n_rows = 2048; }
    else { const int li = (jid - 16) >> 1, w = (jid - 16) & 1, bi = layer_base(li) + ff_off(li);
        if (w == 0) { J.W = inp(P, bi + 1); J.ldw = DFF; J.K = 2048; J.WT = WB + WE_FF + (size_t)li * 33554432; J.ldt = 2048; J.n_rows = DFF; }
        else { J.W = inp(P, bi + 2); J.ldw = 2048; J.K = DFF; J.WT = WB + WE_FF + (size_t)li * 33554432 + 16777216; J.ldt = DFF; J.n_rows = 2048; } }
    return J;
}

namespace fa {
typedef float f32x16 __attribute__((ext_vector_type(16)));
typedef short bf16x8 __attribute__((ext_vector_type(8)));
constexpr int KROW = 272, VROW = 144, KTILE = 64 * KROW, VTILE = 128 * VROW;
constexpr int KBUF0 = 0, VBUF0 = 3 * KTILE, IMP_OFF = VBUF0 + 2 * VTILE, MSK_OFF = RING_BYTES - 1024;
static_assert(IMP_OFF + 32768 <= MSK_OFF, "attention LDS map");
static_assert(MSK_OFF + 1024 <= RING_BYTES, "attention LDS map");
constexpr float C2 = ATT_SCALE * 1.4426950408889634f;
#define FA_MFMA(a, b, c) __builtin_amdgcn_mfma_f32_32x32x16_bf16(a, b, c, 0, 0, 0)
__device__ __forceinline__ float half_max(float v) { auto rr = __builtin_amdgcn_permlane32_swap(__float_as_uint(v), __float_as_uint(v), false, false); return fmaxf(__uint_as_float(rr[0]), __uint_as_float(rr[1])); }
__device__ __forceinline__ float half_sum(float v) { auto rr = __builtin_amdgcn_permlane32_swap(__float_as_uint(v), __float_as_uint(v), false, false); return __uint_as_float(rr[0]) + __uint_as_float(rr[1]); }
struct Src { const bf16* K0; long ldk; const bf16* V0; long ldv; int tsh; };
struct Stage { u32x4 k0, k1, v0, v1; };
__device__ __forceinline__ void stage_load_k(Stage& s, const Src& src, int T, int tid) {
    const int kr = tid >> 4, kc = tid & 15;
    const char* kb = (const char*)(src.K0 + (long)(64 * (T >> src.tsh)) * src.ldk); const char* kb2 = kb + 64 * src.ldk;
    unsigned ko = (unsigned)(kr * (int)src.ldk + kc * 8) * 2u; asm volatile("" : "+v"(ko));
    s.k0 = *(const u32x4*)(kb + ko); s.k1 = *(const u32x4*)(kb2 + ko);
}
__device__ __forceinline__ void stage_load_v(Stage& s, const Src& src, int T, int tid) {
    const int vr = tid >> 3, vp = tid & 7;
    const char* vb = (const char*)(src.V0 + 64 * (T >> src.tsh)); const char* vb2 = vb + 128 * src.ldv;
    unsigned vo = (unsigned)(vr * (int)src.ldv + vp * 8) * 2u; asm volatile("" : "+v"(vo));
    s.v0 = *(const u32x4*)(vb + vo); s.v1 = *(const u32x4*)(vb2 + vo);
}
__device__ __forceinline__ void stage_load(Stage& s, const Src& src, int T, int tid, bool withV) { stage_load_k(s, src, T, tid); if (withV) stage_load_v(s, src, T, tid); }
__device__ __forceinline__ void stage_write_k_at(const Stage& s, LAS unsigned char* ktile, int tid) {
    const int kr = tid >> 4, kc = tid & 15;
    LAS unsigned char* kb = ktile + kr * KROW + kc * 16;
    *(LAS u32x4*)kb = s.k0; *(LAS u32x4*)(kb + 32 * KROW) = s.k1;
}
__device__ __forceinline__ void stage_write_k(const Stage& s, LAS unsigned char* lds, int kbuf, int tid) { stage_write_k_at(s, lds + KBUF0 + kbuf * KTILE, tid); }
__device__ __forceinline__ void stage_write_v_at(const Stage& s, LAS unsigned char* vtile, int tid);
__device__ __forceinline__ void stage_write_v(const Stage& s, LAS unsigned char* lds, int vbuf, int tid) { stage_write_v_at(s, lds + VBUF0 + vbuf * VTILE, tid); }
__device__ __forceinline__ void stage_write_v_at(const Stage& s, LAS unsigned char* vtile, int tid) {
    const int vr = tid >> 3, vp = tid & 7, g16 = vp >> 1, half = vp & 1;
    LAS unsigned char* vb = vtile + vr * VROW + g16 * 32 + half * 8;
    *(LAS u32x2*)(vb) = (u32x2){s.v0.x, s.v0.y}; *(LAS u32x2*)(vb + 16) = (u32x2){s.v0.z, s.v0.w};
    *(LAS u32x2*)(vb + 64 * VROW) = (u32x2){s.v1.x, s.v1.y}; *(LAS u32x2*)(vb + 64 * VROW + 16) = (u32x2){s.v1.z, s.v1.w};
}
__device__ __forceinline__ void stage_write(const Stage& s, LAS unsigned char* lds, int buf, int tid, bool withV) { stage_write_k(s, lds, buf, tid); if (withV) stage_write_v(s, lds, buf, tid); }
__device__ __forceinline__ void load_q(bf16x8 (&qf)[8], const bf16* qrow, int hi) {
#pragma unroll
    for (int kk = 0; kk < 8; ++kk) qf[kk] = *(const bf16x8*)(qrow + kk * 16 + hi * 8);
}
#define FA_PIPE_16() do { __builtin_amdgcn_sched_group_barrier(0x100, 4, 0); \
    _Pragma("unroll") for (int i_ = 0; i_ < 12; ++i_) { __builtin_amdgcn_sched_group_barrier(0x008, 1, 0); __builtin_amdgcn_sched_group_barrier(0x100, 1, 0); } \
    __builtin_amdgcn_sched_group_barrier(0x008, 4, 0); } while (0)
__device__ __forceinline__ void qk_tile_at(f32x16& p0, f32x16& p1, const LAS unsigned char* ktile, const bf16x8 (&qf)[8], int c32, int hi);
__device__ __forceinline__ void qk_tile(f32x16& p0, f32x16& p1, const LAS unsigned char* lds, int buf, const bf16x8 (&qf)[8], int c32, int hi) { qk_tile_at(p0, p1, lds + KBUF0 + buf * KTILE, qf, c32, hi); }
__device__ __forceinline__ void qk_tile_at(f32x16& p0, f32x16& p1, const LAS unsigned char* ktile, const bf16x8 (&qf)[8], int c32, int hi) {
#pragma unroll
    for (int r = 0; r < 16; ++r) { p0[r] = 0.f; p1[r] = 0.f; }
    const LAS unsigned char* kb = ktile + c32 * KROW + hi * 16;
    bf16x8 a[16];
#pragma unroll
    for (int kk = 0; kk < 8; ++kk) { a[2 * kk] = *(const LAS bf16x8*)(kb + 32 * kk); a[2 * kk + 1] = *(const LAS bf16x8*)(kb + 32 * KROW + 32 * kk); }
#pragma unroll
    for (int kk = 0; kk < 8; ++kk) { p0 = FA_MFMA(a[2 * kk], qf[kk], p0); p1 = FA_MFMA(a[2 * kk + 1], qf[kk], p1); }
    FA_PIPE_16();
}
__device__ __forceinline__ void pv_tile_at(f32x16 (&o)[4], const LAS unsigned char* vtile, const bf16x8 (&pa)[4], int c32, int hi);
__device__ __forceinline__ void pv_tile(f32x16 (&o)[4], const LAS unsigned char* lds, int buf, const bf16x8 (&pa)[4], int c32, int hi) { pv_tile_at(o, lds + VBUF0 + buf * VTILE, pa, c32, hi); }
__device__ __forceinline__ void pv_tile_at(f32x16 (&o)[4], const LAS unsigned char* vtile, const bf16x8 (&pa)[4], int c32, int hi) {
    const LAS unsigned char* vb = vtile + c32 * VROW + hi * 16;
    bf16x8 a[16];
#pragma unroll
    for (int S = 0; S < 4; ++S)
#pragma unroll
        for (int db = 0; db < 4; ++db) a[4 * S + db] = *(const LAS bf16x8*)(vb + db * 32 * VROW + 32 * S);
#pragma unroll
    for (int S = 0; S < 4; ++S)
#pragma unroll
        for (int db = 0; db < 4; ++db) o[db] = FA_MFMA(a[4 * S + db], pa[S], o[db]);
    FA_PIPE_16();
}
__device__ __forceinline__ void mask_range(f32x16& p0, f32x16& p1, int lo, int hi_, int hi) {
    const int lo4 = lo - 4 * hi, hi4 = hi_ - 4 * hi;
#pragma unroll
    for (int r = 0; r < 16; ++r) { const int c = (r & 3) + 8 * (r >> 2);
        if (c < lo4 || c > hi4) p0[r] = -INFINITY;
        if (c + 32 < lo4 || c + 32 > hi4) p1[r] = -INFINITY; }
}
template <int B_> __device__ __forceinline__ bf16x8 pack8r(const f32x16& p) {
    u32x4 w; w.x = pk2(p[B_ + 0], p[B_ + 1]); w.y = pk2(p[B_ + 2], p[B_ + 3]); w.z = pk2(p[B_ + 4], p[B_ + 5]); w.w = pk2(p[B_ + 6], p[B_ + 7]);
    return __builtin_bit_cast(bf16x8, w); }
constexpr float THR = 8.0f;
__device__ __forceinline__ void softmax_step(f32x16& p0, f32x16& p1, bool rowoff, float& m, float& l, f32x16 (&o)[4], bf16x8 (&pa)[4]) {
    float mx = fmaxf(fmaxf(p0[0], p0[1]), p0[2]);
#pragma unroll
    for (int r = 3; r < 15; r += 2) mx = fmaxf(fmaxf(mx, p0[r]), p0[r + 1]);
    mx = fmaxf(mx, p0[15]);
#pragma unroll
    for (int r = 0; r < 16; r += 2) mx = fmaxf(fmaxf(mx, p1[r]), p1[r + 1]);
    mx = half_max(mx);
    if (rowoff) mx = -INFINITY;
    if (!__all((mx - m) * C2 <= THR)) {
        const float mn = fmaxf(m, mx), alpha = __builtin_amdgcn_exp2f((m - mn) * C2); m = mn; l *= alpha;
#pragma unroll
        for (int db = 0; db < 4; ++db) o[db] = o[db] * alpha;
    }
    const float mnL = rowoff ? -INFINITY : -m * C2;
    p0 = p0 * C2 + mnL; p1 = p1 * C2 + mnL;
#pragma unroll
    for (int r = 0; r < 16; ++r) { p0[r] = __builtin_amdgcn_exp2f(p0[r]); p1[r] = __builtin_amdgcn_exp2f(p1[r]); }
    f32x16 sv = p0 + p1;
    const float ps = ((sv[0] + sv[1]) + (sv[2] + sv[3])) + ((sv[4] + sv[5]) + (sv[6] + sv[7])) + (((sv[8] + sv[9]) + (sv[10] + sv[11])) + ((sv[12] + sv[13]) + (sv[14] + sv[15])));
    l += half_sum(ps);
    pa[0] = pack8r<0>(p0); pa[1] = pack8r<8>(p0); pa[2] = pack8r<0>(p1); pa[3] = pack8r<8>(p1);
}
struct Msk { int qlo, qhi; const LAS unsigned* sel; };
#define FA_PIPE_8() do { __builtin_amdgcn_sched_group_barrier(0x100, 4, 0); \
    _Pragma("unroll") for (int i_ = 0; i_ < 4; ++i_) { __builtin_amdgcn_sched_group_barrier(0x008, 1, 0); __builtin_amdgcn_sched_group_barrier(0x100, 1, 0); } \
    __builtin_amdgcn_sched_group_barrier(0x008, 4, 0); } while (0)
__device__ __forceinline__ void qk_half(f32x16& p, const LAS unsigned char* lds, int kbuf, int half, const bf16x8 (&qf)[8], int c32, int hi) {
#pragma unroll
    for (int r = 0; r < 16; ++r) p[r] = 0.f;
    const LAS unsigned char* kb = lds + KBUF0 + kbuf * KTILE + half * 32 * KROW + c32 * KROW + hi * 16;
    bf16x8 a[8];
#pragma unroll
    for (int kk = 0; kk < 8; ++kk) a[kk] = *(const LAS bf16x8*)(kb + 32 * kk);
#pragma unroll
    for (int kk = 0; kk < 8; ++kk) p = FA_MFMA(a[kk], qf[kk], p);
    FA_PIPE_8();
}
__device__ __forceinline__ void pv_half(f32x16 (&o)[4], const LAS unsigned char* lds, int vbuf, int half, const bf16x8 (&pa)[2], int c32, int hi) {
    const LAS unsigned char* vb = lds + VBUF0 + vbuf * VTILE + c32 * VROW + hi * 16 + half * 64;
    bf16x8 a[8];
#pragma unroll
    for (int s2 = 0; s2 < 2; ++s2)
#pragma unroll
        for (int db = 0; db < 4; ++db) a[4 * s2 + db] = *(const LAS bf16x8*)(vb + db * 32 * VROW + 32 * s2);
#pragma unroll
    for (int s2 = 0; s2 < 2; ++s2)
#pragma unroll
        for (int db = 0; db < 4; ++db) o[db] = FA_MFMA(a[4 * s2 + db], pa[s2], o[db]);
    FA_PIPE_8();
}
__device__ __forceinline__ void softmax_half(f32x16& p, int half, bool needrange, int lo, int hi_, int hi, bool rowoff, float& m, float& l, f32x16 (&o)[4], bf16x8 (&pa)[2]) {
    if (needrange) { const int lo4 = lo - 4 * hi - 32 * half, hi4 = hi_ - 4 * hi - 32 * half;
#pragma unroll
        for (int r = 0; r < 16; ++r) { const int c = (r & 3) + 8 * (r >> 2); if (c < lo4 || c > hi4) p[r] = -INFINITY; } }
    float mx = fmaxf(fmaxf(p[0], p[1]), p[2]);
#pragma unroll
    for (int r = 3; r < 15; r += 2) mx = fmaxf(fmaxf(mx, p[r]), p[r + 1]);
    mx = half_max(fmaxf(mx, p[15]));
    if (rowoff) mx = -INFINITY;
    if (!__all((mx - m) * C2 <= THR)) {
        const float mn = fmaxf(m, mx), alpha = __builtin_amdgcn_exp2f((m - mn) * C2); m = mn; l *= alpha;
#pragma unroll
        for (int db = 0; db < 4; ++db) o[db] = o[db] * alpha;
    }
    const float mnL = rowoff ? -INFINITY : -m * C2;
#pragma unroll
    for (int r = 0; r < 16; ++r) p[r] = __builtin_amdgcn_exp2f(fmaf(p[r], C2, mnL));
    const float ps = (((p[0] + p[1]) + (p[2] + p[3])) + ((p[4] + p[5]) + (p[6] + p[7]))) + (((p[8] + p[9]) + (p[10] + p[11])) + ((p[12] + p[13]) + (p[14] + p[15])));
    l += half_sum(ps);
    pa[0] = pack8r<0>(p); pa[1] = pack8r<8>(p);
}
__device__ __forceinline__ void flash_flags(const Msk& mk, int Tt, int tsh, int& lo, int& hi_, bool& rowoff) {
    const int T = Tt >> tsh;
    lo = mk.qlo - 64 * T; hi_ = mk.qhi - 64 * T;
    rowoff = !(hi_ >= 0 && lo <= 63);
    if (mk.sel) { const unsigned w = mk.sel[T >> 5]; rowoff = rowoff || (((w >> (T & 31)) & 1u) == 0u); }
}
__device__ __forceinline__ void flash_pass(LAS unsigned char* lds, int tid, int c32, int hi, int T0, int T1, const Src& src, const Msk& mk, const bf16x8 (&qf)[8],
                                           float& m, float& l, f32x16 (&o)[4]) {
    Stage st; f32x16 sA, sB;
    const int n = T1 - T0 + 1; const bool lateqk = __builtin_amdgcn_readfirstlane(tid >> 8) != 0;
    __syncthreads();
    {   Stage st1;
        stage_load(st, src, T0, tid, true); if (n > 1) stage_load_k(st1, src, T0 + 1, tid);
        stage_write(st, lds, 0, tid, true); if (n > 1) stage_write_k(st1, lds, 1, tid); }
    if (n > 2) stage_load_k(st, src, T0 + 2, tid);
    if (n > 1) stage_load_v(st, src, T0 + 1, tid);
    __syncthreads();
    int lo, hi_; bool rowoff; flash_flags(mk, T0, src.tsh, lo, hi_, rowoff);
    bool act = !__all(rowoff);
    if (act) qk_half(sA, lds, 0, 0, qf, c32, hi);
#pragma unroll 1
    for (int i = 0; i < n; ++i) {
        if (i > 0) __syncthreads();
        if (i + 2 < n) stage_write_k(st, lds, (i + 2) % 3, tid);
        if (i + 1 < n) stage_write_v(st, lds, (i + 1) & 1, tid);
        if (i + 3 < n) stage_load_k(st, src, T0 + i + 3, tid);
        if (i + 2 < n) stage_load_v(st, src, T0 + i + 2, tid);
        const bool needrange = __any(!rowoff && !(lo <= 0 && hi_ >= 63));
        bf16x8 pa[2];
        if (act) { if (!lateqk) qk_half(sB, lds, i % 3, 1, qf, c32, hi);
                   softmax_half(sA, 0, needrange, lo, hi_, hi, rowoff, m, l, o, pa); pv_half(o, lds, i & 1, 0, pa, c32, hi);
                   if (lateqk) qk_half(sB, lds, i % 3, 1, qf, c32, hi); }
        int lo2 = 0, hi2 = 0; bool off2 = true, act2 = false;
        if (i + 1 < n) { flash_flags(mk, T0 + i + 1, src.tsh, lo2, hi2, off2); act2 = !__all(off2); }
        if (act2 && !lateqk) qk_half(sA, lds, (i + 1) % 3, 0, qf, c32, hi);
        if (act) { softmax_half(sB, 1, needrange, lo, hi_, hi, rowoff, m, l, o, pa); pv_half(o, lds, i & 1, 1, pa, c32, hi); }
        if (act2 && lateqk) qk_half(sA, lds, (i + 1) % 3, 0, qf, c32, hi);
        lo = lo2; hi_ = hi2; rowoff = off2; act = act2;
    }
}

constexpr int ASLOT = KTILE + VTILE;
constexpr int ANSLOT = 4;
static_assert(ANSLOT * ASLOT <= MSK_OFF, "async ring must not reach the selection masks");
__device__ __forceinline__ void lds_signal(volatile LAS unsigned* w, int lane) {
    asm volatile("s_waitcnt lgkmcnt(0)" ::: "memory");
    if (lane == 0) (void)__hip_atomic_fetch_add((LAS unsigned*)w, 1u, __ATOMIC_RELAXED, __HIP_MEMORY_SCOPE_WORKGROUP);
}
__device__ __forceinline__ void lds_wait(volatile LAS unsigned* w, unsigned target) {
    unsigned spins = 0;
    while ((unsigned)__builtin_amdgcn_readfirstlane(*w) < target) { __builtin_amdgcn_s_sleep(1); if (++spins > (1u << 22)) break; }
    asm volatile("" ::: "memory");
}
__device__ __forceinline__ void flash_pass_async(LAS unsigned char* lds, int tid, int lane, int c32, int hi, int T0, int T1, const Src& src, const Msk& mk, const bf16x8 (&qf)[8],
                                                 float& m, float& l, f32x16 (&o)[4]) {
    volatile LAS unsigned* fill = (volatile LAS unsigned*)(lds + RING_BYTES + 2048); volatile LAS unsigned* done = fill + 8;
    const int n = T1 - T0 + 1;
    Stage st;
    __syncthreads();
    if (tid < 16) fill[tid] = 0u;
    stage_load(st, src, T0, tid, true);
    __syncthreads();
    stage_write_k_at(st, lds, tid); stage_write_v_at(st, lds + KTILE, tid); lds_signal(fill + 0, lane);
    if (n > 1) stage_load(st, src, T0 + 1, tid, true);
#pragma unroll 1
    for (int i = 0; i < n; ++i) {
        const int s0 = i % ANSLOT;
        if (i + 1 < n) { const int s1 = (i + 1) % ANSLOT;
            lds_wait(done + s1, 8u * (unsigned)((i + 1) / ANSLOT));
            stage_write_k_at(st, lds + s1 * ASLOT, tid); stage_write_v_at(st, lds + s1 * ASLOT + KTILE, tid); lds_signal(fill + s1, lane);
            if (i + 2 < n) stage_load(st, src, T0 + i + 2, tid, true); }
        int lo, hi_; bool rowoff; flash_flags(mk, T0 + i, src.tsh, lo, hi_, rowoff);
        if (!__all(rowoff)) {
            lds_wait(fill + s0, 8u * (unsigned)(i / ANSLOT + 1));
            f32x16 p0, p1; bf16x8 pa[4];
            qk_tile_at(p0, p1, lds + s0 * ASLOT, qf, c32, hi);
            if (__any(!rowoff && !(lo <= 0 && hi_ >= 63))) mask_range(p0, p1, lo, hi_, hi);
            softmax_step(p0, p1, rowoff, m, l, o, pa);
            pv_tile_at(o, lds + s0 * ASLOT + KTILE, pa, c32, hi);
        }
        lds_signal(done + s0, lane);
    }
}
}

__device__ __forceinline__ void nsa_item(LAS unsigned char* lds, int wave, int lane, int b, int g, int c, const bf16* Q, const bf16* QR, const bf16* KCB, const bf16* VCT,
                                         const bf16* KS, const bf16* KW, const bf16* VT, const float* GT, float* OACC, bf16* ATT) {
    using namespace fa;
    const int tid = wave * 64 + lane, c32 = lane & 31, hi = lane >> 5;
    const int tl = wave * 8 + (c32 >> 2), head = c32 & 3, t = c * 64 + tl, mrow = b * SEQ + t, hq = g * 4 + head, bg = b * 4 + g;
    LAS float* IMP = (LAS float*)(lds + IMP_OFF); LAS unsigned* MSK = (LAS unsigned*)(lds + MSK_OFF);
    bf16x8 qf[8]; f32x16 o[4]; float m, l;
#define NSA_PTRS() int mr_ = mrow, hq_ = hq; asm volatile("" : "+v"(mr_), "+v"(hq_)); const float* gp = GT + (size_t)(mr_ * 48 + hq_ * 3); float* oacc = OACC + (size_t)mr_ * 2048 + (unsigned)(hq_ * 128); (void)gp; (void)oacc
    {
        { int mr_ = mrow, hq_ = hq; asm volatile("" : "+v"(mr_), "+v"(hq_)); load_q(qf, Q + (size_t)mr_ * 2048 + (unsigned)(hq_ * 128), hi); }
        const int NTc = (4 * c + 3 + 63) >> 6;
        const int qhi = (t - 31) >> 4;
        const Src src{KCB + (size_t)bg * 512 * 128, 128, VCT + (size_t)bg * 128 * 512, 512, 0};
        m = -1e30f; l = 0.f;
        Stage st;
        __syncthreads();
        stage_load(st, src, 0, tid, false);
#pragma unroll 1
        for (int T = 0; T < NTc; ++T) {
            const int buf = T & 1;
            stage_write(st, lds, buf, tid, false);
            __syncthreads();
            if (T + 1 < NTc) stage_load(st, src, T + 1, tid, false);
            f32x16 p0, p1;
            qk_tile(p0, p1, lds, buf, qf, c32, hi);
            mask_range(p0, p1, 0, qhi - 64 * T, hi);
            float mx = p0[0];
#pragma unroll
            for (int r = 1; r < 16; ++r) mx = fmaxf(mx, p0[r]);
#pragma unroll
            for (int r = 0; r < 16; ++r) mx = fmaxf(mx, p1[r]);
            mx = half_max(mx);
            const float mn = fmaxf(m, mx), alpha = __builtin_amdgcn_exp2f((m - mn) * C2), mnL = -mn * C2; m = mn;
            float ps = 0.f;
#pragma unroll
            for (int r = 0; r < 16; ++r) ps += __builtin_amdgcn_exp2f(fmaf(p0[r], C2, mnL)) + __builtin_amdgcn_exp2f(fmaf(p1[r], C2, mnL));
            l = l * alpha + half_sum(ps);
        }
        const float inv = l > 0.f ? 1.0f / l : 0.f, mnL = -m * C2;
#pragma unroll
        for (int db = 0; db < 4; ++db)
#pragma unroll
            for (int r = 0; r < 16; ++r) o[db][r] = 0.f;
        float carry = 0.f;
        __syncthreads();
        stage_load(st, src, 0, tid, true);
#pragma unroll 1
        for (int T = 0; T < NTc; ++T) {
            const int buf = T & 1;
            stage_write(st, lds, buf, tid, true);
            __syncthreads();
            if (T + 1 < NTc) stage_load(st, src, T + 1, tid, true);
            f32x16 p0, p1; bf16x8 pa[4];
            qk_tile(p0, p1, lds, buf, qf, c32, hi);
            mask_range(p0, p1, 0, qhi - 64 * T, hi);
#pragma unroll
            for (int r = 0; r < 16; ++r) { p0[r] = __builtin_amdgcn_exp2f(fmaf(p0[r], C2, mnL)) * inv; p1[r] = __builtin_amdgcn_exp2f(fmaf(p1[r], C2, mnL)) * inv; }
#pragma unroll
            for (int hf = 0; hf < 2; ++hf) {
                float qs[4], flo[4], fhi[4];
#pragma unroll
                for (int q4 = 0; q4 < 4; ++q4) {
                    const float e0 = hf ? p1[4 * q4] : p0[4 * q4], e1 = hf ? p1[4 * q4 + 1] : p0[4 * q4 + 1], e2 = hf ? p1[4 * q4 + 2] : p0[4 * q4 + 2], e3 = hf ? p1[4 * q4 + 3] : p0[4 * q4 + 3];
                    qs[q4] = (e0 + e1) + (e2 + e3);
                    auto rr = __builtin_amdgcn_permlane32_swap(__float_as_uint(e3), __float_as_uint(e3), false, false);
                    flo[q4] = __uint_as_float(rr[0]); fhi[q4] = __uint_as_float(rr[1]);
                }
#pragma unroll
                for (int q4 = 0; q4 < 4; ++q4) {
                    const float cin = hi ? flo[q4] : (q4 == 0 ? carry : fhi[q4 == 0 ? 0 : q4 - 1]);
                    float v = qs[q4] + cin; v += __shfl_xor(v, 1); v += __shfl_xor(v, 2);
                    if (head == 0) IMP[tl * 128 + 16 * T + 8 * hf + 2 * q4 + hi] = v;
                }
                carry = fhi[3];
            }
            pa[0] = pack8r<0>(p0); pa[1] = pack8r<8>(p0); pa[2] = pack8r<0>(p1); pa[3] = pack8r<8>(p1);
            pv_tile(o, lds, buf, pa, c32, hi);
        }
        NSA_PTRS();
        const float g0 = gp[0];
#pragma unroll
        for (int db = 0; db < 4; ++db)
#pragma unroll
            for (int q4 = 0; q4 < 4; ++q4)
                *(f32x4*)(oacc + 32 * db + 8 * q4 + 4 * hi) = (f32x4){o[db][4 * q4] * g0, o[db][4 * q4 + 1] * g0, o[db][4 * q4 + 2] * g0, o[db][4 * q4 + 3] * g0};
    }
    LDS_WAIT();
#ifndef REP_TOPK
#define REP_TOPK 1
#endif
#pragma unroll 1
    for (int rep_ = 0; rep_ < fresh_s(REP_TOPK); ++rep_)
#pragma unroll 1
    for (int tk = 0; tk < 8; ++tk) {
        LAS float* row = IMP + (wave * 8 + tk) * 128;
        const int j0 = lane, j1 = lane + 64;
        const float v0 = row[j0], v1 = row[j1];
        const float val0 = j0 > c ? -INFINITY : ((j0 == 0 || j0 == c || j0 == c - 1) ? 3.0e38f : v0);
        const float val1 = j1 > c ? -INFINITY : ((j1 == c || j1 == c - 1) ? 3.0e38f : v1);
        LDS_WAIT();
        row[j0] = val0; row[j1] = val1;
        LDS_WAIT();
        int cnt0 = 0, cnt1 = 0;
#pragma unroll 4
        for (int i4 = 0; i4 <= (c >> 2); ++i4) {
            const f32x4 x = *(const LAS f32x4*)(row + 4 * i4);
#pragma unroll
            for (int e = 0; e < 4; ++e) { const int i = 4 * i4 + e; cnt0 += (x[e] > val0 || (x[e] == val0 && i < j0)) ? 1 : 0; cnt1 += (x[e] > val1 || (x[e] == val1 && i < j1)) ? 1 : 0; } }
        const unsigned long long m0 = __ballot(j0 <= c && cnt0 < 16), m1 = __ballot(j1 <= c && cnt1 < 16);
        if (lane == 0) { LAS unsigned* mp = MSK + (wave * 8 + tk) * 4; mp[0] = (unsigned)m0; mp[1] = (unsigned)(m0 >> 32); mp[2] = (unsigned)m1; mp[3] = (unsigned)(m1 >> 32); }
    }
    LDS_WAIT();
    { int mr_ = mrow, hq_ = hq; asm volatile("" : "+v"(mr_), "+v"(hq_)); load_q(qf, QR + (size_t)mr_ * 2048 + (unsigned)(hq_ * 128), hi); }
    {
        Msk mk; mk.qlo = 0; mk.qhi = t; mk.sel = MSK + tl * 4;
        #ifdef PROBE_SEL2
        const Src src{KS + (size_t)b * SEQ * 512 + g * 128, 512, VT + (size_t)(g * 128) * LDV + (size_t)b * SEQ, LDV, 1};
#else
        const Src src{KS + (size_t)b * SEQ * 512 + g * 128, 512, VT + (size_t)(g * 128) * LDV + (size_t)b * SEQ, LDV, 0};
#endif
#ifndef REP_SEL
#define REP_SEL 1
#endif
        m = -1e30f; l = 0.f;
#pragma unroll
        for (int db = 0; db < 4; ++db)
#pragma unroll
            for (int r = 0; r < 16; ++r) o[db][r] = 0.f;
#ifdef PROBE_SEL2
        flash_pass(lds, tid, c32, hi, 0, 2 * c + 1, src, mk, qf, m, l, o);
#else
        flash_pass_async(lds, tid, lane, c32, hi, 0, c, src, mk, qf, m, l, o);
#endif
        NSA_PTRS();
        const float sc = gp[1] / l;
#pragma unroll
        for (int db = 0; db < 4; ++db)
#pragma unroll
            for (int q4 = 0; q4 < 4; ++q4) { float* p = oacc + 32 * db + 8 * q4 + 4 * hi; const f32x4 a = *(const f32x4*)p;
                *(f32x4*)p = (f32x4){a[0] + o[db][4 * q4] * sc, a[1] + o[db][4 * q4 + 1] * sc, a[2] + o[db][4 * q4 + 2] * sc, a[3] + o[db][4 * q4 + 3] * sc}; }
    }
    {
        Msk mk; mk.qlo = t - 511; mk.qhi = t; mk.sel = nullptr;
        const Src src{KW + (size_t)b * SEQ * 512 + g * 128, 512, VT + (size_t)(512 + g * 128) * LDV + (size_t)b * SEQ, LDV, 0};
        m = -1e30f; l = 0.f;
#pragma unroll
        for (int db = 0; db < 4; ++db)
#pragma unroll
            for (int r = 0; r < 16; ++r) o[db][r] = 0.f;
        flash_pass(lds, tid, c32, hi, c >= 8 ? c - 8 : 0, c, src, mk, qf, m, l, o);
        NSA_PTRS();
        const float sc = gp[2] / l;
        bf16* arow = ATT + (size_t)mr_ * 2048 + (unsigned)(hq_ * 128);
#pragma unroll
        for (int db = 0; db < 4; ++db)
#pragma unroll
            for (int q4 = 0; q4 < 4; ++q4) { const f32x4 a = *(const f32x4*)(oacc + 32 * db + 8 * q4 + 4 * hi);
                u32x2 w; w.x = pk2(a[0] + o[db][4 * q4] * sc, a[1] + o[db][4 * q4 + 1] * sc); w.y = pk2(a[2] + o[db][4 * q4 + 2] * sc, a[3] + o[db][4 * q4 + 3] * sc);
                *(u32x2*)(arow + 32 * db + 8 * q4 + 4 * hi) = w; }
    }
#undef NSA_PTRS
}

__device__ __forceinline__ void dil_item(LAS unsigned char* lds, int wave, int lane, int p, int sq, int h, int qb, const bf16* QK, const bf16* VT, float* OACC, float* ML, bf16* ATT) {
    using namespace fa;
    const int tid = wave * 64 + lane, c32 = lane & 31, hi = lane >> 5, dsh = 2 * p, L = SEQ >> dsh;
    const int b = sq >> dsh, r = sq & ((1 << dsh) - 1), q = qb * 256 + wave * 32 + c32, mrow = b * SEQ + (q << dsh) + r;
    const size_t seqbase = (size_t)sq * L;
    bf16x8 qf[8]; f32x16 o[4]; float m = -1e30f, l = 0.f;
    load_q(qf, QK + (seqbase + q) * 4096 + h * 128, hi);
    if (p > 0) {
        const float* op = OACC + (size_t)mrow * 2048 + h * 128;
#pragma unroll
        for (int db = 0; db < 4; ++db)
#pragma unroll
            for (int q4 = 0; q4 < 4; ++q4) { const f32x4 a = *(const f32x4*)(op + 32 * db + 8 * q4 + 4 * hi); o[db][4 * q4] = a[0]; o[db][4 * q4 + 1] = a[1]; o[db][4 * q4 + 2] = a[2]; o[db][4 * q4 + 3] = a[3]; }
        const f32x2 ml = *(const f32x2*)(ML + ((size_t)mrow * 16 + h) * 2); m = ml[0]; l = ml[1];
    } else {
#pragma unroll
        for (int db = 0; db < 4; ++db)
#pragma unroll
            for (int rr = 0; rr < 16; ++rr) o[db][rr] = 0.f;
    }
    Msk mk; mk.qlo = q - 128; mk.qhi = q; mk.sel = nullptr;
    const Src src{QK + seqbase * 4096 + 2048 + h * 128, 4096, VT + (size_t)(h * 128) * LDV + seqbase, LDV, 0};
    flash_pass(lds, tid, c32, hi, qb * 4 >= 2 ? qb * 4 - 2 : 0, qb * 4 + 3, src, mk, qf, m, l, o);
    int mr_ = mrow; asm volatile("" : "+v"(mr_));
    if (p < 2) {
        float* op = OACC + (size_t)mr_ * 2048 + h * 128;
#pragma unroll
        for (int db = 0; db < 4; ++db)
#pragma unroll
            for (int q4 = 0; q4 < 4; ++q4) *(f32x4*)(op + 32 * db + 8 * q4 + 4 * hi) = (f32x4){o[db][4 * q4], o[db][4 * q4 + 1], o[db][4 * q4 + 2], o[db][4 * q4 + 3]};
        if (hi == 0) *(f32x2*)(ML + ((size_t)mr_ * 16 + h) * 2) = (f32x2){m, l};
    } else {
        const float il = 1.0f / l; bf16* arow = ATT + (size_t)mr_ * 2048 + h * 128;
#pragma unroll
        for (int db = 0; db < 4; ++db)
#pragma unroll
            for (int q4 = 0; q4 < 4; ++q4) { u32x2 w; w.x = pk2(o[db][4 * q4] * il, o[db][4 * q4 + 1] * il); w.y = pk2(o[db][4 * q4 + 2] * il, o[db][4 * q4 + 3] * il);
                *(u32x2*)(arow + 32 * db + 8 * q4 + 4 * hi) = w; }
    }
}

__device__ __forceinline__ void modulate_row(const float* x32, const bf16* x16, const float* gain, const float* shift, const float* scale, bf16* orow, float* frow, int lane) {
    f32x4 v[8]; float ss = 0.f;
    if (x32) {
#pragma unroll
        for (int j = 0; j < 8; ++j) v[j] = *(const f32x4*)(x32 + 4 * lane + 256 * j);
    } else {
        u32x2 w[8];
#pragma unroll
        for (int j = 0; j < 8; ++j) w[j] = *(const u32x2*)(x16 + 4 * lane + 256 * j);
#pragma unroll
        for (int j = 0; j < 8; ++j) v[j] = (f32x4){lo_bf(w[j].x), hi_bf(w[j].x), lo_bf(w[j].y), hi_bf(w[j].y)};
    }
#pragma unroll
    for (int j = 0; j < 8; ++j) ss += (v[j][0] * v[j][0] + v[j][1] * v[j][1]) + (v[j][2] * v[j][2] + v[j][3] * v[j][3]);
    const float rinv = rsqrtf(wave_sum(ss) * (1.0f / D) + NORM_EPS);
#pragma unroll
    for (int j = 0; j < 8; ++j) {
        const int col = 4 * lane + 256 * j;
        const f32x4 gn = *(const f32x4*)(gain + col);
        f32x4 r = v[j] * rinv * gn;
        if (shift) { const f32x4 sh = *(const f32x4*)(shift + col), sc = *(const f32x4*)(scale + col); r = r * (1.0f + sc) + sh;
            u32x2 w; w.x = pk2(r[0], r[1]); w.y = pk2(r[2], r[3]); *(u32x2*)(orow + col) = w; }
        else *(f32x4*)(frow + col) = r;
    }
}

__device__ __forceinline__ unsigned char* wsp_(unsigned char* ws, size_t off) { asm volatile("" : "+s"(off)); return ws + off; }
#define FRESH_IDS() const int wave = fresh_s(wave_s), lane = lane_id_asm(), tid = wave * 64 + lane; (void)tid; \
    const int Gf_ = fresh_s(G), bx_ = fresh_s((int)blockIdx.x); const int gw = bx_ * NWAVES + wave, NGW = Gf_ * NWAVES, gtid = bx_ * NTHREADS + tid, NGT = Gf_ * NTHREADS; \
    LAS float* wl = (LAS float*)(lds + wave * 16384); (void)lane; (void)gw; (void)NGW; (void)gtid; (void)NGT; (void)wl
__global__ void __launch_bounds__(NTHREADS, 2) mega_fwd(Params P) {
    extern __shared__ __attribute__((aligned(16))) unsigned char lds_raw[];
    LAS unsigned char* lds = (LAS unsigned char*)lds_raw;
    volatile LAS unsigned* MISC = (volatile LAS unsigned*)(lds + MISC_OFF);
    const int G = gridDim.x;
    unsigned char* ws = P.ws;
    for (int u = threadIdx.x; u < (LDS_BYTES - RING_BYTES) / 4; u += NTHREADS) ((LAS unsigned*)(lds + RING_BYTES))[u] = 0u;
    __syncthreads();
    const int wave_s = __builtin_amdgcn_readfirstlane(threadIdx.x >> 6);
    XcdBarrier bar = xcd_barrier_post((unsigned*)(ws + WS_CTL) + 4096, MISC + 8); bar.wave = wave_s;
#define GRID_BAR() xcd_barrier(bar)
#define WSP(T, off) ((T*)wsp_(ws, (off)))

    {
        FRESH_IDS();
        float* MODP = WSP(float, WS_MODP); float* COS = WSP(float, WS_COS); float* SIN = WSP(float, WS_SIN); float* BPEP = WSP(float, WS_BPEP); float* LSP = WSP(float, WS_LSP);
        const float* cv = inp(P, IN_C);
        for (int task = gw; task < 4 * 48 * 8; task += NGW) {
            const int kc = task & 7, cg = (task >> 3) % 48, l = task / (8 * 48);
            const float* w = inp(P, layer_base(l)) + (size_t)cg * 256 + lane * 4;
            f32x4 a0 = {0.f, 0.f, 0.f, 0.f}, a1 = {0.f, 0.f, 0.f, 0.f};
#pragma unroll 8
            for (int k = kc * 256; k < kc * 256 + 256; ++k) {
                const float c0 = cv[k], c1 = cv[2048 + k];
                const float s0 = c0 / (1.0f + __expf(-c0)), s1 = c1 / (1.0f + __expf(-c1));
                const f32x4 wv = *(const f32x4*)(w + (size_t)k * 12288);
                a0 += s0 * wv; a1 += s1 * wv;
            }
            *(f32x4*)(MODP + ((size_t)((kc * 4 + l) * 2 + 0)) * 12288 + cg * 256 + lane * 4) = a0;
            *(f32x4*)(MODP + ((size_t)((kc * 4 + l) * 2 + 1)) * 12288 + cg * 256 + lane * 4) = a1;
        }
        for (int i = gtid; i < SEQ * 64; i += NGT) {
            const int t = i >> 6, f = i & 63;
            const double invf = exp2(-(double)f * (13.287712379549449 / 64.0));
            const double ang = (double)t * invf;
            const double n = rint(ang * 0.15915494309189535);
            const double r = (ang - n * 6.283185307179586) - n * 2.4492935982947064e-16;
            COS[i] = (float)cos(r); SIN[i] = (float)sin(r);
        }
        for (int task = gw; task < 2 * 2 * 2 * 16; task += NGW) {
            const int kc = task & 15, cg = (task >> 4) & 1, kv = (task >> 5) & 1, slot = task >> 6;
            const int bi = slot == 0 ? 2 : 34;
            const float* pe = inp(P, bi + 4) + kv * 4096; const float* w = inp(P, bi + 5) + (size_t)kv * 4096 * 512 + cg * 256 + lane * 4;
            f32x4 a = {0.f, 0.f, 0.f, 0.f};
#pragma unroll 8
            for (int k = kc * 256; k < kc * 256 + 256; ++k) a += pe[k] * *(const f32x4*)(w + (size_t)k * 512);
            *(f32x4*)(BPEP + (size_t)((kc * 2 + slot) * 2 + kv) * 512 + cg * 256 + lane * 4) = a;
        }
        { const float* lamp = inp(P, 21 + 8);
          for (int i = gtid; i < DRNN; i += NGT) { const double lam = (double)lamp[i]; LSP[i] = (float)(-8.0 * log1p(exp(-lam))); } }
    }
    GRID_BAR();
    {
        FRESH_IDS();
#pragma unroll 1
        for (int jid = 0; jid < NJOBS; ++jid) {
            const Job J = get_job(P, jid);
            const int nitems = (J.K / 64) * (J.n_rows / 32);
            for (int it = gw; it < nitems; it += NGW) conv_item(J, it, wl, lane);
        }
        {
            const float* wg = inp(P, 21 + 6); bf16* WG = WSP(bf16, WS_W) + WE_RG_WG;
            for (long i = gtid; i < (long)5376 * (DRNN / 8); i += NGT) {
                const int row = (int)(i / (DRNN / 8)), k8 = (int)(i % (DRNN / 8)) * 8;
                const int gate = (row >> 7) & 1, ch = (row >> 8) * 128 + (row & 127), nb = ch / 168, dd = ch % 168;
                float v[8];
#pragma unroll
                for (int e = 0; e < 8; ++e) { const int k = k8 + e; v[e] = (k / 168 == nb) ? wg[((size_t)(gate * 16 + nb) * 168 + (k % 168)) * 168 + dd] : 0.f; }
                u32x4 o; o.x = pk2(v[0], v[1]); o.y = pk2(v[2], v[3]); o.z = pk2(v[4], v[5]); o.w = pk2(v[6], v[7]);
                *(u32x4*)(WG + (size_t)row * DRNN + k8) = o;
            }
        }
        {   const float* MODP = WSP(float, WS_MODP); float* MOD = WSP(float, WS_MOD);
#pragma unroll 1
            for (int l = 0; l < 4; ++l) { const float* bias = inp(P, layer_base(l) + 1);
                for (int i = gtid; i < 2 * 12288; i += NGT) {
                    const int col = i % 12288, lb = l * 2 + i / 12288;
                    float a = bias[col];
#pragma unroll
                    for (int kc = 0; kc < 8; ++kc) a += MODP[(size_t)(kc * 8 + lb) * 12288 + col];
                    MOD[(size_t)lb * 12288 + col] = a;
                } }
            const float* BPEP = WSP(float, WS_BPEP); float* BPE = WSP(float, WS_BPE);
            for (int i = gtid; i < 2 * 2 * 512; i += NGT) { float a = 0.f;
#pragma unroll
                for (int kc = 0; kc < 16; ++kc) a += BPEP[(size_t)kc * 2048 + i];
                BPE[i] = a; }
        }
    }
    GRID_BAR();

#pragma unroll 1
    for (int li = 0; li < 4; ++li) {
        const int kind = li % 3, bi = layer_base(li);
        {   FRESH_IDS();
            const float* x32 = li == 0 ? inp(P, IN_X) : (const float*)nullptr; const bf16* XR = WSP(bf16, WS_XR); const float* gain = inp(P, bi + 2);
            const float* modl = WSP(float, WS_MOD) + (size_t)li * 2 * 12288; bf16* HN = WSP(bf16, WS_HN);
            for (int r = gw; r < M; r += NGW) { const int b = r >> 13;
                modulate_row(x32 ? x32 + (size_t)r * D : (const float*)nullptr, XR + (size_t)r * D, gain, modl + (size_t)b * 12288, modl + (size_t)b * 12288 + 2048, HN + (size_t)r * D, nullptr, lane); } }
        GRID_BAR();
        if (kind == 0) {
            const int slot = li == 0 ? 0 : 1;
            {   bf16* wbase = WSP(bf16, WS_W) + (size_t)slot * WE_NSA_SZ;
                pg8::Gemm g{WSP(bf16, WS_HN), wbase + WE_NSA_WIN, M, NSA_N1, D}; pg8::StaticOrder S; S.init(M, NSA_N1, fresh_s(G), fresh_s((int)blockIdx.x));
                EpiNsaIn E{WSP(bf16, NS_Q), WSP(bf16, NS_QR), WSP(bf16, NS_PK), WSP(bf16, NS_PV), WSP(bf16, NS_KS), WSP(bf16, NS_KW), WSP(float, NS_GT), WSP(float, WS_COS), WSP(float, WS_SIN)};
                pg8::gemm_phase<EpiNsaIn, pg8::StaticOrder, true, true>(lds, g, S, E, wave_s); }
            {
                bf16* wbase = WSP(bf16, WS_W) + (size_t)slot * WE_NSA_SZ;
                pg8::Gemm g{wbase + WE_NSA_WIN + (size_t)4352 * D, WSP(bf16, WS_HN), 1024, M, D}; pg8::StaticOrder S; S.init(1024, M, fresh_s(G), fresh_s((int)blockIdx.x));
                EpiBf16<0> E{WSP(bf16, NS_VT), LDV, 0};
                pg8::gemm_phase<EpiBf16<0>, pg8::StaticOrder, true, true>(lds, g, S, E, wave_s); }
            GRID_BAR();
#pragma unroll 1
            for (int kv = 0; kv < 2; ++kv) {
                bf16* wbase = WSP(bf16, WS_W) + (size_t)slot * WE_NSA_SZ;
                pg8::Gemm g{kv ? WSP(bf16, NS_PV) : WSP(bf16, NS_PK), wbase + WE_NSA_W1 + (size_t)kv * 1024 * 2048, 4096, 1024, 2048}; pg8::StaticOrder S; S.init(4096, 1024, fresh_s(G), fresh_s((int)((blockIdx.x + 128 * kv) % G)));
                EpiF32 E{WSP(float, NS_HC) + (size_t)kv * 4096 * 1024, 1024};
                pg8::gemm_phase<EpiF32, pg8::StaticOrder, true, true>(lds, g, S, E, wave_s); }
            {
                bf16* wbase = WSP(bf16, WS_W) + (size_t)slot * WE_NSA_SZ;
                pg8::Gemm g{WSP(bf16, WS_HN), wbase + WE_NSA_WIN + (size_t)4096 * D, M, 256, D}; pg8::StaticOrder S; S.init(M, 256, fresh_s(G), fresh_s((int)((blockIdx.x + 192) % G)));
                EpiGates E{WSP(float, NS_GT)};
                pg8::gemm_phase<EpiGates, pg8::StaticOrder, true, true>(lds, g, S, E, wave_s); }
            GRID_BAR();
            {
                FRESH_IDS();
                const float* w2 = inp(P, bi + 6); const float* bpe = WSP(float, WS_BPE) + slot * 1024; const float* HCb = WSP(float, NS_HC); bf16* KCb = WSP(bf16, NS_KC); bf16* VCt = WSP(bf16, NS_VCT);
                for (int task = gw; task < 2 * 8 * 128; task += NGW) {
                    const int n0 = (task & 127) * 4, bg = (task >> 7) & 7, kv = task >> 10;
                    const float* hrow = HCb + ((size_t)kv * 4096 + bg * 512 + n0) * 1024;
#pragma unroll
                    for (int q = 0; q < 2; ++q) { const int c = lane * 8 + q * 4; const f32x4 pb = *(const f32x4*)(bpe + kv * 512 + c);
                        f32x4 hv[4];
#pragma unroll
                        for (int r = 0; r < 4; ++r) { const f32x4 a = *(const f32x4*)(hrow + (size_t)r * 1024 + c), bb = n0 + r < 511 ? *(const f32x4*)(hrow + (size_t)(r + 1) * 1024 + 512 + c) : (f32x4){0.f, 0.f, 0.f, 0.f};
#pragma unroll
                            for (int e = 0; e < 4; ++e) hv[r][e] = n0 + r < 511 ? gelu_tanh(a[e] + bb[e] + pb[e]) : 0.f; }
#pragma unroll
                        for (int e = 0; e < 4; ++e) *(LAS f32x4*)(wl + (c + e) * 4) = (f32x4){hv[0][e], hv[1][e], hv[2][e], hv[3][e]}; }
                    LDS_WAIT();
                    const float* wp = w2 + (size_t)kv * 512 * 128 + 2 * lane; f32x4 o0 = {0.f, 0.f, 0.f, 0.f}, o1 = {0.f, 0.f, 0.f, 0.f};
#pragma unroll 16
                    for (int c = 0; c < 512; ++c) { const f32x2 wv = *(const f32x2*)(wp + (size_t)c * 128); const f32x4 hv = *(const LAS f32x4*)(wl + c * 4); o0 += hv * wv[0]; o1 += hv * wv[1]; }
                    const int d0 = 2 * lane, d1 = 2 * lane + 1;
                    if (kv == 0) {
#pragma unroll
                        for (int r = 0; r < 4; ++r) { bf16* dst = KCb + ((size_t)bg * 512 + n0 + r) * 128; dst[(d0 & 63) * 2 + (d0 >> 6)] = (bf16)(pk2(o0[r], 0.f) & 0xffffu); dst[(d1 & 63) * 2 + (d1 >> 6)] = (bf16)(pk2(o1[r], 0.f) & 0xffffu); } }
                    else { bf16* dst = VCt + (size_t)bg * 128 * 512 + n0;
                        u32x2 w0; w0.x = pk2(o0[0], o0[1]); w0.y = pk2(o0[2], o0[3]); *(u32x2*)(dst + (size_t)d0 * 512) = w0;
                        u32x2 w1; w1.x = pk2(o1[0], o1[1]); w1.y = pk2(o1[2], o1[3]); *(u32x2*)(dst + (size_t)d1 * 512) = w1; }
                    LDS_WAIT();
                }
            }
            GRID_BAR();
#ifndef REP_NSA
#define REP_NSA 1
#endif
#pragma unroll 1
            for (int rep = 0; rep < fresh_s(REP_NSA); ++rep)
            {   FRESH_IDS();
#pragma unroll 1
                for (int pi = bx_; pi < 512; pi += Gf_) {
                    const int bg = Gf_ == 256 ? (pi & 7) : (pi >> 6), cc = Gf_ == 256 ? ((pi & 255) >> 3) + 32 * (pi >> 8) : (pi & 63);
#pragma unroll 1
                    for (int e = 0; e < 2; ++e)
                        nsa_item(lds, wave, lane, bg >> 2, bg & 3, e ? cc : 127 - cc, WSP(bf16, NS_Q), WSP(bf16, NS_QR), WSP(bf16, NS_KC), WSP(bf16, NS_VCT), WSP(bf16, NS_KS), WSP(bf16, NS_KW),
                                 WSP(bf16, NS_VT), WSP(float, NS_GT), P.out, WSP(bf16, WS_ATT));
                }
                __syncthreads();
            }
            GRID_BAR();
        } else if (kind == 1) {
#pragma unroll 1
            for (int p = 0; p < 3; ++p) {
                {   pg8::Gemm g{WSP(bf16, WS_HN), WSP(bf16, WS_W) + WE_DIL + (size_t)p * 6144 * D, M, 4096, D, 2 * p, 0}; pg8::StaticOrder S; S.init(M, 4096, fresh_s(G), fresh_s((int)blockIdx.x));
                    EpiDilQK E{WSP(bf16, DL_QK) + (size_t)p * M * 4096, WSP(float, WS_COS), WSP(float, WS_SIN), 2 * p};
                    pg8::gemm_phase<EpiDilQK, pg8::StaticOrder, true, true>(lds, g, S, E, wave_s); }
                {   pg8::Gemm g{WSP(bf16, WS_W) + WE_DIL + ((size_t)p * 6144 + 4096) * D, WSP(bf16, WS_HN), 2048, M, D, 0, 2 * p}; pg8::StaticOrder S; S.init(2048, M, fresh_s(G), fresh_s((int)blockIdx.x));
                    EpiBf16<0> E{(bf16*)(WSP(unsigned char, DL_VT) + (size_t)p * DL_VT_STRIDE), LDV, 0};
                    pg8::gemm_phase<EpiBf16<0>, pg8::StaticOrder, true, true>(lds, g, S, E, wave_s); }
            }
            GRID_BAR();
#pragma unroll 1
            for (int p = 0; p < 3; ++p) {
                {   FRESH_IDS();
                    const int dsh = 2 * p, nqb = (SEQ >> dsh) >> 8;
#pragma unroll 1
                    for (int it = bx_; it < 1024; it += Gf_) {
                        const int qb = it % nqb, h = (it / nqb) & 15, sq = it / (nqb * 16);
                        dil_item(lds, wave, lane, p, sq, h, qb, WSP(bf16, DL_QK) + (size_t)p * M * 4096, (const bf16*)(WSP(unsigned char, DL_VT) + (size_t)p * DL_VT_STRIDE), P.out, WSP(float, DL_ML), WSP(bf16, WS_ATT));
                    }
                    __syncthreads();
                }
                GRID_BAR();
            }
        } else {
            {   pg8::Gemm g{WSP(bf16, WS_HN), WSP(bf16, WS_W) + WE_RG, M, RG_N, D}; pg8::StaticOrder S; S.init(M, RG_N, fresh_s(G), fresh_s((int)blockIdx.x));
                EpiBf16<2> E{WSP(bf16, RG_YX), RG_N, 11};
                pg8::gemm_phase<EpiBf16<2>, pg8::StaticOrder, true, true>(lds, g, S, E, wave_s); }
            GRID_BAR();
            {
                FRESH_IDS();
                const float* cw = inp(P, bi + 4); const float* cb = inp(P, bi + 5); const bf16* YX = WSP(bf16, RG_YX); bf16* Xc = WSP(bf16, RG_X);
                for (long i = gtid; i < (long)(M / 4) * (DRNN / 8); i += NGT) {
                    const int r4 = (int)(i / (DRNN / 8)) * 4, c8 = (int)(i % (DRNN / 8)) * 8, t0 = r4 & (SEQ - 1);
                    u32x4 xr[7];
#pragma unroll
                    for (int j = 0; j < 7; ++j) xr[j] = (t0 - 3 + j >= 0) ? *(const u32x4*)(YX + (size_t)(r4 - 3 + j) * RG_N + RG_XOFF + c8) : (u32x4){0u, 0u, 0u, 0u};
                    f32x4 w0[4], w1[4];
#pragma unroll
                    for (int j = 0; j < 4; ++j) { w0[j] = *(const f32x4*)(cw + j * DRNN + c8); w1[j] = *(const f32x4*)(cw + j * DRNN + c8 + 4); }
                    const f32x4 b0 = *(const f32x4*)(cb + c8), b1 = *(const f32x4*)(cb + c8 + 4);
#pragma unroll
                    for (int rr = 0; rr < 4; ++rr) {
                        f32x4 a0 = b0, a1 = b1;
#pragma unroll
                        for (int j = 0; j < 4; ++j) { const u32x4 xw = xr[rr + j];
                            a0 += w0[j] * (f32x4){lo_bf(xw.x), hi_bf(xw.x), lo_bf(xw.y), hi_bf(xw.y)}; a1 += w1[j] * (f32x4){lo_bf(xw.z), hi_bf(xw.z), lo_bf(xw.w), hi_bf(xw.w)}; }
                        u32x4 o; o.x = pk2(a0[0], a0[1]); o.y = pk2(a0[2], a0[3]); o.z = pk2(a1[0], a1[1]); o.w = pk2(a1[2], a1[3]);
                        *(u32x4*)(Xc + (size_t)(r4 + rr) * DRNN + c8) = o;
                    }
                }
            }
            GRID_BAR();
            {   pg8::Gemm g{WSP(bf16, RG_X), WSP(bf16, WS_W) + WE_RG_WG, M, 5376, DRNN}; pg8::GateOrder S; S.init(M, 5376, fresh_s(G), fresh_s((int)blockIdx.x));
                EpiRgGate E{WSP(bf16, RG_X), inp(P, bi + 7), WSP(float, WS_LSP), WSP(unsigned, RG_A)};
                pg8::gemm_phase<EpiRgGate, pg8::GateOrder, true, true>(lds, g, S, E, wave_s); }
            GRID_BAR();
            {
                FRESH_IDS();
                const unsigned* AB = WSP(unsigned, RG_A); float* CA = WSP(float, RG_CA); float* CB = WSP(float, RG_CB);
                for (int task = gw; task < 2 * 128 * 21; task += NGW) {
                    const int cg = task % 21, k = (task / 21) & 127, b = task / (21 * 128), ch = cg * 128 + 2 * lane;
                    const size_t o = (size_t)(b * SEQ + k * 64) * DRNN + ch; f32x2 pa = {1.f, 1.f}, hb = {0.f, 0.f};
#pragma unroll 16
                    for (int s = 0; s < 64; ++s) { const u32x2 w = *(const u32x2*)(AB + o + (size_t)s * DRNN);
                        const f32x2 a = {__builtin_amdgcn_exp2f(lo_bf(w.x)), __builtin_amdgcn_exp2f(lo_bf(w.y))}, bv = {hi_bf(w.x), hi_bf(w.y)}; hb = a * hb + bv; pa = pa * a; }
                    *(f32x2*)(CA + (size_t)(b * 128 + k) * DRNN + ch) = pa; *(f32x2*)(CB + (size_t)(b * 128 + k) * DRNN + ch) = hb;
                } }
            GRID_BAR();
            {   FRESH_IDS();
                const unsigned* AB = WSP(unsigned, RG_A); const float* CA = WSP(float, RG_CA); const float* CB = WSP(float, RG_CB);
                const bf16* YX = WSP(bf16, RG_YX); bf16* ATT = WSP(bf16, WS_ATT);
                for (int task = gw; task < 2 * 128 * 21; task += NGW) {
                    const int cg = task % 21, k = (task / 21) & 127, b = task / (21 * 128), ch = cg * 128 + 2 * lane;
                    f32x2 h = {0.f, 0.f};
                    { const size_t co = (size_t)(b * 128) * DRNN + ch;
#pragma unroll 8
                      for (int kk = 0; kk < k; ++kk) { const f32x2 ca = *(const f32x2*)(CA + co + (size_t)kk * DRNN), cb = *(const f32x2*)(CB + co + (size_t)kk * DRNN); h = ca * h + cb; } }
                    const size_t o = (size_t)(b * SEQ + k * 64) * DRNN + ch; const size_t yo = (size_t)(b * SEQ + k * 64) * RG_N + ch;
#pragma unroll 16
                    for (int s = 0; s < 64; ++s) { const u32x2 w = *(const u32x2*)(AB + o + (size_t)s * DRNN);
                        const f32x2 a = {__builtin_amdgcn_exp2f(lo_bf(w.x)), __builtin_amdgcn_exp2f(lo_bf(w.y))}, bv = {hi_bf(w.x), hi_bf(w.y)};
                        const unsigned yw = *(const unsigned*)(YX + yo + (size_t)s * RG_N);
                        h = a * h + bv;
                        *(unsigned*)(ATT + o + (size_t)s * DRNN) = pk2(h[0] * lo_bf(yw), h[1] * hi_bf(yw)); }
                } }
            GRID_BAR();
        }
        {   const int Kd = kind == 2 ? DRNN : D;
            const bf16* wt = kind == 0 ? WSP(bf16, WS_W) + (size_t)(li == 0 ? 0 : 1) * WE_NSA_SZ + WE_NSA_WOUT : kind == 1 ? WSP(bf16, WS_W) + WE_DIL_WOUT : WSP(bf16, WS_W) + WE_RG_WOUT;
            const float* x32 = li == 0 ? inp(P, IN_X) : (const float*)nullptr;
            pg8::Gemm g{WSP(bf16, WS_ATT), wt, M, D, Kd}; pg8::StaticOrder S; S.init(M, D, fresh_s(G), fresh_s((int)blockIdx.x));
            EpiRes E{x32, WSP(bf16, WS_XR), WSP(bf16, WS_XR), WSP(float, WS_MOD) + (size_t)li * 2 * 12288 + 2 * 2048};
            pg8::gemm_phase<EpiRes, pg8::StaticOrder, true, true>(lds, g, S, E, wave_s); }
        GRID_BAR();
        {   FRESH_IDS();
            const float* gain = inp(P, bi + ff_off(li)); const float* modl = WSP(float, WS_MOD) + (size_t)li * 2 * 12288; bf16* HN = WSP(bf16, WS_HN); const bf16* XR = WSP(bf16, WS_XR);
            for (int r = gw; r < M; r += NGW) { const int b = r >> 13;
                modulate_row(nullptr, XR + (size_t)r * D, gain, modl + (size_t)b * 12288 + 3 * 2048, modl + (size_t)b * 12288 + 4 * 2048, HN + (size_t)r * D, nullptr, lane); } }
        GRID_BAR();
#ifndef REP_FF1
#define REP_FF1 1
#endif
#pragma unroll 1
        for (int rep = 0; rep < fresh_s(REP_FF1); ++rep)
        {   pg8::Gemm g{WSP(bf16, WS_HN), WSP(bf16, WS_W) + WE_FF + (size_t)li * 33554432, M, DFF, D}; pg8::StaticOrder S; S.init(M, DFF, fresh_s(G), fresh_s((int)blockIdx.x));
            EpiBf16<1> E{WSP(bf16, WS_BIG), DFF, 0};
            pg8::gemm_phase<EpiBf16<1>, pg8::StaticOrder, true, true>(lds, g, S, E, wave_s); }
        GRID_BAR();
        {   pg8::Gemm g{WSP(bf16, WS_BIG), WSP(bf16, WS_W) + WE_FF + (size_t)li * 33554432 + 16777216, M, D, DFF}; pg8::StaticOrder S; S.init(M, D, fresh_s(G), fresh_s((int)blockIdx.x));
            EpiRes E{nullptr, WSP(bf16, WS_XR), WSP(bf16, WS_XR), WSP(float, WS_MOD) + (size_t)li * 2 * 12288 + 5 * 2048};
            pg8::gemm_phase<EpiRes, pg8::StaticOrder, true, true>(lds, g, S, E, wave_s); }
        GRID_BAR();
    }
    {   FRESH_IDS();
        const float* gain = inp(P, IN_NORMF); const bf16* XR = WSP(bf16, WS_XR); float* OUT = P.out;
        for (int r = gw; r < M; r += NGW) modulate_row(nullptr, XR + (size_t)r * D, gain, nullptr, nullptr, nullptr, OUT + (size_t)r * D, lane); }
}

extern "C" void kernel_launch(void* const* d_in, const int* in_sizes, int n_in, void* d_out, int out_size, void* d_ws, size_t ws_size, hipStream_t stream) {
    static int grid = 0;
    if (grid == 0) {
        if (n_in != 46 || out_size != M * D || ws_size < WS_END) { fprintf(stderr, "kernel_launch: unexpected shapes (n_in %d out %d ws %zu need %zu)\n", n_in, out_size, ws_size, (size_t)WS_END); grid = -1; return; }
        int dev = 0, cus = 0, per_cu = 0;
        if (hipGetDevice(&dev) != hipSuccess || hipDeviceGetAttribute(&cus, hipDeviceAttributeMultiprocessorCount, dev) != hipSuccess) { grid = -1; return; }
        if (hipFuncSetAttribute((const void*)mega_fwd, hipFuncAttributeMaxDynamicSharedMemorySize, LDS_BYTES) != hipSuccess) { fprintf(stderr, "kernel_launch: hipFuncSetAttribute failed\n"); grid = -1; return; }
        if (hipOccupancyMaxActiveBlocksPerMultiprocessor(&per_cu, (const void*)mega_fwd, NTHREADS, LDS_BYTES) != hipSuccess || per_cu < 1) { fprintf(stderr, "kernel_launch: occupancy query says %d\n", per_cu); }
        (void)hipGetLastError();
        grid = cus;
    }
    if (grid < 0) return;
    if (hipMemsetAsync((char*)d_ws + WS_CTL, 0, CTL_ZERO_BYTES, stream) != hipSuccess) return;
    Params p{};
    for (int i = 0; i < 46; ++i) p.in[i] = (const float*)d_in[i];
    p.out = (float*)d_out; p.ws = (unsigned char*)d_ws;
    hipLaunchKernelGGL(mega_fwd, dim3(grid), dim3(NTHREADS), LDS_BYTES, stream, p);
}
```

```cpp
#include <hip/hip_runtime.h>
#include <cstdio>
#include <cstdint>

#define GAS __attribute__((address_space(1)))
#define LAS __attribute__((address_space(3)))
typedef unsigned short bf16;
typedef float f32x4 __attribute__((ext_vector_type(4)));
typedef float f32x2 __attribute__((ext_vector_type(2)));
typedef unsigned u32x4 __attribute__((ext_vector_type(4)));
typedef unsigned u32x2 __attribute__((ext_vector_type(2)));
#define LDS_WAIT() asm volatile("s_waitcnt lgkmcnt(0)" ::: "memory")
__device__ __forceinline__ int fresh_s(int v) { asm volatile("" : "+s"(v)); return v; }
__device__ __forceinline__ int lane_id_asm() { int l; asm volatile("v_mbcnt_lo_u32_b32 %0, -1, 0\n\tv_mbcnt_hi_u32_b32 %0, -1, %0" : "=v"(l)); return l; }

namespace pg8 {
#define PG8_LAS __attribute__((address_space(3)))
typedef unsigned short bf16_t;
typedef short bf16x8 __attribute__((ext_vector_type(8)));
constexpr int BM = 256, BK = 64, HALF = 128, HTB = HALF * BK * 2, STAGE_BYTES = 8 * HTB, NXCD = 8, WGM = 8;
__host__ __device__ __forceinline__ int lds_byte(int r, int c) { const int st = (r >> 4) * 2 + (c >> 5), rr = r & 15, cc = c & 31, ob = rr * 64 + cc * 2; return st * 1024 + (ob ^ (((ob >> 9) & 1) << 5)); }
__host__ __device__ __forceinline__ void stage_rc(int b, int& R, int& C) { const int st = b / 1024, sb = b % 1024, swz = sb ^ (((sb >> 9) & 1) << 5); R = (st >> 1) * 16 + swz / 64; C = (st & 1) * 32 + (swz % 64) / 2; }
__host__ __device__ __forceinline__ int perm32(int rho) { const int n = rho >> 4, i = rho & 15; return 8 * (i >> 2) + 4 * n + (i & 3); }
struct Unit { int pm, pn; };
struct Gemm { const bf16_t* A; const bf16_t* Bt; int M, N, K; int dshA, dshB; };
__device__ __forceinline__ long rowbase(int p, int dsh) { const int i0 = p * 256; if (dsh == 0) return i0; const int b = i0 >> 13, rem = i0 & 8191, sh = 13 - dsh; return (long)(b << 13) + ((rem & ((1 << sh) - 1)) << dsh) + (rem >> sh); }
struct StaticOrder {
    int nM, nN, nwg, G, c;
    __host__ __device__ void init(int M, int N, int G_, int c_) { nM = M / BM; nN = N / BM; nwg = nM * nN; G = G_; c = c_; }
    __host__ __device__ bool next(int i, Unit& u) const {
        const long L = (long)i * G + c; if (L >= nwg) return false;
        int wgid = (int)L; { const int q = nwg / NXCD, r = nwg % NXCD, xcd = wgid % NXCD, off = wgid / NXCD; wgid = (xcd < r ? xcd * (q + 1) : r * (q + 1) + (xcd - r) * q) + off; }
        const int nig = WGM * nN, gid = wgid / nig, fm = gid * WGM, gsz = (nM - fm) < WGM ? (nM - fm) : WGM;
        u.pm = fm + ((wgid % nig) % gsz); u.pn = (wgid % nig) / gsz; return true;
    }
    __device__ __forceinline__ void a_ready(const Unit&) const {}
    __device__ __forceinline__ void done(const Unit&) const {}
    __device__ __forceinline__ void krange(const Unit&, int K, int& kbeg, int& nt) const { kbeg = 0; nt = K / BK; }
};
struct GateOrder : StaticOrder {
    __device__ __forceinline__ void krange(const Unit& u, int K, int& kbeg, int& nt) const {
        const int c0 = u.pn * 128, nb0 = c0 / 168, nb1 = (c0 + 127) / 168;
        kbeg = (nb0 * 168) & ~127; int kend = ((nb1 + 1) * 168 + 127) & ~127; if (kend > K) kend = K;
        nt = (kend - kbeg) / BK; }
};
__device__ __forceinline__ unsigned cvt_pk_bf16(float lo, float hi) { unsigned r; asm volatile("v_cvt_pk_bf16_f32 %0, %1, %2" : "=v"(r) : "v"(lo), "v"(hi)); return r; }

template <class Epi, class Sched, bool ALIGN_EPI = false, bool SP2 = false>
__device__ __forceinline__ void gemm_phase(PG8_LAS unsigned char* lds, const Gemm g, const Sched& S, const Epi& E, int wid_in) {
    int wid = wid_in; asm volatile("" : "+s"(wid));
    const int lane = lane_id_asm(), tid = wid * 64 + lane, wr = wid >> 2, wc = wid & 3, fr = lane & 15, fq = lane >> 4;
    const int K = g.K;
    unsigned voffA[2], voffB[2];
#pragma unroll
    for (int i = 0; i < 2; ++i) { int R, C; stage_rc(tid * 16 + i * 8192, R, C); const int Rb = Epi::PERM ? ((R & ~31) + perm32(R & 31)) : R;
        voffA[i] = (unsigned)((R << g.dshA) * K + C) * 2u; voffB[i] = (unsigned)((Rb << g.dshB) * K + C) * 2u; }
    const size_t kstep = (size_t)(BK * 2);
    const size_t hstepA = (size_t)(HALF << g.dshA) * K * 2, hstepB = (size_t)(HALF << g.dshB) * K * 2;
#define PG8_BASEA(u) ((const char*)g.A + (size_t)rowbase((u).pm, g.dshA) * K * 2)
#define PG8_BASEB(u) ((const char*)g.Bt + (size_t)rowbase((u).pn, g.dshB) * K * 2)
    const unsigned ldsw = (unsigned)wid * 1024u;
    const int aoff = lds_byte(wr * 64 + fr, fq * 8), boff = lds_byte(wc * 32 + fr, fq * 8);
#define PG8_SA(b, h) (((b) * 2 + (h)) * HTB)
#define PG8_SB(b, h) ((4 + (b) * 2 + (h)) * HTB)
#define PG8_STAGE(bufoff, gbase, voff) do { _Pragma("unroll") for (int _i = 0; _i < 2; ++_i) \
        __builtin_amdgcn_global_load_lds((const unsigned*)((const char*)(gbase) + (voff)[_i]), (PG8_LAS unsigned*)(lds + (bufoff) + ldsw + _i * 8192), 16, 0, 0); } while (0)
#define PG8_LDA(dst, b, h) do { _Pragma("unroll") for (int m = 0; m < 4; ++m) _Pragma("unroll") for (int k = 0; k < 2; ++k) dst[m][k] = *(const PG8_LAS bf16x8*)(lds + PG8_SA(b, h) + aoff + m * 2048 + k * 1024); } while (0)
#define PG8_LDB(dst, b, h) do { _Pragma("unroll") for (int n = 0; n < 2; ++n) _Pragma("unroll") for (int k = 0; k < 2; ++k) dst[n][k] = *(const PG8_LAS bf16x8*)(lds + PG8_SB(b, h) + boff + n * 2048 + k * 1024); } while (0)
#define PG8_MMA(ai, bj, At, Bt) do { __builtin_amdgcn_s_setprio(1); _Pragma("unroll") for (int m = 0; m < 4; ++m) _Pragma("unroll") for (int n = 0; n < 2; ++n) _Pragma("unroll") for (int k = 0; k < 2; ++k) \
        acc[ai][bj][m][n] = __builtin_amdgcn_mfma_f32_16x16x32_bf16(Bt[n][k], At[m][k], acc[ai][bj][m][n], 0, 0, 0); __builtin_amdgcn_s_setprio(0); } while (0)
#define PG8_WAIT_V(n) asm volatile("s_waitcnt vmcnt(" #n ")" ::: "memory")
#define PG8_WAIT_L(n) asm volatile("s_waitcnt lgkmcnt(" #n ")" ::: "memory")
#define PG8_BAR __builtin_amdgcn_s_barrier()
#define PG8_SCHED __builtin_amdgcn_sched_barrier(0)
    Unit cur, nxt; int ui = 0;
    if (!S.next(0, cur)) return;
    f32x4 acc[2][2][4][2];
#pragma unroll
    for (int a = 0; a < 2; ++a)
#pragma unroll
        for (int b = 0; b < 2; ++b)
#pragma unroll
            for (int m = 0; m < 4; ++m)
#pragma unroll
                for (int n = 0; n < 2; ++n) acc[a][b][m][n] = (f32x4){0.f, 0.f, 0.f, 0.f};
    bf16x8 At[4][2], B0[2][2], B1[2][2];
    int kb_cur, nt; S.krange(cur, K, kb_cur, nt);
    const char* cA = PG8_BASEA(cur) + (size_t)kb_cur * 2; const char* cB = PG8_BASEB(cur) + (size_t)kb_cur * 2;
    S.a_ready(cur);
    if constexpr (SP2) {
        PG8_STAGE(PG8_SB(0, 0), cB, voffB); PG8_STAGE(PG8_SB(0, 1), cB + hstepB, voffB); PG8_STAGE(PG8_SA(0, 0), cA, voffA); PG8_STAGE(PG8_SA(0, 1), cA + hstepA, voffA);
        if (wr == 1) PG8_BAR;
        PG8_WAIT_V(2); PG8_BAR;
        PG8_STAGE(PG8_SB(1, 0), cB + kstep, voffB); PG8_STAGE(PG8_SA(1, 0), cA + kstep, voffA); PG8_STAGE(PG8_SB(1, 1), cB + hstepB + kstep, voffB);
        PG8_WAIT_V(6); PG8_BAR;
    } else {
        PG8_STAGE(PG8_SB(0, 0), cB, voffB); PG8_STAGE(PG8_SA(0, 0), cA, voffA); PG8_STAGE(PG8_SB(0, 1), cB + hstepB, voffB); PG8_STAGE(PG8_SA(0, 1), cA + hstepA, voffA);
        if (wr == 1) PG8_BAR;
        PG8_WAIT_V(4); PG8_BAR;
        PG8_STAGE(PG8_SB(1, 0), cB + kstep, voffB); PG8_STAGE(PG8_SA(1, 0), cA + kstep, voffA); PG8_STAGE(PG8_SB(1, 1), cB + hstepB + kstep, voffB);
        PG8_WAIT_V(6); PG8_BAR;
    }
    for (;;) {
        const bool has_next = S.next(ui + 1, nxt);
        int kb_nxt = 0, nt_nxt = nt; if (has_next) S.krange(nxt, K, kb_nxt, nt_nxt);
        const char* nA = has_next ? PG8_BASEA(nxt) + (size_t)kb_nxt * 2 : cA; const char* nB = has_next ? PG8_BASEB(nxt) + (size_t)kb_nxt * 2 : cB;
        for (int t = 0; t < nt; t += 2) {
            const bool last = (t == nt - 2);
            const char* a1 = cA + (size_t)(t + 1) * kstep;
            const char* a2 = last ? nA : cA + (size_t)(t + 2) * kstep; const char* b2 = last ? nB : cB + (size_t)(t + 2) * kstep;
            const char* a3 = a2 + kstep; const char* b3 = b2 + kstep;
            if (last && has_next) S.a_ready(nxt);
            if constexpr (SP2) {
            PG8_LDB(B0, 0, 0); PG8_LDB(B1, 0, 1); PG8_SCHED; PG8_LDA(At, 0, 0); PG8_STAGE(PG8_SA(1, 1), a1 + hstepA, voffA);
            PG8_WAIT_V(8); PG8_WAIT_L(0); PG8_BAR; PG8_MMA(0, 0, At, B0); PG8_MMA(0, 1, At, B1); PG8_BAR; PG8_SCHED;
            PG8_LDA(At, 0, 1); PG8_STAGE(PG8_SB(0, 0), b2, voffB); PG8_STAGE(PG8_SB(0, 1), b2 + hstepB, voffB); PG8_STAGE(PG8_SA(0, 0), a2, voffA);
            PG8_WAIT_V(8); PG8_WAIT_L(0); PG8_BAR; PG8_MMA(1, 0, At, B0); PG8_MMA(1, 1, At, B1); PG8_BAR; PG8_SCHED;
            PG8_LDB(B0, 1, 0); PG8_LDB(B1, 1, 1); PG8_SCHED; PG8_LDA(At, 1, 0); PG8_STAGE(PG8_SA(0, 1), a2 + hstepA, voffA);
            PG8_WAIT_V(8); PG8_WAIT_L(0); PG8_BAR; PG8_MMA(0, 0, At, B0); PG8_MMA(0, 1, At, B1); PG8_BAR; PG8_SCHED;
            PG8_LDA(At, 1, 1); PG8_STAGE(PG8_SB(1, 0), b3, voffB); PG8_STAGE(PG8_SB(1, 1), b3 + hstepB, voffB); PG8_STAGE(PG8_SA(1, 0), a3, voffA);
            PG8_WAIT_V(8); PG8_WAIT_L(0); PG8_BAR; PG8_MMA(1, 0, At, B0); PG8_MMA(1, 1, At, B1); PG8_BAR; PG8_SCHED;
            } else {
            PG8_LDB(B0, 0, 0); PG8_SCHED; PG8_LDA(At, 0, 0); PG8_STAGE(PG8_SA(1, 1), a1 + hstepA, voffA);
            PG8_WAIT_L(8); PG8_BAR; PG8_WAIT_L(0); PG8_MMA(0, 0, At, B0); PG8_BAR; PG8_SCHED;
            PG8_LDB(B1, 0, 1); PG8_STAGE(PG8_SB(0, 0), b2, voffB);
            PG8_BAR; PG8_WAIT_L(0); PG8_MMA(0, 1, At, B1); PG8_BAR;
            PG8_LDA(At, 0, 1); PG8_STAGE(PG8_SA(0, 0), a2, voffA);
            PG8_BAR; PG8_WAIT_L(0); PG8_MMA(1, 0, At, B0); PG8_BAR; PG8_SCHED;
            PG8_STAGE(PG8_SB(0, 1), b2 + hstepB, voffB);
            PG8_WAIT_V(6); PG8_BAR; PG8_MMA(1, 1, At, B1); PG8_BAR;
            PG8_LDB(B0, 1, 0); PG8_SCHED; PG8_LDA(At, 1, 0); PG8_STAGE(PG8_SA(0, 1), a2 + hstepA, voffA);
            PG8_WAIT_L(8); PG8_BAR; PG8_WAIT_L(0); PG8_MMA(0, 0, At, B0); PG8_BAR; PG8_SCHED;
            PG8_LDB(B1, 1, 1); PG8_STAGE(PG8_SB(1, 0), b3, voffB);
            PG8_BAR; PG8_WAIT_L(0); PG8_MMA(0, 1, At, B1); PG8_BAR;
            PG8_LDA(At, 1, 1); PG8_STAGE(PG8_SA(1, 0), a3, voffA);
            PG8_BAR; PG8_WAIT_L(0); PG8_MMA(1, 0, At, B0); PG8_BAR; PG8_SCHED;
            PG8_STAGE(PG8_SB(1, 1), b3 + hstepB, voffB);
            PG8_WAIT_V(6); PG8_BAR; PG8_MMA(1, 1, At, B1); PG8_BAR;
            }
        }
        if constexpr (ALIGN_EPI) { if (wr == 0) PG8_BAR; }
        E(acc, cur, wr, wc, fr, fq); S.done(cur);
        if (!has_next) break;
#pragma unroll
        for (int a = 0; a < 2; ++a)
#pragma unroll
            for (int b = 0; b < 2; ++b)
#pragma unroll
                for (int m = 0; m < 4; ++m)
#pragma unroll
                    for (int n = 0; n < 2; ++n) acc[a][b][m][n] = (f32x4){0.f, 0.f, 0.f, 0.f};
        cur = nxt; cA = nA; cB = nB; nt = nt_nxt; ++ui;
        if constexpr (ALIGN_EPI) { if (wr == 1) PG8_BAR; }
    }
    PG8_WAIT_V(0);
    if constexpr (!ALIGN_EPI) { if (wr == 0) PG8_BAR; }
    PG8_BAR;
#undef PG8_BASEA
#undef PG8_BASEB
#undef PG8_SA
#undef PG8_SB
#undef PG8_STAGE
#undef PG8_LDA
#undef PG8_LDB
#undef PG8_MMA
#undef PG8_WAIT_V
#undef PG8_WAIT_L
#undef PG8_BAR
#undef PG8_SCHED
}
}

#define XB_TMO      128
#define XB_XCNT(j)  (256  + 64 * (j))
#define XB_XSUB(j)  (1280 + 64 * (j))
#define XB_XGEN(j)  (2304 + 64 * (j))
#define XB_TOP      3328
#define XB_TOPGEN   3392
#define XCD_BAR_WORDS 3456
#define XB_SPIN_CAP (1u << 22)
__device__ __forceinline__ unsigned xb_ld(unsigned* p)              { return __hip_atomic_load(p, __ATOMIC_RELAXED, __HIP_MEMORY_SCOPE_AGENT); }
__device__ __forceinline__ unsigned xb_add(unsigned* p, unsigned v) { return __hip_atomic_fetch_add(p, v, __ATOMIC_RELAXED, __HIP_MEMORY_SCOPE_AGENT); }
__device__ __forceinline__ unsigned xb_xcc_id() { return (unsigned)__builtin_amdgcn_s_getreg((3 << 11) | 20) & 0xFu; }
#define XB_SPIN(cond, bar) do { unsigned _sp = 0; while (cond) { __builtin_amdgcn_s_sleep(1); \
    if ((++_sp & 255u) == 0u) { if (xb_ld(&(bar)[XB_TMO])) break; if (_sp > XB_SPIN_CAP) { atomicAdd(&(bar)[XB_TMO], 1u); break; } } } } while (0)
struct XcdBarrier { unsigned* bar; unsigned x; volatile LAS unsigned* st; int wave; };
__device__ __forceinline__ XcdBarrier xcd_barrier_post(unsigned* bar, volatile LAS unsigned* st) {
    XcdBarrier b; b.bar = bar; b.x = xb_xcc_id(); b.st = st;
    if (threadIdx.x == 0) (void)xb_add(&bar[XB_XCNT(b.x)], 1u);
    return b;
}
__device__ __forceinline__ void xcd_barrier_complete(unsigned* bar, unsigned x, unsigned& nloc, unsigned& nx) {
    const unsigned G = gridDim.x * gridDim.y * gridDim.z;
    unsigned sum, cnt, mine, sp = 0u;
    for (;;) {
        sum = 0u; cnt = 0u; mine = 0u;
#pragma unroll
        for (unsigned j = 0; j < 16; ++j) { const unsigned c = xb_ld(&bar[XB_XCNT(j)]); sum += c; cnt += (c > 0u) ? 1u : 0u; mine = (j == x) ? c : mine; }
        if (sum == G) break;
        __builtin_amdgcn_s_sleep(1);
        if ((++sp & 255u) == 0u) { if (xb_ld(&bar[XB_TMO])) break; if (sp > XB_SPIN_CAP) { atomicAdd(&bar[XB_TMO], 1u); break; } }
    }
    nloc = mine > 0u ? mine : 1u; nx = cnt > 0u ? cnt : 1u;
}
__device__ __forceinline__ void xcd_barrier(const XcdBarrier& b) {
    asm volatile("s_waitcnt vmcnt(0)" ::: "memory");
    __syncthreads();
    if (b.wave == 0 && lane_id_asm() == 0) {
        unsigned* bar = b.bar; unsigned bx = b.x;
        asm volatile("" : "+s"(bar), "+s"(bx));
        __builtin_amdgcn_s_waitcnt(0);
        unsigned nloc = b.st[0], nx = b.st[1];
        if (nloc == 0u) { xcd_barrier_complete(bar, bx, nloc, nx); b.st[0] = nloc; b.st[1] = nx; }
        const unsigned old = xb_add(&bar[XB_XSUB(bx)], 1u);
        const unsigned gen = old / nloc;
        if (old + 1u == (gen + 1u) * nloc) {
            __builtin_amdgcn_fence(__ATOMIC_RELEASE, "agent");
            asm volatile("s_waitcnt vmcnt(0)" ::: "memory");
            const unsigned og = xb_add(&bar[XB_TOP], 1u);
            const unsigned tg = og / nx;
            if (og + 1u == (tg + 1u) * nx) xb_add(&bar[XB_TOPGEN], 1u);
            else XB_SPIN(xb_ld(&bar[XB_TOPGEN]) == tg, bar);
            __builtin_amdgcn_fence(__ATOMIC_ACQUIRE, "agent");
            xb_add(&bar[XB_XGEN(bx)], 1u);
            asm volatile("s_waitcnt vmcnt(0)" ::: "memory");
        } else {
            XB_SPIN(xb_ld(&bar[XB_XGEN(bx)]) == gen, bar);
            __builtin_amdgcn_fence(__ATOMIC_ACQUIRE, "agent");
            asm volatile("s_waitcnt vmcnt(0)" ::: "memory");
        }
    }
    __syncthreads();
}

constexpr int D = 2048, SEQ = 8192, M = 16384, DFF = 8192;
constexpr int NSA_N = 5376;
constexpr int NSA_N1 = 4096;
constexpr int DIL_N = 18432;
constexpr int DRNN = 2688, RG_N = 5632;
constexpr int RG_XOFF = 2816;
constexpr int NWAVES = 8, NTHREADS = 512;
constexpr int LDV = M + 64;
constexpr float ATT_SCALE = 0.08838834764831845f;
constexpr float NORM_EPS = 1e-6f;

constexpr int IN_X = 0, IN_C = 1, IN_NORMF = 45;
__host__ __device__ __forceinline__ constexpr int layer_base(int li) { return li == 0 ? 2 : li == 1 ? 13 : li == 2 ? 21 : 34; }
__host__ __device__ __forceinline__ constexpr int ff_off(int li) { return li == 1 ? 5 : li == 2 ? 10 : 8; }
__host__ __device__ __forceinline__ constexpr int wout_off(int li) { return li == 1 ? 4 : li == 2 ? 9 : 7; }

constexpr size_t MiB = 1u << 20;
constexpr size_t WS_CTL = 0, CTL_ZERO_BYTES = 1 * MiB;
constexpr size_t WS_MODP = 1 * MiB;
constexpr size_t WS_MOD = 4 * MiB;
constexpr size_t WS_COS = 5 * MiB, WS_SIN = 7 * MiB;
constexpr size_t WS_BPEP = 9 * MiB;
constexpr size_t WS_BPE = 9 * MiB + 512 * 1024;
constexpr size_t WS_LSP = 9 * MiB + 768 * 1024;
constexpr size_t WS_W = 10 * MiB;
constexpr size_t WE_NSA_WIN = 0, WE_NSA_W1 = 11010048, WE_NSA_WOUT = 11010048 + 4194304, WE_NSA_SZ = 19398656;
constexpr size_t WE_DIL = 2 * WE_NSA_SZ, WE_DIL_WOUT = WE_DIL + 37748736;
constexpr size_t WE_RG = WE_DIL + 41943040, WE_RG_WG = WE_RG + 11534336, WE_RG_WOUT = WE_RG_WG + 14450688;
constexpr size_t WE_FF = WE_RG + 31490048;
constexpr size_t WE_END = WE_FF + 4 * (size_t)33554432;
static_assert(WE_END == 246448128, "weight map");
constexpr size_t WS_HN = 482 * MiB;
constexpr size_t WS_ATT = 546 * MiB;
constexpr size_t WS_XR = 630 * MiB;
constexpr size_t WS_BIG = 694 * MiB;
static_assert(WS_W + WE_END * 2 <= WS_HN, "ws map");
constexpr size_t NS_Q = WS_BIG, NS_QR = NS_Q + 64 * MiB, NS_PK = NS_QR + 64 * MiB, NS_PV = NS_PK + 16 * MiB, NS_KS = NS_PV + 16 * MiB, NS_KW = NS_KS + 16 * MiB,
                 NS_VT = NS_KW + 16 * MiB  , NS_GT = NS_VT + 34 * MiB, NS_HC = NS_GT + 4 * MiB, NS_KC = NS_HC + 32 * MiB  ,
                 NS_VCT = NS_KC + 1 * MiB  , NS_END = NS_VCT + 1 * MiB;
constexpr size_t RG_YX = WS_BIG, RG_X = RG_YX + 176 * MiB, RG_A = RG_X + 84 * MiB, RG_B = RG_A + 168 * MiB, RG_CA = RG_B + 168 * MiB, RG_CB = RG_CA + 3 * MiB;
constexpr size_t DL_QK = WS_BIG, DL_VT = WS_BIG + 384 * MiB, DL_VT_STRIDE = 66 * MiB, DL_ML = WS_BIG + 582 * MiB;
constexpr size_t WS_END = WS_BIG + 610 * MiB;
static_assert(RG_CB + 3 * MiB <= WS_END && NS_END <= WS_END && DL_ML + 2 * MiB <= WS_END && WS_END <= (size_t)1396 * MiB, "ws map");

constexpr int RING_BYTES = 147456, MISC_OFF = RING_BYTES + 320, LDS_BYTES = 163840;

struct Params { const float* in[46]; float* out; unsigned char* ws; };

__device__ __forceinline__ float lo_bf(unsigned w) { return __uint_as_float(w << 16); }
__device__ __forceinline__ float hi_bf(unsigned w) { return __uint_as_float(w & 0xffff0000u); }
__device__ __forceinline__ unsigned pk2(float lo, float hi) { return pg8::cvt_pk_bf16(lo, hi); }
__device__ __forceinline__ float wave_sum(float v) {
#pragma unroll
    for (int o = 1; o < 64; o <<= 1) v += __shfl_xor(v, o);
    return v;
}
__device__ __forceinline__ float wave_max(float v) {
#pragma unroll
    for (int o = 1; o < 64; o <<= 1) v = fmaxf(v, __shfl_xor(v, o));
    return v;
}
__device__ __forceinline__ float sigmoidf_(float x) { return 1.0f / (1.0f + __expf(-x)); }
__device__ __forceinline__ float gelu_tanh(float x) { const float u = 0.7978845608028654f * (x + 0.044715f * x * x * x); const float e = __expf(2.0f * u); return 0.5f * x * (2.0f - 2.0f / (e + 1.0f)); }
__device__ __forceinline__ int sigma_d(int pos) { return (pos & 1) * 64 + (pos >> 1); }
__device__ __forceinline__ void store8_bf16(bf16* p, const f32x4 v0, const f32x4 v1) {
    u32x4 w; w.x = pk2(v0[0], v0[1]); w.y = pk2(v0[2], v0[3]); w.z = pk2(v1[0], v1[1]); w.w = pk2(v1[2], v1[3]); *(u32x4*)p = w; }
__device__ __forceinline__ void rope8(f32x4& v0, f32x4& v1, const float* cosr, const float* sinr, int i0) {
    const f32x4 cs = *(const f32x4*)(cosr + i0), sn = *(const f32x4*)(sinr + i0);
    const f32x4 a = v0, b = v1;
    v0[0] = a[0] * cs[0] - a[1] * sn[0]; v0[1] = a[0] * sn[0] + a[1] * cs[0];
    v0[2] = a[2] * cs[1] - a[3] * sn[1]; v0[3] = a[2] * sn[1] + a[3] * cs[1];
    v1[0] = b[0] * cs[2] - b[1] * sn[2]; v1[1] = b[0] * sn[2] + b[1] * cs[2];
    v1[2] = b[2] * cs[3] - b[3] * sn[3]; v1[3] = b[2] * sn[3] + b[3] * cs[3];
}

__device__ __forceinline__ void rope8v(f32x4& v0, f32x4& v1, const f32x4 cs, const f32x4 sn) {
    const f32x4 a = v0, b = v1;
    v0[0] = a[0] * cs[0] - a[1] * sn[0]; v0[1] = a[0] * sn[0] + a[1] * cs[0];
    v0[2] = a[2] * cs[1] - a[3] * sn[1]; v0[3] = a[2] * sn[1] + a[3] * cs[1];
    v1[0] = b[0] * cs[2] - b[1] * sn[2]; v1[1] = b[0] * sn[2] + b[1] * cs[2];
    v1[2] = b[2] * cs[3] - b[3] * sn[3]; v1[3] = b[2] * sn[3] + b[3] * cs[3];
}
#define EPI_LOOP_ROWS for (int ai = 0; ai < 2; ++ai) _Pragma("unroll") for (int m = 0; m < 4; ++m)
struct EpiNsaIn {
    static constexpr bool PERM = true, AFTER_DRAIN = false;
    bf16 *Q, *QR, *PK, *PV, *KS, *KW; float* GT; const float *COS, *SIN;
    __device__ __forceinline__ void operator()(const f32x4 (&acc)[2][2][4][2], const pg8::Unit& u, int wr, int wc, int fr, int fq) const {
        const int pn = u.pn, row0 = u.pm * 256 + wr * 64 + fr, cl = wc * 32 + 8 * fq;
        const bool rot = pn < 8 || pn >= 12;
#pragma unroll
        for (int ai = 0; ai < 2; ++ai) {
            f32x4 cs[4], sn[4];
            if (rot) {
#pragma unroll
                for (int m = 0; m < 4; ++m) { const int t = (row0 + ai * 128 + m * 16) & (SEQ - 1); cs[m] = *(const f32x4*)(COS + (size_t)t * 64 + (cl >> 1)); sn[m] = *(const f32x4*)(SIN + (size_t)t * 64 + (cl >> 1)); } }
#pragma unroll
            for (int m = 0; m < 4; ++m) {
                const int row = row0 + ai * 128 + m * 16, t = row & (SEQ - 1), b = row >> 13;
#pragma unroll
                for (int bj = 0; bj < 2; ++bj) {
                    f32x4 v0 = acc[ai][bj][m][0], v1 = acc[ai][bj][m][1];
                    const int hh = (pn & 1) * 2 + bj;
                    if (pn < 8) {
                        const size_t o = (size_t)row * 2048 + pn * 256 + bj * 128 + cl;
                        store8_bf16(Q + o, v0, v1);
                        rope8v(v0, v1, cs[m], sn[m]);
                        store8_bf16(QR + o, v0, v1);
                    } else if (pn < 12) {
                        bf16* P = pn < 10 ? PK : PV;
                        const size_t o = ((size_t)((b * 4 + hh) * 512 + (t >> 4))) * 2048 + (t & 15) * 128 + cl;
                        store8_bf16(P + o, v0, v1);
                    } else {
                        bf16* P = pn < 14 ? KS : KW;
                        rope8v(v0, v1, cs[m], sn[m]);
                        store8_bf16(P + (size_t)row * 512 + hh * 128 + cl, v0, v1);
                    }
                }
            }
        }
    }
};
struct EpiGates {
    static constexpr bool PERM = true, AFTER_DRAIN = false;
    float* GT;
    __device__ __forceinline__ void operator()(const f32x4 (&acc)[2][2][4][2], const pg8::Unit& u, int wr, int wc, int fr, int fq) const {
        const int row0 = u.pm * 256 + wr * 64 + fr, cl = wc * 32 + 8 * fq;
        if (cl < 48) {
#pragma unroll
            EPI_LOOP_ROWS { const int row = row0 + ai * 128 + m * 16; const f32x4 v0 = acc[ai][0][m][0], v1 = acc[ai][0][m][1];
#pragma unroll
                for (int e = 0; e < 4; ++e) { GT[(size_t)row * 48 + cl + e] = sigmoidf_(v0[e]); GT[(size_t)row * 48 + cl + 4 + e] = sigmoidf_(v1[e]); } }
        }
    }
};
struct EpiDilQK {
    static constexpr bool PERM = true, AFTER_DRAIN = false;
    bf16* O; const float *COS, *SIN; int dsh;
    __device__ __forceinline__ void operator()(const f32x4 (&acc)[2][2][4][2], const pg8::Unit& u, int wr, int wc, int fr, int fq) const {
        const int pn = u.pn, row0 = u.pm * 256 + wr * 64 + fr, cl = wc * 32 + 8 * fq, sh = 13 - dsh;
#pragma unroll
        for (int ai = 0; ai < 2; ++ai) {
            f32x4 cs[4], sn[4];
#pragma unroll
            for (int m = 0; m < 4; ++m) { const int row = row0 + ai * 128 + m * 16, rem = row & (SEQ - 1), t = ((rem & ((1 << sh) - 1)) << dsh) + (rem >> sh);
                cs[m] = *(const f32x4*)(COS + (size_t)t * 64 + (cl >> 1)); sn[m] = *(const f32x4*)(SIN + (size_t)t * 64 + (cl >> 1)); }
#pragma unroll
            for (int m = 0; m < 4; ++m) { const int row = row0 + ai * 128 + m * 16;
#pragma unroll
                for (int bj = 0; bj < 2; ++bj) {
                    f32x4 v0 = acc[ai][bj][m][0], v1 = acc[ai][bj][m][1];
                    rope8v(v0, v1, cs[m], sn[m]);
                    store8_bf16(O + (size_t)row * 4096 + pn * 256 + bj * 128 + cl, v0, v1);
                } }
        }
    }
};
template <int ACT> struct EpiBf16 {
    static constexpr bool PERM = true, AFTER_DRAIN = false;
    bf16* O; int ldc; int act_tiles;
    __device__ __forceinline__ void operator()(const f32x4 (&acc)[2][2][4][2], const pg8::Unit& u, int wr, int wc, int fr, int fq) const {
        const int pn = u.pn, row0 = u.pm * 256 + wr * 64 + fr, cl = wc * 32 + 8 * fq;
        const bool act = pn < act_tiles;
#pragma unroll
        EPI_LOOP_ROWS {
            const int row = row0 + ai * 128 + m * 16;
#pragma unroll
            for (int bj = 0; bj < 2; ++bj) {
                f32x4 v0 = acc[ai][bj][m][0], v1 = acc[ai][bj][m][1];
                if (ACT == 1) {
#pragma unroll
                    for (int e = 0; e < 4; ++e) { const float a = fmaxf(v0[e], 0.f), c = fmaxf(v1[e], 0.f); v0[e] = a * a; v1[e] = c * c; }
                }
                if (ACT == 2) { if (act) {
#pragma unroll
                    for (int e = 0; e < 4; ++e) { v0[e] = gelu_tanh(v0[e]); v1[e] = gelu_tanh(v1[e]); } } }
                store8_bf16(O + (size_t)row * ldc + pn * 256 + bj * 128 + cl, v0, v1);
            }
        }
    }
};
struct EpiF32 {
    static constexpr bool PERM = false, AFTER_DRAIN = false;
    float* C; int ldc;
    __device__ __forceinline__ void operator()(const f32x4 (&acc)[2][2][4][2], const pg8::Unit& u, int wr, int wc, int fr, int fq) const {
        const int row0 = u.pm * 256 + wr * 64 + fr, col0 = u.pn * 256 + wc * 32 + 4 * fq;
#pragma unroll
        EPI_LOOP_ROWS {
            float* rowp = C + (size_t)(row0 + ai * 128 + m * 16) * ldc + col0;
#pragma unroll
            for (int bj = 0; bj < 2; ++bj)
#pragma unroll
                for (int n = 0; n < 2; ++n) *(f32x4*)(rowp + bj * 128 + n * 16) = acc[ai][bj][m][n];
        }
    }
};
struct EpiRes {
    static constexpr bool PERM = true, AFTER_DRAIN = false;
    const float* xin32; const bf16* xin16; bf16* out; const float* gate;
    __device__ __forceinline__ void operator()(const f32x4 (&acc)[2][2][4][2], const pg8::Unit& u, int wr, int wc, int fr, int fq) const {
        const int row0 = u.pm * 256 + wr * 64 + fr, cl = wc * 32 + 8 * fq, b = (u.pm * 256) >> 13;
        f32x4 g0[2], g1[2];
#pragma unroll
        for (int bj = 0; bj < 2; ++bj) { const float* gp = gate + (size_t)b * 12288 + u.pn * 256 + bj * 128 + cl; g0[bj] = *(const f32x4*)gp; g1[bj] = *(const f32x4*)(gp + 4); }
#pragma unroll
        for (int ai = 0; ai < 2; ++ai) {
            f32x4 x0[4][2], x1[4][2];
#pragma unroll
            for (int m = 0; m < 4; ++m)
#pragma unroll
                for (int bj = 0; bj < 2; ++bj) { const size_t o = (size_t)(row0 + ai * 128 + m * 16) * D + u.pn * 256 + bj * 128 + cl;
                    if (xin32) { x0[m][bj] = *(const f32x4*)(xin32 + o); x1[m][bj] = *(const f32x4*)(xin32 + o + 4); }
                    else { const u32x4 w = *(const u32x4*)(xin16 + o); x0[m][bj] = (f32x4){lo_bf(w.x), hi_bf(w.x), lo_bf(w.y), hi_bf(w.y)}; x1[m][bj] = (f32x4){lo_bf(w.z), hi_bf(w.z), lo_bf(w.w), hi_bf(w.w)}; } }
#pragma unroll
            for (int m = 0; m < 4; ++m)
#pragma unroll
                for (int bj = 0; bj < 2; ++bj) store8_bf16(out + (size_t)(row0 + ai * 128 + m * 16) * D + u.pn * 256 + bj * 128 + cl, x0[m][bj] + g0[bj] * acc[ai][bj][m][0], x1[m][bj] + g1[bj] * acc[ai][bj][m][1]);
        }
    }
};
struct EpiRgGate {
    static constexpr bool PERM = true, AFTER_DRAIN = false;
    const bf16* X; const float *bgate, *LSP; unsigned* AB;
    __device__ __forceinline__ void operator()(const f32x4 (&acc)[2][2][4][2], const pg8::Unit& u, int wr, int wc, int fr, int fq) const {
        const int row0 = u.pm * 256 + wr * 64 + fr, ch0 = u.pn * 128 + wc * 32 + 8 * fq;
        u32x4 xw[2][4];
#pragma unroll
        for (int ai = 0; ai < 2; ++ai)
#pragma unroll
            for (int m = 0; m < 4; ++m) xw[ai][m] = *(const u32x4*)(X + (size_t)(row0 + ai * 128 + m * 16) * DRNN + ch0);
        const f32x4 br0 = *(const f32x4*)(bgate + ch0), br1 = *(const f32x4*)(bgate + ch0 + 4);
        const f32x4 bi0 = *(const f32x4*)(bgate + DRNN + ch0), bi1 = *(const f32x4*)(bgate + DRNN + ch0 + 4);
        const f32x4 ls0 = *(const f32x4*)(LSP + ch0), ls1 = *(const f32x4*)(LSP + ch0 + 4);
#pragma unroll
        EPI_LOOP_ROWS {
            const size_t o = (size_t)(row0 + ai * 128 + m * 16) * DRNN + ch0;
            const u32x4 xv = xw[ai][m];
            const f32x4 x0 = (f32x4){lo_bf(xv.x), hi_bf(xv.x), lo_bf(xv.y), hi_bf(xv.y)}, x1 = (f32x4){lo_bf(xv.z), hi_bf(xv.z), lo_bf(xv.w), hi_bf(xv.w)};
            const f32x4 r0 = acc[ai][0][m][0] + br0, r1 = acc[ai][0][m][1] + br1, i0 = acc[ai][1][m][0] + bi0, i1 = acc[ai][1][m][1] + bi1;
            u32x4 w0, w1;
#pragma unroll
            for (int e = 0; e < 4; ++e) {
                float la = ls0[e] * sigmoidf_(r0[e]); float bb = sqrtf(fmaxf(-expm1f(2.0f * la), 0.f)) * (sigmoidf_(i0[e]) * x0[e]); w0[e] = pk2(la * 1.4426950408889634f, bb);
                la = ls1[e] * sigmoidf_(r1[e]); bb = sqrtf(fmaxf(-expm1f(2.0f * la), 0.f)) * (sigmoidf_(i1[e]) * x1[e]); w1[e] = pk2(la * 1.4426950408889634f, bb);
            }
            *(u32x4*)(AB + o) = w0; *(u32x4*)(AB + o + 4) = w1;
        }
    }
};

__device__ __forceinline__ const float* inp(const Params& P, int i) { i = __builtin_amdgcn_readfirstlane(i); asm volatile("" : "+s"(i)); return P.in[i]; }
enum { MAP_ID = 0, MAP_NSA = 1, MAP_DIL = 2, MAP_RG = 3 };
struct Job { const float* W; int ldw, K; bf16* WT; int ldt, n_begin, n_rows, map, srcoff; };
__device__ __forceinline__ int srccol(int map, int n, int srcoff) {
    if (map == MAP_ID) return n + srcoff;
    if (map == MAP_NSA) {
        if (n < 2048) return (n & ~127) + sigma_d(n & 127);
        if (n < 3072) return n;
        if (n < 3584) return (n & ~127) + sigma_d(n & 127);
        if (n < 4096) return ((n + 512) & ~127) + sigma_d(n & 127);
        if (n < 4144) return 5120 + (n - 4096);
        if (n < 4352) return -1;
        if (n < 4864) return n - 768;
        return n - 256;
    }
    if (map == MAP_DIL) { const int j = (n >> 11) % 3; return j < 2 ? (n & ~127) + sigma_d(n & 127) : n; }
    if (n < DRNN) return n; if (n < RG_XOFF) return -1; if (n < RG_XOFF + DRNN) return n - (RG_XOFF - DRNN); return -1;
}
__device__ __forceinline__ bool is_sigma(int map, int n) {
    if (map == MAP_NSA) return n < 2048 || (n >= 3072 && n < 4096);
    if (map == MAP_DIL) return ((n >> 11) % 3) < 2;
    return false;
}
__device__ __forceinline__ void conv_item(const Job& J, int item, LAS float* scr, int lane) {
    const int nblk = J.n_rows / 32, kb = item / nblk, nb = item % nblk, k0 = 64 * kb, n0 = J.n_begin + 32 * nb, nl0 = n0 - J.n_begin;
    const int ks = lane >> 3, c4 = lane & 7;
    const bool sig = is_sigma(J.map, nl0);
    const int dl0 = sig ? 8 * (c4 & 3) + (c4 >> 2) : 4 * c4, dstep = sig ? 2 : 1;
    const int sc4 = srccol(J.map, nl0 + dl0, J.srcoff);
    f32x4 v[8];
#pragma unroll
    for (int i = 0; i < 8; ++i) v[i] = sc4 >= 0 ? __builtin_nontemporal_load((const f32x4*)(J.W + (size_t)(k0 + 8 * i + ks) * J.ldw + sc4)) : (f32x4){0.f, 0.f, 0.f, 0.f};
#pragma unroll
    for (int i = 0; i < 8; ++i) { LAS float* d = scr + (8 * i + ks) * 33 + dl0; d[0] = v[i][0]; d[dstep] = v[i][1]; d[2 * dstep] = v[i][2]; d[3 * dstep] = v[i][3]; }
    LDS_WAIT();
    const int c = lane & 7;
#pragma unroll
    for (int j = 0; j < 4; ++j) { const int n = (lane >> 3) + 8 * j; const LAS float* sp = scr + (8 * c) * 33 + n;
        u32x4 o; o.x = pk2(sp[0 * 33], sp[1 * 33]); o.y = pk2(sp[2 * 33], sp[3 * 33]); o.z = pk2(sp[4 * 33], sp[5 * 33]); o.w = pk2(sp[6 * 33], sp[7 * 33]);
        *(u32x4*)(J.WT + (size_t)(n0 + n) * J.ldt + k0 + 8 * c) = o; }
    LDS_WAIT();
}
constexpr int NJOBS = 24;
__device__ __forceinline__ Job get_job(const Params& P, int jid) {
    bf16* WB = (bf16*)(P.ws + WS_W);
    Job J; J.srcoff = 0; J.map = MAP_ID; J.n_begin = 0;
    if (jid < 12) {
        const int slot = jid / 6, r = jid % 6, bi = slot == 0 ? 2 : 34; bf16* base = WB + (size_t)slot * WE_NSA_SZ;
        if (r == 0) { J.W = inp(P, bi + 3); J.ldw = 5168; J.K = 2048; J.WT = base + WE_NSA_WIN; J.ldt = 2048; J.n_rows = NSA_N; J.map = MAP_NSA; }
        else if (r < 5) { const int kv = (r - 1) >> 1, half = (r - 1) & 1;
            J.W = inp(P, bi + 5) + (size_t)kv * 4096 * 512 + (size_t)half * 2048 * 512; J.ldw = 512; J.K = 2048;
            J.WT = base + WE_NSA_W1 + (size_t)kv * 1024 * 2048; J.ldt = 2048; J.n_begin = half * 512; J.n_rows = 512; }
        else { J.W = inp(P, bi + 7); J.ldw = 2048; J.K = 2048; J.WT = base + WE_NSA_WOUT; J.ldt = 2048; J.n_rows = 2048; }
    } else if (jid == 12) { J.W = inp(P, 13 + 3); J.ldw = DIL_N; J.K = 2048; J.WT = WB + WE_DIL; J.ldt = 2048; J.n_rows = DIL_N; J.map = MAP_DIL; }
    else if (jid == 13) { J.W = inp(P, 13 + 4); J.ldw = 2048; J.K = 2048; J.WT = WB + WE_DIL_WOUT; J.ldt = 2048; J.n_rows = 2048; }
    else if (jid == 14) { J.W = inp(P, 21 + 3); J.ldw = 2 * DRNN; J.K = 2048; J.WT = WB + WE_RG; J.ldt = 2048; J.n_rows = RG_N; J.map = MAP_RG; }
    else if (jid == 15) { J.W = inp(P, 21 + 9); J.ldw = 2048; J.K = DRNN; J.WT = WB + WE_RG_WOUT; J.ldt = DRNN; J.n_rows = 2048; }
    else { const int li = (jid - 16) >> 1, w = (jid - 16) & 1, bi = layer_base(li) + ff_off(li);
        if (w == 0) { J.W = inp(P, bi + 1); J.ldw = DFF; J.K = 2048; J.WT = WB + WE_FF + (size_t)li * 33554432; J.ldt = 2048; J.n_rows = DFF; }
        else { J.W = inp(P, bi + 2); J.ldw = 2048; J.K = DFF; J.WT = WB + WE_FF + (size_t)li * 33554432 + 16777216; J.ldt = DFF; J.n_rows = 2048; } }
    return J;
}

namespace fa {
typedef float f32x16 __attribute__((ext_vector_type(16)));
typedef short bf16x8 __attribute__((ext_vector_type(8)));
constexpr int KROW = 272, VROW = 144, KTILE = 64 * KROW, VTILE = 128 * VROW;
constexpr int KBUF0 = 0, VBUF0 = 3 * KTILE, IMP_OFF = VBUF0 + 2 * VTILE, MSK_OFF = RING_BYTES - 1024;
static_assert(IMP_OFF + 32768 <= MSK_OFF, "attention LDS map");
static_assert(MSK_OFF + 1024 <= RING_BYTES, "attention LDS map");
constexpr float C2 = ATT_SCALE * 1.4426950408889634f;
#define FA_MFMA(a, b, c) __builtin_amdgcn_mfma_f32_32x32x16_bf16(a, b, c, 0, 0, 0)
__device__ __forceinline__ float half_max(float v) { auto rr = __builtin_amdgcn_permlane32_swap(__float_as_uint(v), __float_as_uint(v), false, false); return fmaxf(__uint_as_float(rr[0]), __uint_as_float(rr[1])); }
__device__ __forceinline__ float half_sum(float v) { auto rr = __builtin_amdgcn_permlane32_swap(__float_as_uint(v), __float_as_uint(v), false, false); return __uint_as_float(rr[0]) + __uint_as_float(rr[1]); }
struct Src { const bf16* K0; long ldk; const bf16* V0; long ldv; int tsh; };
struct Stage { u32x4 k0, k1, v0, v1; };
__device__ __forceinline__ void stage_load_k(Stage& s, const Src& src, int T, int tid) {
    const int kr = tid >> 4, kc = tid & 15;
    const char* kb = (const char*)(src.K0 + (long)(64 * (T >> src.tsh)) * src.ldk); const char* kb2 = kb + 64 * src.ldk;
    unsigned ko = (unsigned)(kr * (int)src.ldk + kc * 8) * 2u; asm volatile("" : "+v"(ko));
    s.k0 = *(const u32x4*)(kb + ko); s.k1 = *(const u32x4*)(kb2 + ko);
}
__device__ __forceinline__ void stage_load_v(Stage& s, const Src& src, int T, int tid) {
    const int vr = tid >> 3, vp = tid & 7;
    const char* vb = (const char*)(src.V0 + 64 * (T >> src.tsh)); const char* vb2 = vb + 128 * src.ldv;
    unsigned vo = (unsigned)(vr * (int)src.ldv + vp * 8) * 2u; asm volatile("" : "+v"(vo));
    s.v0 = *(const u32x4*)(vb + vo); s.v1 = *(const u32x4*)(vb2 + vo);
}
__device__ __forceinline__ void stage_load(Stage& s, const Src& src, int T, int tid, bool withV) { stage_load_k(s, src, T, tid); if (withV) stage_load_v(s, src, T, tid); }
__device__ __forceinline__ void stage_write_k_at(const Stage& s, LAS unsigned char* ktile, int tid) {
    const int kr = tid >> 4, kc = tid & 15;
    LAS unsigned char* kb = ktile + kr * KROW + kc * 16;
    *(LAS u32x4*)kb = s.k0; *(LAS u32x4*)(kb + 32 * KROW) = s.k1;
}
__device__ __forceinline__ void stage_write_k(const Stage& s, LAS unsigned char* lds, int kbuf, int tid) { stage_write_k_at(s, lds + KBUF0 + kbuf * KTILE, tid); }
__device__ __forceinline__ void stage_write_v_at(const Stage& s, LAS unsigned char* vtile, int tid);
__device__ __forceinline__ void stage_write_v(const Stage& s, LAS unsigned char* lds, int vbuf, int tid) { stage_write_v_at(s, lds + VBUF0 + vbuf * VTILE, tid); }
__device__ __forceinline__ void stage_write_v_at(const Stage& s, LAS unsigned char* vtile, int tid) {
    const int vr = tid >> 3, vp = tid & 7, g16 = vp >> 1, half = vp & 1;
    LAS unsigned char* vb = vtile + vr * VROW + g16 * 32 + half * 8;
    *(LAS u32x2*)(vb) = (u32x2){s.v0.x, s.v0.y}; *(LAS u32x2*)(vb + 16) = (u32x2){s.v0.z, s.v0.w};
    *(LAS u32x2*)(vb + 64 * VROW) = (u32x2){s.v1.x, s.v1.y}; *(LAS u32x2*)(vb + 64 * VROW + 16) = (u32x2){s.v1.z, s.v1.w};
}
__device__ __forceinline__ void stage_write(const Stage& s, LAS unsigned char* lds, int buf, int tid, bool withV) { stage_write_k(s, lds, buf, tid); if (withV) stage_write_v(s, lds, buf, tid); }
__device__ __forceinline__ void load_q(bf16x8 (&qf)[8], const bf16* qrow, int hi) {
#pragma unroll
    for (int kk = 0; kk < 8; ++kk) qf[kk] = *(const bf16x8*)(qrow + kk * 16 + hi * 8);
}
#define FA_PIPE_16() do { __builtin_amdgcn_sched_group_barrier(0x100, 4, 0); \
    _Pragma("unroll") for (int i_ = 0; i_ < 12; ++i_) { __builtin_amdgcn_sched_group_barrier(0x008, 1, 0); __builtin_amdgcn_sched_group_barrier(0x100, 1, 0); } \
    __builtin_amdgcn_sched_group_barrier(0x008, 4, 0); } while (0)
__device__ __forceinline__ void qk_tile_at(f32x16& p0, f32x16& p1, const LAS unsigned char* ktile, const bf16x8 (&qf)[8], int c32, int hi);
__device__ __forceinline__ void qk_tile(f32x16& p0, f32x16& p1, const LAS unsigned char* lds, int buf, const bf16x8 (&qf)[8], int c32, int hi) { qk_tile_at(p0, p1, lds + KBUF0 + buf * KTILE, qf, c32, hi); }
__device__ __forceinline__ void qk_tile_at(f32x16& p0, f32x16& p1, const LAS unsigned char* ktile, const bf16x8 (&qf)[8], int c32, int hi) {
#pragma unroll
    for (int r = 0; r < 16; ++r) { p0[r] = 0.f; p1[r] = 0.f; }
    const LAS unsigned char* kb = ktile + c32 * KROW + hi * 16;
    bf16x8 a[16];
#pragma unroll
    for (int kk = 0; kk < 8; ++kk) { a[2 * kk] = *(const LAS bf16x8*)(kb + 32 * kk); a[2 * kk + 1] = *(const LAS bf16x8*)(kb + 32 * KROW + 32 * kk); }
#pragma unroll
    for (int kk = 0; kk < 8; ++kk) { p0 = FA_MFMA(a[2 * kk], qf[kk], p0); p1 = FA_MFMA(a[2 * kk + 1], qf[kk], p1); }
    FA_PIPE_16();
}
__device__ __forceinline__ void pv_tile_at(f32x16 (&o)[4], const LAS unsigned char* vtile, const bf16x8 (&pa)[4], int c32, int hi);
__device__ __forceinline__ void pv_tile(f32x16 (&o)[4], const LAS unsigned char* lds, int buf, const bf16x8 (&pa)[4], int c32, int hi) { pv_tile_at(o, lds + VBUF0 + buf * VTILE, pa, c32, hi); }
__device__ __forceinline__ void pv_tile_at(f32x16 (&o)[4], const LAS unsigned char* vtile, const bf16x8 (&pa)[4], int c32, int hi) {
    const LAS unsigned char* vb = vtile + c32 * VROW + hi * 16;
    bf16x8 a[16];
#pragma unroll
    for (int S = 0; S < 4; ++S)
#pragma unroll
        for (int db = 0; db < 4; ++db) a[4 * S + db] = *(const LAS bf16x8*)(vb + db * 32 * VROW + 32 * S);
#pragma unroll
    for (int S = 0; S < 4; ++S)
#pragma unroll
        for (int db = 0; db < 4; ++db) o[db] = FA_MFMA(a[4 * S + db], pa[S], o[db]);
    FA_PIPE_16();
}
__device__ __forceinline__ void mask_range(f32x16& p0, f32x16& p1, int lo, int hi_, int hi) {
    const int lo4 = lo - 4 * hi, hi4 = hi_ - 4 * hi;
#pragma unroll
    for (int r = 0; r < 16; ++r) { const int c = (r & 3) + 8 * (r >> 2);
        if (c < lo4 || c > hi4) p0[r] = -INFINITY;
        if (c + 32 < lo4 || c + 32 > hi4) p1[r] = -INFINITY; }
}
template <int B_> __device__ __forceinline__ bf16x8 pack8r(const f32x16& p) {
    u32x4 w; w.x = pk2(p[B_ + 0], p[B_ + 1]); w.y = pk2(p[B_ + 2], p[B_ + 3]); w.z = pk2(p[B_ + 4], p[B_ + 5]); w.w = pk2(p[B_ + 6], p[B_ + 7]);
    return __builtin_bit_cast(bf16x8, w); }
constexpr float THR = 8.0f;
__device__ __forceinline__ void softmax_step(f32x16& p0, f32x16& p1, bool rowoff, float& m, float& l, f32x16 (&o)[4], bf16x8 (&pa)[4]) {
    float mx = fmaxf(fmaxf(p0[0], p0[1]), p0[2]);
#pragma unroll
    for (int r = 3; r < 15; r += 2) mx = fmaxf(fmaxf(mx, p0[r]), p0[r + 1]);
    mx = fmaxf(mx, p0[15]);
#pragma unroll
    for (int r = 0; r < 16; r += 2) mx = fmaxf(fmaxf(mx, p1[r]), p1[r + 1]);
    mx = half_max(mx);
    if (rowoff) mx = -INFINITY;
    if (!__all((mx - m) * C2 <= THR)) {
        const float mn = fmaxf(m, mx), alpha = __builtin_amdgcn_exp2f((m - mn) * C2); m = mn; l *= alpha;
#pragma unroll
        for (int db = 0; db < 4; ++db) o[db] = o[db] * alpha;
    }
    const float mnL = rowoff ? -INFINITY : -m * C2;
    p0 = p0 * C2 + mnL; p1 = p1 * C2 + mnL;
#pragma unroll
    for (int r = 0; r < 16; ++r) { p0[r] = __builtin_amdgcn_exp2f(p0[r]); p1[r] = __builtin_amdgcn_exp2f(p1[r]); }
    f32x16 sv = p0 + p1;
    const float ps = ((sv[0] + sv[1]) + (sv[2] + sv[3])) + ((sv[4] + sv[5]) + (sv[6] + sv[7])) + (((sv[8] + sv[9]) + (sv[10] + sv[11])) + ((sv[12] + sv[13]) + (sv[14] + sv[15])));
    l += half_sum(ps);
    pa[0] = pack8r<0>(p0); pa[1] = pack8r<8>(p0); pa[2] = pack8r<0>(p1); pa[3] = pack8r<8>(p1);
}
struct Msk { int qlo, qhi; const LAS unsigned* sel; };
#define FA_PIPE_8() do { __builtin_amdgcn_sched_group_barrier(0x100, 4, 0); \
    _Pragma("unroll") for (int i_ = 0; i_ < 4; ++i_) { __builtin_amdgcn_sched_group_barrier(0x008, 1, 0); __builtin_amdgcn_sched_group_barrier(0x100, 1, 0); } \
    __builtin_amdgcn_sched_group_barrier(0x008, 4, 0); } while (0)
__device__ __forceinline__ void qk_half(f32x16& p, const LAS unsigned char* lds, int kbuf, int half, const bf16x8 (&qf)[8], int c32, int hi) {
#pragma unroll
    for (int r = 0; r < 16; ++r) p[r] = 0.f;
    const LAS unsigned char* kb = lds + KBUF0 + kbuf * KTILE + half * 32 * KROW + c32 * KROW + hi * 16;
    bf16x8 a[8];
#pragma unroll
    for (int kk = 0; kk < 8; ++kk) a[kk] = *(const LAS bf16x8*)(kb + 32 * kk);
#pragma unroll
    for (int kk = 0; kk < 8; ++kk) p = FA_MFMA(a[kk], qf[kk], p);
    FA_PIPE_8();
}
__device__ __forceinline__ void pv_half(f32x16 (&o)[4], const LAS unsigned char* lds, int vbuf, int half, const bf16x8 (&pa)[2], int c32, int hi) {
    const LAS unsigned char* vb = lds + VBUF0 + vbuf * VTILE + c32 * VROW + hi * 16 + half * 64;
    bf16x8 a[8];
#pragma unroll
    for (int s2 = 0; s2 < 2; ++s2)
#pragma unroll
        for (int db = 0; db < 4; ++db) a[4 * s2 + db] = *(const LAS bf16x8*)(vb + db * 32 * VROW + 32 * s2);
#pragma unroll
    for (int s2 = 0; s2 < 2; ++s2)
#pragma unroll
        for (int db = 0; db < 4; ++db) o[db] = FA_MFMA(a[4 * s2 + db], pa[s2], o[db]);
    FA_PIPE_8();
}
__device__ __forceinline__ void softmax_half(f32x16& p, int half, bool needrange, int lo, int hi_, int hi, bool rowoff, float& m, float& l, f32x16 (&o)[4], bf16x8 (&pa)[2]) {
    if (needrange) { const int lo4 = lo - 4 * hi - 32 * half, hi4 = hi_ - 4 * hi - 32 * half;
#pragma unroll
        for (int r = 0; r < 16; ++r) { const int c = (r & 3) + 8 * (r >> 2); if (c < lo4 || c > hi4) p[r] = -INFINITY; } }
    float mx = fmaxf(fmaxf(p[0], p[1]), p[2]);
#pragma unroll
    for (int r = 3; r < 15; r += 2) mx = fmaxf(fmaxf(mx, p[r]), p[r + 1]);
    mx = half_max(fmaxf(mx, p[15]));
    if (rowoff) mx = -INFINITY;
    if (!__all((mx - m) * C2 <= THR)) {
        const float mn = fmaxf(m, mx), alpha = __builtin_amdgcn_exp2f((m - mn) * C2); m = mn; l *= alpha;
#pragma unroll
        for (int db = 0; db < 4; ++db) o[db] = o[db] * alpha;
    }
    const float mnL = rowoff ? -INFINITY : -m * C2;
#pragma unroll
    for (int r = 0; r < 16; ++r) p[r] = __builtin_amdgcn_exp2f(fmaf(p[r], C2, mnL));
    const float ps = (((p[0] + p[1]) + (p[2] + p[3])) + ((p[4] + p[5]) + (p[6] + p[7]))) + (((p[8] + p[9]) + (p[10] + p[11])) + ((p[12] + p[13]) + (p[14] + p[15])));
    l += half_sum(ps);
    pa[0] = pack8r<0>(p); pa[1] = pack8r<8>(p);
}
__device__ __forceinline__ void flash_flags(const Msk& mk, int Tt, int tsh, int& lo, int& hi_, bool& rowoff) {
    const int T = Tt >> tsh;
    lo = mk.qlo - 64 * T; hi_ = mk.qhi - 64 * T;
    rowoff = !(hi_ >= 0 && lo <= 63);
    if (mk.sel) { const unsigned w = mk.sel[T >> 5]; rowoff = rowoff || (((w >> (T & 31)) & 1u) == 0u); }
}
__device__ __forceinline__ void flash_pass(LAS unsigned char* lds, int tid, int c32, int hi, int T0, int T1, const Src& src, const Msk& mk, const bf16x8 (&qf)[8],
                                           float& m, float& l, f32x16 (&o)[4]) {
    Stage st; f32x16 sA, sB;
    const int n = T1 - T0 + 1; const bool lateqk = __builtin_amdgcn_readfirstlane(tid >> 8) != 0;
    __syncthreads();
    {   Stage st1;
        stage_load(st, src, T0, tid, true); if (n > 1) stage_load_k(st1, src, T0 + 1, tid);
        stage_write(st, lds, 0, tid, true); if (n > 1) stage_write_k(st1, lds, 1, tid); }
    if (n > 2) stage_load_k(st, src, T0 + 2, tid);
    if (n > 1) stage_load_v(st, src, T0 + 1, tid);
    __syncthreads();
    int lo, hi_; bool rowoff; flash_flags(mk, T0, src.tsh, lo, hi_, rowoff);
    bool act = !__all(rowoff);
    if (act) qk_half(sA, lds, 0, 0, qf, c32, hi);
#pragma unroll 1
    for (int i = 0; i < n; ++i) {
        if (i > 0) __syncthreads();
        if (i + 2 < n) stage_write_k(st, lds, (i + 2) % 3, tid);
        if (i + 1 < n) stage_write_v(st, lds, (i + 1) & 1, tid);
        if (i + 3 < n) stage_load_k(st, src, T0 + i + 3, tid);
        if (i + 2 < n) stage_load_v(st, src, T0 + i + 2, tid);
        const bool needrange = __any(!rowoff && !(lo <= 0 && hi_ >= 63));
        bf16x8 pa[2];
        if (act) { if (!lateqk) qk_half(sB, lds, i % 3, 1, qf, c32, hi);
                   softmax_half(sA, 0, needrange, lo, hi_, hi, rowoff, m, l, o, pa); pv_half(o, lds, i & 1, 0, pa, c32, hi);
                   if (lateqk) qk_half(sB, lds, i % 3, 1, qf, c32, hi); }
        int lo2 = 0, hi2 = 0; bool off2 = true, act2 = false;
        if (i + 1 < n) { flash_flags(mk, T0 + i + 1, src.tsh, lo2, hi2, off2); act2 = !__all(off2); }
        if (act2 && !lateqk) qk_half(sA, lds, (i + 1) % 3, 0, qf, c32, hi);
        if (act) { softmax_half(sB, 1, needrange, lo, hi_, hi, rowoff, m, l, o, pa); pv_half(o, lds, i & 1, 1, pa, c32, hi); }
        if (act2 && lateqk) qk_half(sA, lds, (i + 1) % 3, 0, qf, c32, hi);
        lo = lo2; hi_ = hi2; rowoff = off2; act = act2;
    }
}

constexpr int ASLOT = KTILE + VTILE;
constexpr int ANSLOT = 4;
static_assert(ANSLOT * ASLOT <= MSK_OFF, "async ring must not reach the selection masks");
__device__ __forceinline__ void lds_signal(volatile LAS unsigned* w, int lane) {
    asm volatile("s_waitcnt lgkmcnt(0)" ::: "memory");
    if (lane == 0) (void)__hip_atomic_fetch_add((LAS unsigned*)w, 1u, __ATOMIC_RELAXED, __HIP_MEMORY_SCOPE_WORKGROUP);
}
__device__ __forceinline__ void lds_wait(volatile LAS unsigned* w, unsigned target) {
    unsigned spins = 0;
    while ((unsigned)__builtin_amdgcn_readfirstlane(*w) < target) { __builtin_amdgcn_s_sleep(1); if (++spins > (1u << 22)) break; }
    asm volatile("" ::: "memory");
}
__device__ __forceinline__ void flash_pass_async(LAS unsigned char* lds, int tid, int lane, int c32, int hi, int T0, int T1, const Src& src, const Msk& mk, const bf16x8 (&qf)[8],
                                                 float& m, float& l, f32x16 (&o)[4]) {
    volatile LAS unsigned* fill = (volatile LAS unsigned*)(lds + RING_BYTES + 2048); volatile LAS unsigned* done = fill + 8;
    const int n = T1 - T0 + 1;
    Stage st;
    __syncthreads();
    if (tid < 16) fill[tid] = 0u;
    stage_load(st, src, T0, tid, true);
    __syncthreads();
    stage_write_k_at(st, lds, tid); stage_write_v_at(st, lds + KTILE, tid); lds_signal(fill + 0, lane);
    if (n > 1) stage_load(st, src, T0 + 1, tid, true);
#pragma unroll 1
    for (int i = 0; i < n; ++i) {
        const int s0 = i % ANSLOT;
        if (i + 1 < n) { const int s1 = (i + 1) % ANSLOT;
            lds_wait(done + s1, 8u * (unsigned)((i + 1) / ANSLOT));
            stage_write_k_at(st, lds + s1 * ASLOT, tid); stage_write_v_at(st, lds + s1 * ASLOT + KTILE, tid); lds_signal(fill + s1, lane);
            if (i + 2 < n) stage_load(st, src, T0 + i + 2, tid, true); }
        int lo, hi_; bool rowoff; flash_flags(mk, T0 + i, src.tsh, lo, hi_, rowoff);
        if (!__all(rowoff)) {
            lds_wait(fill + s0, 8u * (unsigned)(i / ANSLOT + 1));
            f32x16 p0, p1; bf16x8 pa[4];
            qk_tile_at(p0, p1, lds + s0 * ASLOT, qf, c32, hi);
            if (__any(!rowoff && !(lo <= 0 && hi_ >= 63))) mask_range(p0, p1, lo, hi_, hi);
            softmax_step(p0, p1, rowoff, m, l, o, pa);
            pv_tile_at(o, lds + s0 * ASLOT + KTILE, pa, c32, hi);
        }
        lds_signal(done + s0, lane);
    }
}
}

__device__ __forceinline__ void nsa_item(LAS unsigned char* lds, int wave, int lane, int b, int g, int c, const bf16* Q, const bf16* QR, const bf16* KCB, const bf16* VCT,
                                         const bf16* KS, const bf16* KW, const bf16* VT, const float* GT, float* OACC, bf16* ATT) {
    using namespace fa;
    const int tid = wave * 64 + lane, c32 = lane & 31, hi = lane >> 5;
    const int tl = wave * 8 + (c32 >> 2), head = c32 & 3, t = c * 64 + tl, mrow = b * SEQ + t, hq = g * 4 + head, bg = b * 4 + g;
    LAS float* IMP = (LAS float*)(lds + IMP_OFF); LAS unsigned* MSK = (LAS unsigned*)(lds + MSK_OFF);
    bf16x8 qf[8]; f32x16 o[4]; float m, l; u32x4 pk[8];
#define NSA_PTRS() int mr_ = mrow, hq_ = hq; asm volatile("" : "+v"(mr_), "+v"(hq_)); const float* gp = GT + (size_t)(mr_ * 48 + hq_ * 3); float* oacc = OACC + (size_t)mr_ * 2048 + (unsigned)(hq_ * 128); (void)gp; (void)oacc
    {
        { int mr_ = mrow, hq_ = hq; asm volatile("" : "+v"(mr_), "+v"(hq_)); load_q(qf, Q + (size_t)mr_ * 2048 + (unsigned)(hq_ * 128), hi); }
        const int NTc = (4 * c + 3 + 63) >> 6;
        const int qhi = (t - 31) >> 4;
        const Src src{KCB + (size_t)bg * 512 * 128, 128, VCT + (size_t)bg * 128 * 512, 512, 0};
        m = -1e30f; l = 0.f;
        Stage st;
        __syncthreads();
        stage_load(st, src, 0, tid, false);
#pragma unroll 1
        for (int T = 0; T < NTc; ++T) {
            const int buf = T & 1;
            stage_write(st, lds, buf, tid, false);
            __syncthreads();
            if (T + 1 < NTc) stage_load(st, src, T + 1, tid, false);
            f32x16 p0, p1;
            qk_tile(p0, p1, lds, buf, qf, c32, hi);
            mask_range(p0, p1, 0, qhi - 64 * T, hi);
            float mx = p0[0];
#pragma unroll
            for (int r = 1; r < 16; ++r) mx = fmaxf(mx, p0[r]);
#pragma unroll
            for (int r = 0; r < 16; ++r) mx = fmaxf(mx, p1[r]);
            mx = half_max(mx);
            const float mn = fmaxf(m, mx), alpha = __builtin_amdgcn_exp2f((m - mn) * C2), mnL = -mn * C2; m = mn;
            float ps = 0.f;
#pragma unroll
            for (int r = 0; r < 16; ++r) ps += __builtin_amdgcn_exp2f(fmaf(p0[r], C2, mnL)) + __builtin_amdgcn_exp2f(fmaf(p1[r], C2, mnL));
            l = l * alpha + half_sum(ps);
        }
        const float inv = l > 0.f ? 1.0f / l : 0.f, mnL = -m * C2;
#pragma unroll
        for (int db = 0; db < 4; ++db)
#pragma unroll
            for (int r = 0; r < 16; ++r) o[db][r] = 0.f;
        float carry = 0.f;
        __syncthreads();
        stage_load(st, src, 0, tid, true);
#pragma unroll 1
        for (int T = 0; T < NTc; ++T) {
            const int buf = T & 1;
            stage_write(st, lds, buf, tid, true);
            __syncthreads();
            if (T + 1 < NTc) stage_load(st, src, T + 1, tid, true);
            f32x16 p0, p1; bf16x8 pa[4];
            qk_tile(p0, p1, lds, buf, qf, c32, hi);
            mask_range(p0, p1, 0, qhi - 64 * T, hi);
#pragma unroll
            for (int r = 0; r < 16; ++r) { p0[r] = __builtin_amdgcn_exp2f(fmaf(p0[r], C2, mnL)) * inv; p1[r] = __builtin_amdgcn_exp2f(fmaf(p1[r], C2, mnL)) * inv; }
#pragma unroll
            for (int hf = 0; hf < 2; ++hf) {
                float qs[4], flo[4], fhi[4];
#pragma unroll
                for (int q4 = 0; q4 < 4; ++q4) {
                    const float e0 = hf ? p1[4 * q4] : p0[4 * q4], e1 = hf ? p1[4 * q4 + 1] : p0[4 * q4 + 1], e2 = hf ? p1[4 * q4 + 2] : p0[4 * q4 + 2], e3 = hf ? p1[4 * q4 + 3] : p0[4 * q4 + 3];
                    qs[q4] = (e0 + e1) + (e2 + e3);
                    auto rr = __builtin_amdgcn_permlane32_swap(__float_as_uint(e3), __float_as_uint(e3), false, false);
                    flo[q4] = __uint_as_float(rr[0]); fhi[q4] = __uint_as_float(rr[1]);
                }
#pragma unroll
                for (int q4 = 0; q4 < 4; ++q4) {
                    const float cin = hi ? flo[q4] : (q4 == 0 ? carry : fhi[q4 == 0 ? 0 : q4 - 1]);
                    float v = qs[q4] + cin; v += __shfl_xor(v, 1); v += __shfl_xor(v, 2);
                    if (head == 0) IMP[tl * 128 + 16 * T + 8 * hf + 2 * q4 + hi] = v;
                }
                carry = fhi[3];
            }
            pa[0] = pack8r<0>(p0); pa[1] = pack8r<8>(p0); pa[2] = pack8r<0>(p1); pa[3] = pack8r<8>(p1);
            pv_tile(o, lds, buf, pa, c32, hi);
        }
        NSA_PTRS();
        const float g0 = gp[0];
#pragma unroll
        for (int db = 0; db < 4; ++db)
#pragma unroll
            for (int q4 = 0; q4 < 4; ++q4) { pk[2 * db + (q4 >> 1)][2 * (q4 & 1)] = pk2(o[db][4 * q4] * g0, o[db][4 * q4 + 1] * g0); pk[2 * db + (q4 >> 1)][2 * (q4 & 1) + 1] = pk2(o[db][4 * q4 + 2] * g0, o[db][4 * q4 + 3] * g0); }
    }
    LDS_WAIT();
#ifndef REP_TOPK
#define REP_TOPK 1
#endif
#pragma unroll 1
    for (int rep_ = 0; rep_ < fresh_s(REP_TOPK); ++rep_)
#pragma unroll 1
    for (int tk = 0; tk < 8; ++tk) {
        LAS float* row = IMP + (wave * 8 + tk) * 128;
        const int j0 = lane, j1 = lane + 64;
        const float v0 = row[j0], v1 = row[j1];
        const float val0 = j0 > c ? -INFINITY : ((j0 == 0 || j0 == c || j0 == c - 1) ? 3.0e38f : v0);
        const float val1 = j1 > c ? -INFINITY : ((j1 == c || j1 == c - 1) ? 3.0e38f : v1);
        LDS_WAIT();
        row[j0] = val0; row[j1] = val1;
        LDS_WAIT();
        int cnt0 = 0, cnt1 = 0;
#pragma unroll 4
        for (int i4 = 0; i4 <= (c >> 2); ++i4) {
            const f32x4 x = *(const LAS f32x4*)(row + 4 * i4);
#pragma unroll
            for (int e = 0; e < 4; ++e) { const int i = 4 * i4 + e; cnt0 += (x[e] > val0 || (x[e] == val0 && i < j0)) ? 1 : 0; cnt1 += (x[e] > val1 || (x[e] == val1 && i < j1)) ? 1 : 0; } }
        const unsigned long long m0 = __ballot(j0 <= c && cnt0 < 16), m1 = __ballot(j1 <= c && cnt1 < 16);
        if (lane == 0) { LAS unsigned* mp = MSK + (wave * 8 + tk) * 4; mp[0] = (unsigned)m0; mp[1] = (unsigned)(m0 >> 32); mp[2] = (unsigned)m1; mp[3] = (unsigned)(m1 >> 32); }
    }
    LDS_WAIT();
    { int mr_ = mrow, hq_ = hq; asm volatile("" : "+v"(mr_), "+v"(hq_)); load_q(qf, QR + (size_t)mr_ * 2048 + (unsigned)(hq_ * 128), hi); }
    {
        Msk mk; mk.qlo = 0; mk.qhi = t; mk.sel = MSK + tl * 4;
        #ifdef PROBE_SEL2
        const Src src{KS + (size_t)b * SEQ * 512 + g * 128, 512, VT + (size_t)(g * 128) * LDV + (size_t)b * SEQ, LDV, 1};
#else
        const Src src{KS + (size_t)b * SEQ * 512 + g * 128, 512, VT + (size_t)(g * 128) * LDV + (size_t)b * SEQ, LDV, 0};
#endif
#ifndef REP_SEL
#define REP_SEL 1
#endif
        m = -1e30f; l = 0.f;
#pragma unroll
        for (int db = 0; db < 4; ++db)
#pragma unroll
            for (int r = 0; r < 16; ++r) o[db][r] = 0.f;
#ifdef PROBE_SEL2
        flash_pass(lds, tid, c32, hi, 0, 2 * c + 1, src, mk, qf, m, l, o);
#else
        flash_pass_async(lds, tid, lane, c32, hi, 0, c, src, mk, qf, m, l, o);
#endif
        NSA_PTRS();
        const float sc = gp[1] / l;
#pragma unroll
        for (int db = 0; db < 4; ++db)
#pragma unroll
            for (int q4 = 0; q4 < 4; ++q4) { const unsigned w0 = pk[2 * db + (q4 >> 1)][2 * (q4 & 1)], w1 = pk[2 * db + (q4 >> 1)][2 * (q4 & 1) + 1];
                pk[2 * db + (q4 >> 1)][2 * (q4 & 1)] = pk2(lo_bf(w0) + o[db][4 * q4] * sc, hi_bf(w0) + o[db][4 * q4 + 1] * sc);
                pk[2 * db + (q4 >> 1)][2 * (q4 & 1) + 1] = pk2(lo_bf(w1) + o[db][4 * q4 + 2] * sc, hi_bf(w1) + o[db][4 * q4 + 3] * sc); }
    }
    {
        Msk mk; mk.qlo = t - 511; mk.qhi = t; mk.sel = nullptr;
        const Src src{KW + (size_t)b * SEQ * 512 + g * 128, 512, VT + (size_t)(512 + g * 128) * LDV + (size_t)b * SEQ, LDV, 0};
        m = -1e30f; l = 0.f;
#pragma unroll
        for (int db = 0; db < 4; ++db)
#pragma unroll
            for (int r = 0; r < 16; ++r) o[db][r] = 0.f;
        flash_pass(lds, tid, c32, hi, c >= 8 ? c - 8 : 0, c, src, mk, qf, m, l, o);
        NSA_PTRS();
        const float sc = gp[2] / l;
        bf16* arow = ATT + (size_t)mr_ * 2048 + (unsigned)(hq_ * 128);
#pragma unroll
        for (int db = 0; db < 4; ++db)
#pragma unroll
            for (int qp = 0; qp < 2; ++qp) {
                unsigned f[2][2];
#pragma unroll
                for (int e = 0; e < 2; ++e) { const int q4 = 2 * qp + e; const unsigned w0 = pk[2 * db + qp][2 * e], w1 = pk[2 * db + qp][2 * e + 1];
                    f[e][0] = pk2(lo_bf(w0) + o[db][4 * q4] * sc, hi_bf(w0) + o[db][4 * q4 + 1] * sc); f[e][1] = pk2(lo_bf(w1) + o[db][4 * q4 + 2] * sc, hi_bf(w1) + o[db][4 * q4 + 3] * sc); }
                auto r0 = __builtin_amdgcn_permlane32_swap(f[0][0], f[1][0], false, false); auto r1 = __builtin_amdgcn_permlane32_swap(f[0][1], f[1][1], false, false);
                u32x4 w; w.x = r0[0]; w.y = r1[0]; w.z = r0[1]; w.w = r1[1];
                *(u32x4*)(arow + 32 * db + 16 * qp + 8 * hi) = w; }
    }
#undef NSA_PTRS
}

__device__ __forceinline__ void dil_item(LAS unsigned char* lds, int wave, int lane, int p, int sq, int h, int qb, const bf16* QK, const bf16* VT, float* OACC, float* ML, bf16* ATT) {
    using namespace fa;
    const int tid = wave * 64 + lane, c32 = lane & 31, hi = lane >> 5, dsh = 2 * p, L = SEQ >> dsh;
    const int b = sq >> dsh, r = sq & ((1 << dsh) - 1), q = qb * 256 + wave * 32 + c32, mrow = b * SEQ + (q << dsh) + r;
    const size_t seqbase = (size_t)sq * L;
    bf16x8 qf[8]; f32x16 o[4]; float m = -1e30f, l = 0.f;
    load_q(qf, QK + (seqbase + q) * 4096 + h * 128, hi);
    if (p > 0) {
        const float* op = OACC + (size_t)mrow * 2048 + h * 128;
#pragma unroll
        for (int db = 0; db < 4; ++db)
#pragma unroll
            for (int q4 = 0; q4 < 4; ++q4) { const f32x4 a = *(const f32x4*)(op + 32 * db + 8 * q4 + 4 * hi); o[db][4 * q4] = a[0]; o[db][4 * q4 + 1] = a[1]; o[db][4 * q4 + 2] = a[2]; o[db][4 * q4 + 3] = a[3]; }
        const f32x2 ml = *(const f32x2*)(ML + ((size_t)mrow * 16 + h) * 2); m = ml[0]; l = ml[1];
    } else {
#pragma unroll
        for (int db = 0; db < 4; ++db)
#pragma unroll
            for (int rr = 0; rr < 16; ++rr) o[db][rr] = 0.f;
    }
    Msk mk; mk.qlo = q - 128; mk.qhi = q; mk.sel = nullptr;
    const Src src{QK + seqbase * 4096 + 2048 + h * 128, 4096, VT + (size_t)(h * 128) * LDV + seqbase, LDV, 0};
    flash_pass(lds, tid, c32, hi, qb * 4 >= 2 ? qb * 4 - 2 : 0, qb * 4 + 3, src, mk, qf, m, l, o);
    int mr_ = mrow; asm volatile("" : "+v"(mr_));
    if (p < 2) {
        float* op = OACC + (size_t)mr_ * 2048 + h * 128;
#pragma unroll
        for (int db = 0; db < 4; ++db)
#pragma unroll
            for (int q4 = 0; q4 < 4; ++q4) *(f32x4*)(op + 32 * db + 8 * q4 + 4 * hi) = (f32x4){o[db][4 * q4], o[db][4 * q4 + 1], o[db][4 * q4 + 2], o[db][4 * q4 + 3]};
        if (hi == 0) *(f32x2*)(ML + ((size_t)mr_ * 16 + h) * 2) = (f32x2){m, l};
    } else {
        const float il = 1.0f / l; bf16* arow = ATT + (size_t)mr_ * 2048 + h * 128;
#pragma unroll
        for (int db = 0; db < 4; ++db)
#pragma unroll
            for (int qp = 0; qp < 2; ++qp) {
                unsigned f[2][2];
#pragma unroll
                for (int e = 0; e < 2; ++e) { const int q4 = 2 * qp + e; f[e][0] = pk2(o[db][4 * q4] * il, o[db][4 * q4 + 1] * il); f[e][1] = pk2(o[db][4 * q4 + 2] * il, o[db][4 * q4 + 3] * il); }
                auto r0 = __builtin_amdgcn_permlane32_swap(f[0][0], f[1][0], false, false); auto r1 = __builtin_amdgcn_permlane32_swap(f[0][1], f[1][1], false, false);
                u32x4 w; w.x = r0[0]; w.y = r1[0]; w.z = r0[1]; w.w = r1[1];
                *(u32x4*)(arow + 32 * db + 16 * qp + 8 * hi) = w; }
    }
}

__device__ __forceinline__ void modulate_row(const float* x32, const bf16* x16, const float* gain, const float* shift, const float* scale, bf16* orow, float* frow, int lane) {
    f32x4 v[8]; float ss = 0.f;
    if (x32) {
#pragma unroll
        for (int j = 0; j < 8; ++j) v[j] = *(const f32x4*)(x32 + 4 * lane + 256 * j);
    } else {
        u32x2 w[8];
#pragma unroll
        for (int j = 0; j < 8; ++j) w[j] = *(const u32x2*)(x16 + 4 * lane + 256 * j);
#pragma unroll
        for (int j = 0; j < 8; ++j) v[j] = (f32x4){lo_bf(w[j].x), hi_bf(w[j].x), lo_bf(w[j].y), hi_bf(w[j].y)};
    }
#pragma unroll
    for (int j = 0; j < 8; ++j) ss += (v[j][0] * v[j][0] + v[j][1] * v[j][1]) + (v[j][2] * v[j][2] + v[j][3] * v[j][3]);
    const float rinv = rsqrtf(wave_sum(ss) * (1.0f / D) + NORM_EPS);
#pragma unroll
    for (int j = 0; j < 8; ++j) {
        const int col = 4 * lane + 256 * j;
        const f32x4 gn = *(const f32x4*)(gain + col);
        f32x4 r = v[j] * rinv * gn;
        if (shift) { const f32x4 sh = *(const f32x4*)(shift + col), sc = *(const f32x4*)(scale + col); r = r * (1.0f + sc) + sh;
            u32x2 w; w.x = pk2(r[0], r[1]); w.y = pk2(r[2], r[3]); *(u32x2*)(orow + col) = w; }
        else *(f32x4*)(frow + col) = r;
    }
}

__device__ __forceinline__ unsigned char* wsp_(unsigned char* ws, size_t off) { asm volatile("" : "+s"(off)); return ws + off; }
#define FRESH_IDS() const int wave = fresh_s(wave_s), lane = lane_id_asm(), tid = wave * 64 + lane; (void)tid; \
    const int Gf_ = fresh_s(G), bx_ = fresh_s((int)blockIdx.x); const int gw = bx_ * NWAVES + wave, NGW = Gf_ * NWAVES, gtid = bx_ * NTHREADS + tid, NGT = Gf_ * NTHREADS; \
    LAS float* wl = (LAS float*)(lds + wave * 16384); (void)lane; (void)gw; (void)NGW; (void)gtid; (void)NGT; (void)wl
__global__ void __launch_bounds__(NTHREADS, 2) mega_fwd(Params P) {
    extern __shared__ __attribute__((aligned(16))) unsigned char lds_raw[];
    LAS unsigned char* lds = (LAS unsigned char*)lds_raw;
    volatile LAS unsigned* MISC = (volatile LAS unsigned*)(lds + MISC_OFF);
    const int G = gridDim.x;
    unsigned char* ws = P.ws;
    for (int u = threadIdx.x; u < (LDS_BYTES - RING_BYTES) / 4; u += NTHREADS) ((LAS unsigned*)(lds + RING_BYTES))[u] = 0u;
    __syncthreads();
    const int wave_s = __builtin_amdgcn_readfirstlane(threadIdx.x >> 6);
    XcdBarrier bar = xcd_barrier_post((unsigned*)(ws + WS_CTL) + 4096, MISC + 8); bar.wave = wave_s;
#define GRID_BAR() xcd_barrier(bar)
#define WSP(T, off) ((T*)wsp_(ws, (off)))

    {
        FRESH_IDS();
        float* MODP = WSP(float, WS_MODP); float* COS = WSP(float, WS_COS); float* SIN = WSP(float, WS_SIN); float* BPEP = WSP(float, WS_BPEP); float* LSP = WSP(float, WS_LSP);
        const float* cv = inp(P, IN_C);
        for (int task = gw; task < 4 * 48 * 8; task += NGW) {
            const int kc = task & 7, cg = (task >> 3) % 48, l = task / (8 * 48);
            const float* w = inp(P, layer_base(l)) + (size_t)cg * 256 + lane * 4;
            f32x4 a0 = {0.f, 0.f, 0.f, 0.f}, a1 = {0.f, 0.f, 0.f, 0.f};
#pragma unroll 8
            for (int k = kc * 256; k < kc * 256 + 256; ++k) {
                const float c0 = cv[k], c1 = cv[2048 + k];
                const float s0 = c0 / (1.0f + __expf(-c0)), s1 = c1 / (1.0f + __expf(-c1));
                const f32x4 wv = __builtin_nontemporal_load((const f32x4*)(w + (size_t)k * 12288));
                a0 += s0 * wv; a1 += s1 * wv;
            }
            *(f32x4*)(MODP + ((size_t)((kc * 4 + l) * 2 + 0)) * 12288 + cg * 256 + lane * 4) = a0;
            *(f32x4*)(MODP + ((size_t)((kc * 4 + l) * 2 + 1)) * 12288 + cg * 256 + lane * 4) = a1;
        }
        for (int i = gtid; i < SEQ * 64; i += NGT) {
            const int t = i >> 6, f = i & 63;
            const double invf = exp2(-(double)f * (13.287712379549449 / 64.0));
            const double ang = (double)t * invf;
            const double n = rint(ang * 0.15915494309189535);
            const double r = (ang - n * 6.283185307179586) - n * 2.4492935982947064e-16;
            COS[i] = (float)cos(r); SIN[i] = (float)sin(r);
        }
        for (int task = gw; task < 2 * 2 * 2 * 16; task += NGW) {
            const int kc = task & 15, cg = (task >> 4) & 1, kv = (task >> 5) & 1, slot = task >> 6;
            const int bi = slot == 0 ? 2 : 34;
            const float* pe = inp(P, bi + 4) + kv * 4096; const float* w = inp(P, bi + 5) + (size_t)kv * 4096 * 512 + cg * 256 + lane * 4;
            f32x4 a = {0.f, 0.f, 0.f, 0.f};
#pragma unroll 8
            for (int k = kc * 256; k < kc * 256 + 256; ++k) a += pe[k] * *(const f32x4*)(w + (size_t)k * 512);
            *(f32x4*)(BPEP + (size_t)((kc * 2 + slot) * 2 + kv) * 512 + cg * 256 + lane * 4) = a;
        }
        { const float* lamp = inp(P, 21 + 8);
          for (int i = gtid; i < DRNN; i += NGT) { const double lam = (double)lamp[i]; LSP[i] = (float)(-8.0 * log1p(exp(-lam))); } }
    }
    GRID_BAR();
    {
        FRESH_IDS();
#pragma unroll 1
        for (int jid = 0; jid < NJOBS; ++jid) {
            const Job J = get_job(P, jid);
            const int nitems = (J.K / 64) * (J.n_rows / 32);
            for (int it = gw; it < nitems; it += NGW) conv_item(J, it, wl, lane);
        }
        {
            const float* wg = inp(P, 21 + 6); bf16* WG = WSP(bf16, WS_W) + WE_RG_WG;
            for (long i = gtid; i < (long)5376 * (DRNN / 8); i += NGT) {
                const int row = (int)(i / (DRNN / 8)), k8 = (int)(i % (DRNN / 8)) * 8;
                const int gate = (row >> 7) & 1, ch = (row >> 8) * 128 + (row & 127), nb = ch / 168, dd = ch % 168;
                float v[8];
#pragma unroll
                for (int e = 0; e < 8; ++e) { const int k = k8 + e; v[e] = (k / 168 == nb) ? wg[((size_t)(gate * 16 + nb) * 168 + (k % 168)) * 168 + dd] : 0.f; }
                u32x4 o; o.x = pk2(v[0], v[1]); o.y = pk2(v[2], v[3]); o.z = pk2(v[4], v[5]); o.w = pk2(v[6], v[7]);
                *(u32x4*)(WG + (size_t)row * DRNN + k8) = o;
            }
        }
        {   const float* MODP = WSP(float, WS_MODP); float* MOD = WSP(float, WS_MOD);
#pragma unroll 1
            for (int l = 0; l < 4; ++l) { const float* bias = inp(P, layer_base(l) + 1);
                for (int i = gtid; i < 2 * 12288; i += NGT) {
                    const int col = i % 12288, lb = l * 2 + i / 12288;
                    float a = bias[col];
#pragma unroll
                    for (int kc = 0; kc < 8; ++kc) a += MODP[(size_t)(kc * 8 + lb) * 12288 + col];
                    MOD[(size_t)lb * 12288 + col] = a;
                } }
            const float* BPEP = WSP(float, WS_BPEP); float* BPE = WSP(float, WS_BPE);
            for (int i = gtid; i < 2 * 2 * 512; i += NGT) { float a = 0.f;
#pragma unroll
                for (int kc = 0; kc < 16; ++kc) a += BPEP[(size_t)kc * 2048 + i];
                BPE[i] = a; }
        }
    }
    GRID_BAR();

#pragma unroll 1
    for (int li = 0; li < 4; ++li) {
        const int kind = li % 3, bi = layer_base(li);
        {   FRESH_IDS();
            const float* x32 = li == 0 ? inp(P, IN_X) : (const float*)nullptr; const bf16* XR = WSP(bf16, WS_XR); const float* gain = inp(P, bi + 2);
            const float* modl = WSP(float, WS_MOD) + (size_t)li * 2 * 12288; bf16* HN = WSP(bf16, WS_HN);
            for (int r = gw; r < M; r += NGW) { const int b = r >> 13;
                modulate_row(x32 ? x32 + (size_t)r * D : (const float*)nullptr, XR + (size_t)r * D, gain, modl + (size_t)b * 12288, modl + (size_t)b * 12288 + 2048, HN + (size_t)r * D, nullptr, lane); } }
        GRID_BAR();
        if (kind == 0) {
            const int slot = li == 0 ? 0 : 1;
            {   bf16* wbase = WSP(bf16, WS_W) + (size_t)slot * WE_NSA_SZ;
                pg8::Gemm g{WSP(bf16, WS_HN), wbase + WE_NSA_WIN, M, NSA_N1, D}; pg8::StaticOrder S; S.init(M, NSA_N1, fresh_s(G), fresh_s((int)blockIdx.x));
                EpiNsaIn E{WSP(bf16, NS_Q), WSP(bf16, NS_QR), WSP(bf16, NS_PK), WSP(bf16, NS_PV), WSP(bf16, NS_KS), WSP(bf16, NS_KW), WSP(float, NS_GT), WSP(float, WS_COS), WSP(float, WS_SIN)};
                pg8::gemm_phase<EpiNsaIn, pg8::StaticOrder, true, true>(lds, g, S, E, wave_s); }
            {
                bf16* wbase = WSP(bf16, WS_W) + (size_t)slot * WE_NSA_SZ;
                pg8::Gemm g{wbase + WE_NSA_WIN + (size_t)4352 * D, WSP(bf16, WS_HN), 1024, M, D}; pg8::StaticOrder S; S.init(1024, M, fresh_s(G), fresh_s((int)blockIdx.x));
                EpiBf16<0> E{WSP(bf16, NS_VT), LDV, 0};
                pg8::gemm_phase<EpiBf16<0>, pg8::StaticOrder, true, true>(lds, g, S, E, wave_s); }
            GRID_BAR();
#pragma unroll 1
            for (int kv = 0; kv < 2; ++kv) {
                bf16* wbase = WSP(bf16, WS_W) + (size_t)slot * WE_NSA_SZ;
                pg8::Gemm g{kv ? WSP(bf16, NS_PV) : WSP(bf16, NS_PK), wbase + WE_NSA_W1 + (size_t)kv * 1024 * 2048, 4096, 1024, 2048}; pg8::StaticOrder S; S.init(4096, 1024, fresh_s(G), fresh_s((int)((blockIdx.x + 128 * kv) % G)));
                EpiF32 E{WSP(float, NS_HC) + (size_t)kv * 4096 * 1024, 1024};
                pg8::gemm_phase<EpiF32, pg8::StaticOrder, true, true>(lds, g, S, E, wave_s); }
            {
                bf16* wbase = WSP(bf16, WS_W) + (size_t)slot * WE_NSA_SZ;
                pg8::Gemm g{WSP(bf16, WS_HN), wbase + WE_NSA_WIN + (size_t)4096 * D, M, 256, D}; pg8::StaticOrder S; S.init(M, 256, fresh_s(G), fresh_s((int)((blockIdx.x + 192) % G)));
                EpiGates E{WSP(float, NS_GT)};
                pg8::gemm_phase<EpiGates, pg8::StaticOrder, true, true>(lds, g, S, E, wave_s); }
            GRID_BAR();
            {
                FRESH_IDS();
                const float* w2 = inp(P, bi + 6); const float* bpe = WSP(float, WS_BPE) + slot * 1024; const float* HCb = WSP(float, NS_HC); bf16* KCb = WSP(bf16, NS_KC); bf16* VCt = WSP(bf16, NS_VCT);
                for (int task = gw; task < 2 * 8 * 128; task += NGW) {
                    const int n0 = (task & 127) * 4, bg = (task >> 7) & 7, kv = task >> 10;
                    const float* hrow = HCb + ((size_t)kv * 4096 + bg * 512 + n0) * 1024;
#pragma unroll
                    for (int q = 0; q < 2; ++q) { const int c = lane * 8 + q * 4; const f32x4 pb = *(const f32x4*)(bpe + kv * 512 + c);
                        f32x4 hv[4];
#pragma unroll
                        for (int r = 0; r < 4; ++r) { const f32x4 a = *(const f32x4*)(hrow + (size_t)r * 1024 + c), bb = n0 + r < 511 ? *(const f32x4*)(hrow + (size_t)(r + 1) * 1024 + 512 + c) : (f32x4){0.f, 0.f, 0.f, 0.f};
#pragma unroll
                            for (int e = 0; e < 4; ++e) hv[r][e] = n0 + r < 511 ? gelu_tanh(a[e] + bb[e] + pb[e]) : 0.f; }
#pragma unroll
                        for (int e = 0; e < 4; ++e) *(LAS f32x4*)(wl + (c + e) * 4) = (f32x4){hv[0][e], hv[1][e], hv[2][e], hv[3][e]}; }
                    LDS_WAIT();
                    const float* wp = w2 + (size_t)kv * 512 * 128 + 2 * lane; f32x4 o0 = {0.f, 0.f, 0.f, 0.f}, o1 = {0.f, 0.f, 0.f, 0.f};
#pragma unroll 16
                    for (int c = 0; c < 512; ++c) { const f32x2 wv = *(const f32x2*)(wp + (size_t)c * 128); const f32x4 hv = *(const LAS f32x4*)(wl + c * 4); o0 += hv * wv[0]; o1 += hv * wv[1]; }
                    const int d0 = 2 * lane, d1 = 2 * lane + 1;
                    if (kv == 0) {
#pragma unroll
                        for (int r = 0; r < 4; ++r) { bf16* dst = KCb + ((size_t)bg * 512 + n0 + r) * 128; dst[(d0 & 63) * 2 + (d0 >> 6)] = (bf16)(pk2(o0[r], 0.f) & 0xffffu); dst[(d1 & 63) * 2 + (d1 >> 6)] = (bf16)(pk2(o1[r], 0.f) & 0xffffu); } }
                    else { bf16* dst = VCt + (size_t)bg * 128 * 512 + n0;
                        u32x2 w0; w0.x = pk2(o0[0], o0[1]); w0.y = pk2(o0[2], o0[3]); *(u32x2*)(dst + (size_t)d0 * 512) = w0;
                        u32x2 w1; w1.x = pk2(o1[0], o1[1]); w1.y = pk2(o1[2], o1[3]); *(u32x2*)(dst + (size_t)d1 * 512) = w1; }
                    LDS_WAIT();
                }
            }
            GRID_BAR();
#ifndef REP_NSA
#define REP_NSA 1
#endif
#pragma unroll 1
            for (int rep = 0; rep < fresh_s(REP_NSA); ++rep)
            {   FRESH_IDS();
#pragma unroll 1
                for (int pi = bx_; pi < 512; pi += Gf_) {
                    const int bg = Gf_ == 256 ? (pi & 7) : (pi >> 6), cc = Gf_ == 256 ? ((pi & 255) >> 3) + 32 * (pi >> 8) : (pi & 63);
#pragma unroll 1
                    for (int e = 0; e < 2; ++e)
                        nsa_item(lds, wave, lane, bg >> 2, bg & 3, e ? cc : 127 - cc, WSP(bf16, NS_Q), WSP(bf16, NS_QR), WSP(bf16, NS_KC), WSP(bf16, NS_VCT), WSP(bf16, NS_KS), WSP(bf16, NS_KW),
                                 WSP(bf16, NS_VT), WSP(float, NS_GT), P.out, WSP(bf16, WS_ATT));
                }
                __syncthreads();
            }
            GRID_BAR();
        } else if (kind == 1) {
#pragma unroll 1
            for (int p = 0; p < 3; ++p) {
                {   pg8::Gemm g{WSP(bf16, WS_HN), WSP(bf16, WS_W) + WE_DIL + (size_t)p * 6144 * D, M, 4096, D, 2 * p, 0}; pg8::StaticOrder S; S.init(M, 4096, fresh_s(G), fresh_s((int)blockIdx.x));
                    EpiDilQK E{WSP(bf16, DL_QK) + (size_t)p * M * 4096, WSP(float, WS_COS), WSP(float, WS_SIN), 2 * p};
                    pg8::gemm_phase<EpiDilQK, pg8::StaticOrder, true, true>(lds, g, S, E, wave_s); }
                {   pg8::Gemm g{WSP(bf16, WS_W) + WE_DIL + ((size_t)p * 6144 + 4096) * D, WSP(bf16, WS_HN), 2048, M, D, 0, 2 * p}; pg8::StaticOrder S; S.init(2048, M, fresh_s(G), fresh_s((int)blockIdx.x));
                    EpiBf16<0> E{(bf16*)(WSP(unsigned char, DL_VT) + (size_t)p * DL_VT_STRIDE), LDV, 0};
                    pg8::gemm_phase<EpiBf16<0>, pg8::StaticOrder, true, true>(lds, g, S, E, wave_s); }
            }
            GRID_BAR();
#pragma unroll 1
            for (int p = 0; p < 3; ++p) {
                {   FRESH_IDS();
                    const int dsh = 2 * p, nqb = (SEQ >> dsh) >> 8;
#pragma unroll 1
                    for (int it = bx_; it < 1024; it += Gf_) {
                        const int qb = it % nqb, h = (it / nqb) & 15, sq = it / (nqb * 16);
                        dil_item(lds, wave, lane, p, sq, h, qb, WSP(bf16, DL_QK) + (size_t)p * M * 4096, (const bf16*)(WSP(unsigned char, DL_VT) + (size_t)p * DL_VT_STRIDE), P.out, WSP(float, DL_ML), WSP(bf16, WS_ATT));
                    }
                    __syncthreads();
                }
                GRID_BAR();
            }
        } else {
            {   pg8::Gemm g{WSP(bf16, WS_HN), WSP(bf16, WS_W) + WE_RG, M, RG_N, D}; pg8::StaticOrder S; S.init(M, RG_N, fresh_s(G), fresh_s((int)blockIdx.x));
                EpiBf16<2> E{WSP(bf16, RG_YX), RG_N, 11};
                pg8::gemm_phase<EpiBf16<2>, pg8::StaticOrder, true, true>(lds, g, S, E, wave_s); }
            GRID_BAR();
            {
                FRESH_IDS();
                const float* cw = inp(P, bi + 4); const float* cb = inp(P, bi + 5); const bf16* YX = WSP(bf16, RG_YX); bf16* Xc = WSP(bf16, RG_X);
                for (long i = gtid; i < (long)(M / 4) * (DRNN / 8); i += NGT) {
                    const int r4 = (int)(i / (DRNN / 8)) * 4, c8 = (int)(i % (DRNN / 8)) * 8, t0 = r4 & (SEQ - 1);
                    u32x4 xr[7];
#pragma unroll
                    for (int j = 0; j < 7; ++j) xr[j] = (t0 - 3 + j >= 0) ? *(const u32x4*)(YX + (size_t)(r4 - 3 + j) * RG_N + RG_XOFF + c8) : (u32x4){0u, 0u, 0u, 0u};
                    f32x4 w0[4], w1[4];
#pragma unroll
                    for (int j = 0; j < 4; ++j) { w0[j] = *(const f32x4*)(cw + j * DRNN + c8); w1[j] = *(const f32x4*)(cw + j * DRNN + c8 + 4); }
                    const f32x4 b0 = *(const f32x4*)(cb + c8), b1 = *(const f32x4*)(cb + c8 + 4);
#pragma unroll
                    for (int rr = 0; rr < 4; ++rr) {
                        f32x4 a0 = b0, a1 = b1;
#pragma unroll
                        for (int j = 0; j < 4; ++j) { const u32x4 xw = xr[rr + j];
                            a0 += w0[j] * (f32x4){lo_bf(xw.x), hi_bf(xw.x), lo_bf(xw.y), hi_bf(xw.y)}; a1 += w1[j] * (f32x4){lo_bf(xw.z), hi_bf(xw.z), lo_bf(xw.w), hi_bf(xw.w)}; }
                        u32x4 o; o.x = pk2(a0[0], a0[1]); o.y = pk2(a0[2], a0[3]); o.z = pk2(a1[0], a1[1]); o.w = pk2(a1[2], a1[3]);
                        *(u32x4*)(Xc + (size_t)(r4 + rr) * DRNN + c8) = o;
                    }
                }
            }
            GRID_BAR();
            {   pg8::Gemm g{WSP(bf16, RG_X), WSP(bf16, WS_W) + WE_RG_WG, M, 5376, DRNN}; pg8::GateOrder S; S.init(M, 5376, fresh_s(G), fresh_s((int)blockIdx.x));
                EpiRgGate E{WSP(bf16, RG_X), inp(P, bi + 7), WSP(float, WS_LSP), WSP(unsigned, RG_A)};
                pg8::gemm_phase<EpiRgGate, pg8::GateOrder, true, true>(lds, g, S, E, wave_s); }
            GRID_BAR();
            {
                FRESH_IDS();
                const unsigned* AB = WSP(unsigned, RG_A); float* CA = WSP(float, RG_CA); float* CB = WSP(float, RG_CB);
                for (int task = gw; task < 2 * 128 * 21; task += NGW) {
                    const int cg = task % 21, k = (task / 21) & 127, b = task / (21 * 128), ch = cg * 128 + 2 * lane;
                    const size_t o = (size_t)(b * SEQ + k * 64) * DRNN + ch; f32x2 pa = {1.f, 1.f}, hb = {0.f, 0.f};
#pragma unroll 16
                    for (int s = 0; s < 64; ++s) { const u32x2 w = *(const u32x2*)(AB + o + (size_t)s * DRNN);
                        const f32x2 a = {__builtin_amdgcn_exp2f(lo_bf(w.x)), __builtin_amdgcn_exp2f(lo_bf(w.y))}, bv = {hi_bf(w.x), hi_bf(w.y)}; hb = a * hb + bv; pa = pa * a; }
                    *(f32x2*)(CA + (size_t)(b * 128 + k) * DRNN + ch) = pa; *(f32x2*)(CB + (size_t)(b * 128 + k) * DRNN + ch) = hb;
                } }
            GRID_BAR();
            {   FRESH_IDS();
                const unsigned* AB = WSP(unsigned, RG_A); const float* CA = WSP(float, RG_CA); const float* CB = WSP(float, RG_CB);
                const bf16* YX = WSP(bf16, RG_YX); bf16* ATT = WSP(bf16, WS_ATT);
                for (int task = gw; task < 2 * 128 * 21; task += NGW) {
                    const int cg = task % 21, k = (task / 21) & 127, b = task / (21 * 128), ch = cg * 128 + 2 * lane;
                    f32x2 h = {0.f, 0.f};
                    { const size_t co = (size_t)(b * 128) * DRNN + ch;
#pragma unroll 8
                      for (int kk = 0; kk < k; ++kk) { const f32x2 ca = *(const f32x2*)(CA + co + (size_t)kk * DRNN), cb = *(const f32x2*)(CB + co + (size_t)kk * DRNN); h = ca * h + cb; } }
                    const size_t o = (size_t)(b * SEQ + k * 64) * DRNN + ch; const size_t yo = (size_t)(b * SEQ + k * 64) * RG_N + ch;
#pragma unroll 16
                    for (int s = 0; s < 64; ++s) { const u32x2 w = *(const u32x2*)(AB + o + (size_t)s * DRNN);
                        const f32x2 a = {__builtin_amdgcn_exp2f(lo_bf(w.x)), __builtin_amdgcn_exp2f(lo_bf(w.y))}, bv = {hi_bf(w.x), hi_bf(w.y)};
                        const unsigned yw = *(const unsigned*)(YX + yo + (size_t)s * RG_N);
                        h = a * h + bv;
                        *(unsigned*)(ATT + o + (size_t)s * DRNN) = pk2(h[0] * lo_bf(yw), h[1] * hi_bf(yw)); }
                } }
            GRID_BAR();
        }
        {   const int Kd = kind == 2 ? DRNN : D;
            const bf16* wt = kind == 0 ? WSP(bf16, WS_W) + (size_t)(li == 0 ? 0 : 1) * WE_NSA_SZ + WE_NSA_WOUT : kind == 1 ? WSP(bf16, WS_W) + WE_DIL_WOUT : WSP(bf16, WS_W) + WE_RG_WOUT;
            const float* x32 = li == 0 ? inp(P, IN_X) : (const float*)nullptr;
            pg8::Gemm g{WSP(bf16, WS_ATT), wt, M, D, Kd}; pg8::StaticOrder S; S.init(M, D, fresh_s(G), fresh_s((int)blockIdx.x));
            EpiRes E{x32, WSP(bf16, WS_XR), WSP(bf16, WS_XR), WSP(float, WS_MOD) + (size_t)li * 2 * 12288 + 2 * 2048};
            pg8::gemm_phase<EpiRes, pg8::StaticOrder, true, true>(lds, g, S, E, wave_s); }
        GRID_BAR();
        {   FRESH_IDS();
            const float* gain = inp(P, bi + ff_off(li)); const float* modl = WSP(float, WS_MOD) + (size_t)li * 2 * 12288; bf16* HN = WSP(bf16, WS_HN); const bf16* XR = WSP(bf16, WS_XR);
            for (int r = gw; r < M; r += NGW) { const int b = r >> 13;
                modulate_row(nullptr, XR + (size_t)r * D, gain, modl + (size_t)b * 12288 + 3 * 2048, modl + (size_t)b * 12288 + 4 * 2048, HN + (size_t)r * D, nullptr, lane); } }
        GRID_BAR();
#ifndef REP_FF1
#define REP_FF1 1
#endif
#pragma unroll 1
        for (int rep = 0; rep < fresh_s(REP_FF1); ++rep)
        {   pg8::Gemm g{WSP(bf16, WS_HN), WSP(bf16, WS_W) + WE_FF + (size_t)li * 33554432, M, DFF, D}; pg8::StaticOrder S; S.init(M, DFF, fresh_s(G), fresh_s((int)blockIdx.x));
            EpiBf16<1> E{WSP(bf16, WS_BIG), DFF, 0};
            pg8::gemm_phase<EpiBf16<1>, pg8::StaticOrder, true, true>(lds, g, S, E, wave_s); }
        GRID_BAR();
        {   pg8::Gemm g{WSP(bf16, WS_BIG), WSP(bf16, WS_W) + WE_FF + (size_t)li * 33554432 + 16777216, M, D, DFF}; pg8::StaticOrder S; S.init(M, D, fresh_s(G), fresh_s((int)blockIdx.x));
            EpiRes E{nullptr, WSP(bf16, WS_XR), WSP(bf16, WS_XR), WSP(float, WS_MOD) + (size_t)li * 2 * 12288 + 5 * 2048};
            pg8::gemm_phase<EpiRes, pg8::StaticOrder, true, true>(lds, g, S, E, wave_s); }
        GRID_BAR();
    }
    {   FRESH_IDS();
        const float* gain = inp(P, IN_NORMF); const bf16* XR = WSP(bf16, WS_XR); float* OUT = P.out;
        for (int r = gw; r < M; r += NGW) modulate_row(nullptr, XR + (size_t)r * D, gain, nullptr, nullptr, nullptr, OUT + (size_t)r * D, lane); }
}

extern "C" void kernel_launch(void* const* d_in, const int* in_sizes, int n_in, void* d_out, int out_size, void* d_ws, size_t ws_size, hipStream_t stream) {
    static int grid = 0;
    if (grid == 0) {
        if (n_in != 46 || out_size != M * D || ws_size < WS_END) { fprintf(stderr, "kernel_launch: unexpected shapes (n_in %d out %d ws %zu need %zu)\n", n_in, out_size, ws_size, (size_t)WS_END); grid = -1; return; }
        int dev = 0, cus = 0, per_cu = 0;
        if (hipGetDevice(&dev) != hipSuccess || hipDeviceGetAttribute(&cus, hipDeviceAttributeMultiprocessorCount, dev) != hipSuccess) { grid = -1; return; }
        if (hipFuncSetAttribute((const void*)mega_fwd, hipFuncAttributeMaxDynamicSharedMemorySize, LDS_BYTES) != hipSuccess) { fprintf(stderr, "kernel_launch: hipFuncSetAttribute failed\n"); grid = -1; return; }
        if (hipOccupancyMaxActiveBlocksPerMultiprocessor(&per_cu, (const void*)mega_fwd, NTHREADS, LDS_BYTES) != hipSuccess || per_cu < 1) { fprintf(stderr, "kernel_launch: occupancy query says %d\n", per_cu); }
        (void)hipGetLastError();
        grid = cus;
    }
    if (grid < 0) return;
    if (hipMemsetAsync((char*)d_ws + WS_CTL, 0, CTL_ZERO_BYTES, stream) != hipSuccess) return;
    Params p{};
    for (int i = 0; i < 46; ++i) p.in[i] = (const float*)d_in[i];
    p.out = (float*)d_out; p.ws = (unsigned char*)d_ws;
    hipLaunchKernelGGL(mega_fwd, dim3(grid), dim3(NTHREADS), LDS_BYTES, stream, p);
}
```

```cpp
#include <hip/hip_runtime.h>
#include <cstdio>
#include <cstdint>

#define GAS __attribute__((address_space(1)))
#define LAS __attribute__((address_space(3)))
typedef unsigned short bf16;
typedef float f32x4 __attribute__((ext_vector_type(4)));
typedef float f32x2 __attribute__((ext_vector_type(2)));
typedef unsigned u32x4 __attribute__((ext_vector_type(4)));
typedef unsigned u32x2 __attribute__((ext_vector_type(2)));
#define LDS_WAIT() asm volatile("s_waitcnt lgkmcnt(0)" ::: "memory")
__device__ __forceinline__ int fresh_s(int v) { asm volatile("" : "+s"(v)); return v; }
__device__ __forceinline__ int lane_id_asm() { int l; asm volatile("v_mbcnt_lo_u32_b32 %0, -1, 0\n\tv_mbcnt_hi_u32_b32 %0, -1, %0" : "=v"(l)); return l; }

namespace pg8 {
#define PG8_LAS __attribute__((address_space(3)))
typedef unsigned short bf16_t;
typedef short bf16x8 __attribute__((ext_vector_type(8)));
constexpr int BM = 256, BK = 64, HALF = 128, HTB = HALF * BK * 2, STAGE_BYTES = 8 * HTB, NXCD = 8, WGM = 8;
__host__ __device__ __forceinline__ int lds_byte(int r, int c) { const int st = (r >> 4) * 2 + (c >> 5), rr = r & 15, cc = c & 31, ob = rr * 64 + cc * 2; return st * 1024 + (ob ^ (((ob >> 9) & 1) << 5)); }
__host__ __device__ __forceinline__ void stage_rc(int b, int& R, int& C) { const int st = b / 1024, sb = b % 1024, swz = sb ^ (((sb >> 9) & 1) << 5); R = (st >> 1) * 16 + swz / 64; C = (st & 1) * 32 + (swz % 64) / 2; }
__host__ __device__ __forceinline__ int perm32(int rho) { const int n = rho >> 4, i = rho & 15; return 8 * (i >> 2) + 4 * n + (i & 3); }
struct Unit { int pm, pn; };
struct Gemm { const bf16_t* A; const bf16_t* Bt; int M, N, K; int dshA, dshB; };
__device__ __forceinline__ long rowbase(int p, int dsh) { const int i0 = p * 256; if (dsh == 0) return i0; const int b = i0 >> 13, rem = i0 & 8191, sh = 13 - dsh; return (long)(b << 13) + ((rem & ((1 << sh) - 1)) << dsh) + (rem >> sh); }
struct StaticOrder {
    int nM, nN, nwg, G, c;
    __host__ __device__ void init(int M, int N, int G_, int c_) { nM = M / BM; nN = N / BM; nwg = nM * nN; G = G_; c = c_; }
    __host__ __device__ bool next(int i, Unit& u) const {
        const long L = (long)i * G + c; if (L >= nwg) return false;
        int wgid = (int)L; { const int q = nwg / NXCD, r = nwg % NXCD, xcd = wgid % NXCD, off = wgid / NXCD; wgid = (xcd < r ? xcd * (q + 1) : r * (q + 1) + (xcd - r) * q) + off; }
        const int nig = WGM * nN, gid = wgid / nig, fm = gid * WGM, gsz = (nM - fm) < WGM ? (nM - fm) : WGM;
        u.pm = fm + ((wgid % nig) % gsz); u.pn = (wgid % nig) / gsz; return true;
    }
    __device__ __forceinline__ void a_ready(const Unit&) const {}
    __device__ __forceinline__ void done(const Unit&) const {}
    __device__ __forceinline__ void krange(const Unit&, int K, int& kbeg, int& nt) const { kbeg = 0; nt = K / BK; }
};
struct GateOrder : StaticOrder {
    __device__ __forceinline__ void krange(const Unit& u, int K, int& kbeg, int& nt) const {
        const int c0 = u.pn * 128, nb0 = c0 / 168, nb1 = (c0 + 127) / 168;
        kbeg = (nb0 * 168) & ~127; int kend = ((nb1 + 1) * 168 + 127) & ~127; if (kend > K) kend = K;
        nt = (kend - kbeg) / BK; }
};
__device__ __forceinline__ unsigned cvt_pk_bf16(float lo, float hi) { unsigned r; asm volatile("v_cvt_pk_bf16_f32 %0, %1, %2" : "=v"(r) : "v"(lo), "v"(hi)); return r; }

template <class Epi, class Sched, bool ALIGN_EPI = false, bool SP2 = false>
__device__ __forceinline__ void gemm_phase(PG8_LAS unsigned char* lds, const Gemm g, const Sched& S, const Epi& E, int wid_in) {
    int wid = wid_in; asm volatile("" : "+s"(wid));
    const int lane = lane_id_asm(), tid = wid * 64 + lane, wr = wid >> 2, wc = wid & 3, fr = lane & 15, fq = lane >> 4;
    const int K = g.K;
    unsigned voffA[2], voffB[2];
#pragma unroll
    for (int i = 0; i < 2; ++i) { int R, C; stage_rc(tid * 16 + i * 8192, R, C); const int Rb = Epi::PERM ? ((R & ~31) + perm32(R & 31)) : R;
        voffA[i] = (unsigned)((R << g.dshA) * K + C) * 2u; voffB[i] = (unsigned)((Rb << g.dshB) * K + C) * 2u; }
    const size_t kstep = (size_t)(BK * 2);
    const size_t hstepA = (size_t)(HALF << g.dshA) * K * 2, hstepB = (size_t)(HALF << g.dshB) * K * 2;
#define PG8_BASEA(u) ((const char*)g.A + (size_t)rowbase((u).pm, g.dshA) * K * 2)
#define PG8_BASEB(u) ((const char*)g.Bt + (size_t)rowbase((u).pn, g.dshB) * K * 2)
    const unsigned ldsw = (unsigned)wid * 1024u;
    const int aoff = lds_byte(wr * 64 + fr, fq * 8), boff = lds_byte(wc * 32 + fr, fq * 8);
#define PG8_SA(b, h) (((b) * 2 + (h)) * HTB)
#define PG8_SB(b, h) ((4 + (b) * 2 + (h)) * HTB)
#define PG8_STAGE(bufoff, gbase, voff) do { _Pragma("unroll") for (int _i = 0; _i < 2; ++_i) \
        __builtin_amdgcn_global_load_lds((const unsigned*)((const char*)(gbase) + (voff)[_i]), (PG8_LAS unsigned*)(lds + (bufoff) + ldsw + _i * 8192), 16, 0, 0); } while (0)
#define PG8_LDA(dst, b, h) do { _Pragma("unroll") for (int m = 0; m < 4; ++m) _Pragma("unroll") for (int k = 0; k < 2; ++k) dst[m][k] = *(const PG8_LAS bf16x8*)(lds + PG8_SA(b, h) + aoff + m * 2048 + k * 1024); } while (0)
#define PG8_LDB(dst, b, h) do { _Pragma("unroll") for (int n = 0; n < 2; ++n) _Pragma("unroll") for (int k = 0; k < 2; ++k) dst[n][k] = *(const PG8_LAS bf16x8*)(lds + PG8_SB(b, h) + boff + n * 2048 + k * 1024); } while (0)
#define PG8_MMA(ai, bj, At, Bt) do { __builtin_amdgcn_s_setprio(1); _Pragma("unroll") for (int m = 0; m < 4; ++m) _Pragma("unroll") for (int n = 0; n < 2; ++n) _Pragma("unroll") for (int k = 0; k < 2; ++k) \
        acc[ai][bj][m][n] = __builtin_amdgcn_mfma_f32_16x16x32_bf16(Bt[n][k], At[m][k], acc[ai][bj][m][n], 0, 0, 0); __builtin_amdgcn_s_setprio(0); } while (0)
#define PG8_WAIT_V(n) asm volatile("s_waitcnt vmcnt(" #n ")" ::: "memory")
#define PG8_WAIT_L(n) asm volatile("s_waitcnt lgkmcnt(" #n ")" ::: "memory")
#define PG8_BAR __builtin_amdgcn_s_barrier()
#define PG8_SCHED __builtin_amdgcn_sched_barrier(0)
    Unit cur, nxt; int ui = 0;
    if (!S.next(0, cur)) return;
    f32x4 acc[2][2][4][2];
#pragma unroll
    for (int a = 0; a < 2; ++a)
#pragma unroll
        for (int b = 0; b < 2; ++b)
#pragma unroll
            for (int m = 0; m < 4; ++m)
#pragma unroll
                for (int n = 0; n < 2; ++n) acc[a][b][m][n] = (f32x4){0.f, 0.f, 0.f, 0.f};
    bf16x8 At[4][2], B0[2][2], B1[2][2];
    int kb_cur, nt; S.krange(cur, K, kb_cur, nt);
    const char* cA = PG8_BASEA(cur) + (size_t)kb_cur * 2; const char* cB = PG8_BASEB(cur) + (size_t)kb_cur * 2;
    S.a_ready(cur);
    if constexpr (SP2) {
        PG8_STAGE(PG8_SB(0, 0), cB, voffB); PG8_STAGE(PG8_SB(0, 1), cB + hstepB, voffB); PG8_STAGE(PG8_SA(0, 0), cA, voffA); PG8_STAGE(PG8_SA(0, 1), cA + hstepA, voffA);
        if (wr == 1) PG8_BAR;
        PG8_WAIT_V(2); PG8_BAR;
        PG8_STAGE(PG8_SB(1, 0), cB + kstep, voffB); PG8_STAGE(PG8_SA(1, 0), cA + kstep, voffA); PG8_STAGE(PG8_SB(1, 1), cB + hstepB + kstep, voffB);
        PG8_WAIT_V(6); PG8_BAR;
    } else {
        PG8_STAGE(PG8_SB(0, 0), cB, voffB); PG8_STAGE(PG8_SA(0, 0), cA, voffA); PG8_STAGE(PG8_SB(0, 1), cB + hstepB, voffB); PG8_STAGE(PG8_SA(0, 1), cA + hstepA, voffA);
        if (wr == 1) PG8_BAR;
        PG8_WAIT_V(4); PG8_BAR;
        PG8_STAGE(PG8_SB(1, 0), cB + kstep, voffB); PG8_STAGE(PG8_SA(1, 0), cA + kstep, voffA); PG8_STAGE(PG8_SB(1, 1), cB + hstepB + kstep, voffB);
        PG8_WAIT_V(6); PG8_BAR;
    }
    for (;;) {
        const bool has_next = S.next(ui + 1, nxt);
        int kb_nxt = 0, nt_nxt = nt; if (has_next) S.krange(nxt, K, kb_nxt, nt_nxt);
        const char* nA = has_next ? PG8_BASEA(nxt) + (size_t)kb_nxt * 2 : cA; const char* nB = has_next ? PG8_BASEB(nxt) + (size_t)kb_nxt * 2 : cB;
        for (int t = 0; t < nt; t += 2) {
            const bool last = (t == nt - 2);
            const char* a1 = cA + (size_t)(t + 1) * kstep;
            const char* a2 = last ? nA : cA + (size_t)(t + 2) * kstep; const char* b2 = last ? nB : cB + (size_t)(t + 2) * kstep;
            const char* a3 = a2 + kstep; const char* b3 = b2 + kstep;
            if (last && has_next) S.a_ready(nxt);
            if constexpr (SP2) {
            PG8_LDB(B0, 0, 0); PG8_LDB(B1, 0, 1); PG8_SCHED; PG8_LDA(At, 0, 0); PG8_STAGE(PG8_SA(1, 1), a1 + hstepA, voffA);
            PG8_WAIT_V(8); PG8_WAIT_L(0); PG8_BAR; PG8_MMA(0, 0, At, B0); PG8_MMA(0, 1, At, B1); PG8_BAR; PG8_SCHED;
            PG8_LDA(At, 0, 1); PG8_STAGE(PG8_SB(0, 0), b2, voffB); PG8_STAGE(PG8_SB(0, 1), b2 + hstepB, voffB); PG8_STAGE(PG8_SA(0, 0), a2, voffA);
            PG8_WAIT_V(8); PG8_WAIT_L(0); PG8_BAR; PG8_MMA(1, 0, At, B0); PG8_MMA(1, 1, At, B1); PG8_BAR; PG8_SCHED;
            PG8_LDB(B0, 1, 0); PG8_LDB(B1, 1, 1); PG8_SCHED; PG8_LDA(At, 1, 0); PG8_STAGE(PG8_SA(0, 1), a2 + hstepA, voffA);
            PG8_WAIT_V(8); PG8_WAIT_L(0); PG8_BAR; PG8_MMA(0, 0, At, B0); PG8_MMA(0, 1, At, B1); PG8_BAR; PG8_SCHED;
            PG8_LDA(At, 1, 1); PG8_STAGE(PG8_SB(1, 0), b3, voffB); PG8_STAGE(PG8_SB(1, 1), b3 + hstepB, voffB); PG8_STAGE(PG8_SA(1, 0), a3, voffA);
            PG8_WAIT_V(8); PG8_WAIT_L(0); PG8_BAR; PG8_MMA(1, 0, At, B0); PG8_MMA(1, 1, At, B1); PG8_BAR; PG8_SCHED;
            } else {
            PG8_LDB(B0, 0, 0); PG8_SCHED; PG8_LDA(At, 0, 0); PG8_STAGE(PG8_SA(1, 1), a1 + hstepA, voffA);
            PG8_WAIT_L(8); PG8_BAR; PG8_WAIT_L(0); PG8_MMA(0, 0, At, B0); PG8_BAR; PG8_SCHED;
            PG8_LDB(B1, 0, 1); PG8_STAGE(PG8_SB(0, 0), b2, voffB);
            PG8_BAR; PG8_WAIT_L(0); PG8_MMA(0, 1, At, B1); PG8_BAR;
            PG8_LDA(At, 0, 1); PG8_STAGE(PG8_SA(0, 0), a2, voffA);
            PG8_BAR; PG8_WAIT_L(0); PG8_MMA(1, 0, At, B0); PG8_BAR; PG8_SCHED;
            PG8_STAGE(PG8_SB(0, 1), b2 + hstepB, voffB);
            PG8_WAIT_V(6); PG8_BAR; PG8_MMA(1, 1, At, B1); PG8_BAR;
            PG8_LDB(B0, 1, 0); PG8_SCHED; PG8_LDA(At, 1, 0); PG8_STAGE(PG8_SA(0, 1), a2 + hstepA, voffA);
            PG8_WAIT_L(8); PG8_BAR; PG8_WAIT_L(0); PG8_MMA(0, 0, At, B0); PG8_BAR; PG8_SCHED;
            PG8_LDB(B1, 1, 1); PG8_STAGE(PG8_SB(1, 0), b3, voffB);
            PG8_BAR; PG8_WAIT_L(0); PG8_MMA(0, 1, At, B1); PG8_BAR;
            PG8_LDA(At, 1, 1); PG8_STAGE(PG8_SA(1, 0), a3, voffA);
            PG8_BAR; PG8_WAIT_L(0); PG8_MMA(1, 0, At, B0); PG8_BAR; PG8_SCHED;
            PG8_STAGE(PG8_SB(1, 1), b3 + hstepB, voffB);
            PG8_WAIT_V(6); PG8_BAR; PG8_MMA(1, 1, At, B1); PG8_BAR;
            }
        }
        if constexpr (ALIGN_EPI) { if (wr == 0) PG8_BAR; }
        E(acc, cur, wr, wc, fr, fq); S.done(cur);
        if (!has_next) break;
#pragma unroll
        for (int a = 0; a < 2; ++a)
#pragma unroll
            for (int b = 0; b < 2; ++b)
#pragma unroll
                for (int m = 0; m < 4; ++m)
#pragma unroll
                    for (int n = 0; n < 2; ++n) acc[a][b][m][n] = (f32x4){0.f, 0.f, 0.f, 0.f};
        cur = nxt; cA = nA; cB = nB; nt = nt_nxt; ++ui;
        if constexpr (ALIGN_EPI) { if (wr == 1) PG8_BAR; }
    }
    PG8_WAIT_V(0);
    if constexpr (!ALIGN_EPI) { if (wr == 0) PG8_BAR; }
    PG8_BAR;
#undef PG8_BASEA
#undef PG8_BASEB
#undef PG8_SA
#undef PG8_SB
#undef PG8_STAGE
#undef PG8_LDA
#undef PG8_LDB
#undef PG8_MMA
#undef PG8_WAIT_V
#undef PG8_WAIT_L
#undef PG8_BAR
#undef PG8_SCHED
}
}

#define XB_TMO      128
#define XB_XCNT(j)  (256  + 64 * (j))
#define XB_XSUB(j)  (1280 + 64 * (j))
#define XB_XGEN(j)  (2304 + 64 * (j))
#define XB_TOP      3328
#define XB_TOPGEN   3392
#define XCD_BAR_WORDS 3456
#define XB_SPIN_CAP (1u << 22)
__device__ __forceinline__ unsigned xb_ld(unsigned* p)              { return __hip_atomic_load(p, __ATOMIC_RELAXED, __HIP_MEMORY_SCOPE_AGENT); }
__device__ __forceinline__ unsigned xb_add(unsigned* p, unsigned v) { return __hip_atomic_fetch_add(p, v, __ATOMIC_RELAXED, __HIP_MEMORY_SCOPE_AGENT); }
__device__ __forceinline__ unsigned xb_xcc_id() { return (unsigned)__builtin_amdgcn_s_getreg((3 << 11) | 20) & 0xFu; }
#define XB_SPIN(cond, bar) do { unsigned _sp = 0; while (cond) { __builtin_amdgcn_s_sleep(1); \
    if ((++_sp & 255u) == 0u) { if (xb_ld(&(bar)[XB_TMO])) break; if (_sp > XB_SPIN_CAP) { atomicAdd(&(bar)[XB_TMO], 1u); break; } } } } while (0)
struct XcdBarrier { unsigned* bar; unsigned x; volatile LAS unsigned* st; int wave; };
__device__ __forceinline__ XcdBarrier xcd_barrier_post(unsigned* bar, volatile LAS unsigned* st) {
    XcdBarrier b; b.bar = bar; b.x = xb_xcc_id(); b.st = st;
    if (threadIdx.x == 0) (void)xb_add(&bar[XB_XCNT(b.x)], 1u);
    return b;
}
__device__ __forceinline__ void xcd_barrier_complete(unsigned* bar, unsigned x, unsigned& nloc, unsigned& nx) {
    const unsigned G = gridDim.x * gridDim.y * gridDim.z;
    unsigned sum, cnt, mine, sp = 0u;
    for (;;) {
        sum = 0u; cnt = 0u; mine = 0u;
#pragma unroll
        for (unsigned j = 0; j < 16; ++j) { const unsigned c = xb_ld(&bar[XB_XCNT(j)]); sum += c; cnt += (c > 0u) ? 1u : 0u; mine = (j == x) ? c : mine; }
        if (sum == G) break;
        __builtin_amdgcn_s_sleep(1);
        if ((++sp & 255u) == 0u) { if (xb_ld(&bar[XB_TMO])) break; if (sp > XB_SPIN_CAP) { atomicAdd(&bar[XB_TMO], 1u); break; } }
    }
    nloc = mine > 0u ? mine : 1u; nx = cnt > 0u ? cnt : 1u;
}
__device__ __forceinline__ void xcd_barrier(const XcdBarrier& b) {
    asm volatile("s_waitcnt vmcnt(0)" ::: "memory");
    __syncthreads();
    if (b.wave == 0 && lane_id_asm() == 0) {
        unsigned* bar = b.bar; unsigned bx = b.x;
        asm volatile("" : "+s"(bar), "+s"(bx));
        __builtin_amdgcn_s_waitcnt(0);
        unsigned nloc = b.st[0], nx = b.st[1];
        if (nloc == 0u) { xcd_barrier_complete(bar, bx, nloc, nx); b.st[0] = nloc; b.st[1] = nx; }
        const unsigned old = xb_add(&bar[XB_XSUB(bx)], 1u);
        const unsigned gen = old / nloc;
        if (old + 1u == (gen + 1u) * nloc) {
            __builtin_amdgcn_fence(__ATOMIC_RELEASE, "agent");
            asm volatile("s_waitcnt vmcnt(0)" ::: "memory");
            const unsigned og = xb_add(&bar[XB_TOP], 1u);
            const unsigned tg = og / nx;
            if (og + 1u == (tg + 1u) * nx) xb_add(&bar[XB_TOPGEN], 1u);
            else XB_SPIN(xb_ld(&bar[XB_TOPGEN]) == tg, bar);
            __builtin_amdgcn_fence(__ATOMIC_ACQUIRE, "agent");
            xb_add(&bar[XB_XGEN(bx)], 1u);
            asm volatile("s_waitcnt vmcnt(0)" ::: "memory");
        } else {
            XB_SPIN(xb_ld(&bar[XB_XGEN(bx)]) == gen, bar);
            __builtin_amdgcn_fence(__ATOMIC_ACQUIRE, "agent");
            asm volatile("s_waitcnt vmcnt(0)" ::: "memory");
        }
    }
    __syncthreads();
}

constexpr int D = 2048, SEQ = 8192, M = 16384, DFF = 8192;
constexpr int NSA_N = 5376;
constexpr int NSA_N1 = 4096;
constexpr int DIL_N = 18432;
constexpr int DRNN = 2688, RG_N = 5632;
constexpr int RG_XOFF = 2816;
constexpr int NWAVES = 8, NTHREADS = 512;
constexpr int LDV = M + 64;
constexpr float ATT_SCALE = 0.08838834764831845f;
constexpr float NORM_EPS = 1e-6f;

constexpr int IN_X = 0, IN_C = 1, IN_NORMF = 45;
__host__ __device__ __forceinline__ constexpr int layer_base(int li) { return li == 0 ? 2 : li == 1 ? 13 : li == 2 ? 21 : 34; }
__host__ __device__ __forceinline__ constexpr int ff_off(int li) { return li == 1 ? 5 : li == 2 ? 10 : 8; }
__host__ __device__ __forceinline__ constexpr int wout_off(int li) { return li == 1 ? 4 : li == 2 ? 9 : 7; }

constexpr size_t MiB = 1u << 20;
constexpr size_t WS_CTL = 0, CTL_ZERO_BYTES = 1 * MiB;
constexpr size_t WS_MODP = 1 * MiB;
constexpr size_t WS_MOD = 4 * MiB;
constexpr size_t WS_COS = 5 * MiB, WS_SIN = 7 * MiB;
constexpr size_t WS_BPEP = 9 * MiB;
constexpr size_t WS_BPE = 9 * MiB + 512 * 1024;
constexpr size_t WS_LSP = 9 * MiB + 768 * 1024;
constexpr size_t WS_W = 10 * MiB;
constexpr size_t WE_NSA_WIN = 0, WE_NSA_W1 = 11010048, WE_NSA_WOUT = 11010048 + 4194304, WE_NSA_SZ = 19398656;
constexpr size_t WE_DIL = 2 * WE_NSA_SZ, WE_DIL_WOUT = WE_DIL + 37748736;
constexpr size_t WE_RG = WE_DIL + 41943040, WE_RG_WG = WE_RG + 11534336, WE_RG_WOUT = WE_RG_WG + 14450688;
constexpr size_t WE_FF = WE_RG + 31490048;
constexpr size_t WE_END = WE_FF + 4 * (size_t)33554432;
static_assert(WE_END == 246448128, "weight map");
constexpr size_t WS_HN = 482 * MiB;
constexpr size_t WS_ATT = 546 * MiB;
constexpr size_t WS_XR = 630 * MiB;
constexpr size_t WS_BIG = 694 * MiB;
static_assert(WS_W + WE_END * 2 <= WS_HN, "ws map");
constexpr size_t NS_Q = WS_BIG, NS_QR = NS_Q + 64 * MiB, NS_PK = NS_QR + 64 * MiB, NS_PV = NS_PK + 16 * MiB, NS_KS = NS_PV + 16 * MiB, NS_KW = NS_KS + 16 * MiB,
                 NS_VT = NS_KW + 16 * MiB  , NS_GT = NS_VT + 34 * MiB, NS_HC = NS_GT + 4 * MiB, NS_KC = NS_HC + 32 * MiB  ,
                 NS_VCT = NS_KC + 1 * MiB  , NS_END = NS_VCT + 1 * MiB;
constexpr size_t RG_YX = WS_BIG, RG_X = RG_YX + 176 * MiB, RG_A = RG_X + 84 * MiB, RG_B = RG_A + 168 * MiB, RG_CA = RG_B + 168 * MiB, RG_CB = RG_CA + 3 * MiB;
constexpr size_t DL_QK = WS_BIG, DL_VT = WS_BIG + 384 * MiB, DL_VT_STRIDE = 66 * MiB, DL_ML = WS_BIG + 582 * MiB;
constexpr size_t WS_END = WS_BIG + 610 * MiB;
static_assert(RG_CB + 3 * MiB <= WS_END && NS_END <= WS_END && DL_ML + 2 * MiB <= WS_END && WS_END <= (size_t)1396 * MiB, "ws map");

constexpr int RING_BYTES = 147456, MISC_OFF = RING_BYTES + 320, LDS_BYTES = 163840;

struct Params { const float* in[46]; float* out; unsigned char* ws; };

__device__ __forceinline__ float lo_bf(unsigned w) { return __uint_as_float(w << 16); }
__device__ __forceinline__ float hi_bf(unsigned w) { return __uint_as_float(w & 0xffff0000u); }
__device__ __forceinline__ unsigned pk2(float lo, float hi) { return pg8::cvt_pk_bf16(lo, hi); }
__device__ __forceinline__ float wave_sum(float v) {
#pragma unroll
    for (int o = 1; o < 64; o <<= 1) v += __shfl_xor(v, o);
    return v;
}
__device__ __forceinline__ float wave_max(float v) {
#pragma unroll
    for (int o = 1; o < 64; o <<= 1) v = fmaxf(v, __shfl_xor(v, o));
    return v;
}
__device__ __forceinline__ float sigmoidf_(float x) { return 1.0f / (1.0f + __expf(-x)); }
__device__ __forceinline__ float gelu_tanh(float x) { const float u = 0.7978845608028654f * (x + 0.044715f * x * x * x); const float e = __expf(2.0f * u); return 0.5f * x * (2.0f - 2.0f / (e + 1.0f)); }
__device__ __forceinline__ int sigma_d(int pos) { return (pos & 1) * 64 + (pos >> 1); }
__device__ __forceinline__ void store8_bf16(bf16* p, const f32x4 v0, const f32x4 v1) {
    u32x4 w; w.x = pk2(v0[0], v0[1]); w.y = pk2(v0[2], v0[3]); w.z = pk2(v1[0], v1[1]); w.w = pk2(v1[2], v1[3]); *(u32x4*)p = w; }
__device__ __forceinline__ void rope8(f32x4& v0, f32x4& v1, const float* cosr, const float* sinr, int i0) {
    const f32x4 cs = *(const f32x4*)(cosr + i0), sn = *(const f32x4*)(sinr + i0);
    const f32x4 a = v0, b = v1;
    v0[0] = a[0] * cs[0] - a[1] * sn[0]; v0[1] = a[0] * sn[0] + a[1] * cs[0];
    v0[2] = a[2] * cs[1] - a[3] * sn[1]; v0[3] = a[2] * sn[1] + a[3] * cs[1];
    v1[0] = b[0] * cs[2] - b[1] * sn[2]; v1[1] = b[0] * sn[2] + b[1] * cs[2];
    v1[2] = b[2] * cs[3] - b[3] * sn[3]; v1[3] = b[2] * sn[3] + b[3] * cs[3];
}

__device__ __forceinline__ void rope8v(f32x4& v0, f32x4& v1, const f32x4 cs, const f32x4 sn) {
    const f32x4 a = v0, b = v1;
    v0[0] = a[0] * cs[0] - a[1] * sn[0]; v0[1] = a[0] * sn[0] + a[1] * cs[0];
    v0[2] = a[2] * cs[1] - a[3] * sn[1]; v0[3] = a[2] * sn[1] + a[3] * cs[1];
    v1[0] = b[0] * cs[2] - b[1] * sn[2]; v1[1] = b[0] * sn[2] + b[1] * cs[2];
    v1[2] = b[2] * cs[3] - b[3] * sn[3]; v1[3] = b[2] * sn[3] + b[3] * cs[3];
}
#define EPI_LOOP_ROWS for (int ai = 0; ai < 2; ++ai) _Pragma("unroll") for (int m = 0; m < 4; ++m)
struct EpiNsaIn {
    static constexpr bool PERM = true, AFTER_DRAIN = false;
    bf16 *Q, *QR, *PK, *PV, *KS, *KW; float* GT; const float *COS, *SIN;
    __device__ __forceinline__ void operator()(const f32x4 (&acc)[2][2][4][2], const pg8::Unit& u, int wr, int wc, int fr, int fq) const {
        const int pn = u.pn, row0 = u.pm * 256 + wr * 64 + fr, cl = wc * 32 + 8 * fq;
        const bool rot = pn < 8 || pn >= 12;
#pragma unroll
        for (int ai = 0; ai < 2; ++ai) {
            f32x4 cs[4], sn[4];
            if (rot) {
#pragma unroll
                for (int m = 0; m < 4; ++m) { const int t = (row0 + ai * 128 + m * 16) & (SEQ - 1); cs[m] = *(const f32x4*)(COS + (size_t)t * 64 + (cl >> 1)); sn[m] = *(const f32x4*)(SIN + (size_t)t * 64 + (cl >> 1)); } }
#pragma unroll
            for (int m = 0; m < 4; ++m) {
                const int row = row0 + ai * 128 + m * 16, t = row & (SEQ - 1), b = row >> 13;
#pragma unroll
                for (int bj = 0; bj < 2; ++bj) {
                    f32x4 v0 = acc[ai][bj][m][0], v1 = acc[ai][bj][m][1];
                    const int hh = (pn & 1) * 2 + bj;
                    if (pn < 8) {
                        const size_t o = (size_t)row * 2048 + pn * 256 + bj * 128 + cl;
                        store8_bf16(Q + o, v0, v1);
                        rope8v(v0, v1, cs[m], sn[m]);
                        store8_bf16(QR + o, v0, v1);
                    } else if (pn < 12) {
                        bf16* P = pn < 10 ? PK : PV;
                        const size_t o = ((size_t)((b * 4 + hh) * 512 + (t >> 4))) * 2048 + (t & 15) * 128 + cl;
                        store8_bf16(P + o, v0, v1);
                    } else {
                        bf16* P = pn < 14 ? KS : KW;
                        rope8v(v0, v1, cs[m], sn[m]);
                        store8_bf16(P + (size_t)row * 512 + hh * 128 + cl, v0, v1);
                    }
                }
            }
        }
    }
};
struct EpiGates {
    static constexpr bool PERM = true, AFTER_DRAIN = false;
    float* GT;
    __device__ __forceinline__ void operator()(const f32x4 (&acc)[2][2][4][2], const pg8::Unit& u, int wr, int wc, int fr, int fq) const {
        const int row0 = u.pm * 256 + wr * 64 + fr, cl = wc * 32 + 8 * fq;
        if (cl < 48) {
#pragma unroll
            EPI_LOOP_ROWS { const int row = row0 + ai * 128 + m * 16; const f32x4 v0 = acc[ai][0][m][0], v1 = acc[ai][0][m][1];
#pragma unroll
                for (int e = 0; e < 4; ++e) { GT[(size_t)row * 48 + cl + e] = sigmoidf_(v0[e]); GT[(size_t)row * 48 + cl + 4 + e] = sigmoidf_(v1[e]); } }
        }
    }
};
struct EpiDilQK {
    static constexpr bool PERM = true, AFTER_DRAIN = false;
    bf16* O; const float *COS, *SIN; int dsh;
    __device__ __forceinline__ void operator()(const f32x4 (&acc)[2][2][4][2], const pg8::Unit& u, int wr, int wc, int fr, int fq) const {
        const int pn = u.pn, row0 = u.pm * 256 + wr * 64 + fr, cl = wc * 32 + 8 * fq, sh = 13 - dsh;
#pragma unroll
        for (int ai = 0; ai < 2; ++ai) {
            f32x4 cs[4], sn[4];
#pragma unroll
            for (int m = 0; m < 4; ++m) { const int row = row0 + ai * 128 + m * 16, rem = row & (SEQ - 1), t = ((rem & ((1 << sh) - 1)) << dsh) + (rem >> sh);
                cs[m] = *(const f32x4*)(COS + (size_t)t * 64 + (cl >> 1)); sn[m] = *(const f32x4*)(SIN + (size_t)t * 64 + (cl >> 1)); }
#pragma unroll
            for (int m = 0; m < 4; ++m) { const int row = row0 + ai * 128 + m * 16;
#pragma unroll
                for (int bj = 0; bj < 2; ++bj) {
                    f32x4 v0 = acc[ai][bj][m][0], v1 = acc[ai][bj][m][1];
                    rope8v(v0, v1, cs[m], sn[m]);
                    store8_bf16(O + (size_t)row * 4096 + pn * 256 + bj * 128 + cl, v0, v1);
                } }
        }
    }
};
template <int ACT> struct EpiBf16 {
    static constexpr bool PERM = true, AFTER_DRAIN = false;
    bf16* O; int ldc; int act_tiles;
    __device__ __forceinline__ void operator()(const f32x4 (&acc)[2][2][4][2], const pg8::Unit& u, int wr, int wc, int fr, int fq) const {
        const int pn = u.pn, row0 = u.pm * 256 + wr * 64 + fr, cl = wc * 32 + 8 * fq;
        const bool act = pn < act_tiles;
#pragma unroll
        EPI_LOOP_ROWS {
            const int row = row0 + ai * 128 + m * 16;
#pragma unroll
            for (int bj = 0; bj < 2; ++bj) {
                f32x4 v0 = acc[ai][bj][m][0], v1 = acc[ai][bj][m][1];
                if (ACT == 1) {
#pragma unroll
                    for (int e = 0; e < 4; ++e) { const float a = fmaxf(v0[e], 0.f), c = fmaxf(v1[e], 0.f); v0[e] = a * a; v1[e] = c * c; }
                }
                if (ACT == 2) { if (act) {
#pragma unroll
                    for (int e = 0; e < 4; ++e) { v0[e] = gelu_tanh(v0[e]); v1[e] = gelu_tanh(v1[e]); } } }
                store8_bf16(O + (size_t)row * ldc + pn * 256 + bj * 128 + cl, v0, v1);
            }
        }
    }
};
struct EpiF32 {
    static constexpr bool PERM = false, AFTER_DRAIN = false;
    float* C; int ldc;
    __device__ __forceinline__ void operator()(const f32x4 (&acc)[2][2][4][2], const pg8::Unit& u, int wr, int wc, int fr, int fq) const {
        const int row0 = u.pm * 256 + wr * 64 + fr, col0 = u.pn * 256 + wc * 32 + 4 * fq;
#pragma unroll
        EPI_LOOP_ROWS {
            float* rowp = C + (size_t)(row0 + ai * 128 + m * 16) * ldc + col0;
#pragma unroll
            for (int bj = 0; bj < 2; ++bj)
#pragma unroll
                for (int n = 0; n < 2; ++n) *(f32x4*)(rowp + bj * 128 + n * 16) = acc[ai][bj][m][n];
        }
    }
};
struct EpiRes {
    static constexpr bool PERM = true, AFTER_DRAIN = false;
    const float* xin32; const bf16* xin16; bf16* out; const float* gate;
    __device__ __forceinline__ void operator()(const f32x4 (&acc)[2][2][4][2], const pg8::Unit& u, int wr, int wc, int fr, int fq) const {
        const int row0 = u.pm * 256 + wr * 64 + fr, cl = wc * 32 + 8 * fq, b = (u.pm * 256) >> 13;
        f32x4 g0[2], g1[2];
#pragma unroll
        for (int bj = 0; bj < 2; ++bj) { const float* gp = gate + (size_t)b * 12288 + u.pn * 256 + bj * 128 + cl; g0[bj] = *(const f32x4*)gp; g1[bj] = *(const f32x4*)(gp + 4); }
#pragma unroll
        for (int ai = 0; ai < 2; ++ai) {
            f32x4 x0[4][2], x1[4][2];
#pragma unroll
            for (int m = 0; m < 4; ++m)
#pragma unroll
                for (int bj = 0; bj < 2; ++bj) { const size_t o = (size_t)(row0 + ai * 128 + m * 16) * D + u.pn * 256 + bj * 128 + cl;
                    if (xin32) { x0[m][bj] = *(const f32x4*)(xin32 + o); x1[m][bj] = *(const f32x4*)(xin32 + o + 4); }
                    else { const u32x4 w = *(const u32x4*)(xin16 + o); x0[m][bj] = (f32x4){lo_bf(w.x), hi_bf(w.x), lo_bf(w.y), hi_bf(w.y)}; x1[m][bj] = (f32x4){lo_bf(w.z), hi_bf(w.z), lo_bf(w.w), hi_bf(w.w)}; } }
#pragma unroll
            for (int m = 0; m < 4; ++m)
#pragma unroll
                for (int bj = 0; bj < 2; ++bj) store8_bf16(out + (size_t)(row0 + ai * 128 + m * 16) * D + u.pn * 256 + bj * 128 + cl, x0[m][bj] + g0[bj] * acc[ai][bj][m][0], x1[m][bj] + g1[bj] * acc[ai][bj][m][1]);
        }
    }
};
struct EpiRgGate {
    static constexpr bool PERM = true, AFTER_DRAIN = false;
    const bf16* X; const float *bgate, *LSP; unsigned* AB;
    __device__ __forceinline__ void operator()(const f32x4 (&acc)[2][2][4][2], const pg8::Unit& u, int wr, int wc, int fr, int fq) const {
        const int row0 = u.pm * 256 + wr * 64 + fr, ch0 = u.pn * 128 + wc * 32 + 8 * fq;
        u32x4 xw[2][4];
#pragma unroll
        for (int ai = 0; ai < 2; ++ai)
#pragma unroll
            for (int m = 0; m < 4; ++m) xw[ai][m] = *(const u32x4*)(X + (size_t)(row0 + ai * 128 + m * 16) * DRNN + ch0);
        const f32x4 br0 = *(const f32x4*)(bgate + ch0), br1 = *(const f32x4*)(bgate + ch0 + 4);
        const f32x4 bi0 = *(const f32x4*)(bgate + DRNN + ch0), bi1 = *(const f32x4*)(bgate + DRNN + ch0 + 4);
        const f32x4 ls0 = *(const f32x4*)(LSP + ch0), ls1 = *(const f32x4*)(LSP + ch0 + 4);
#pragma unroll
        EPI_LOOP_ROWS {
            const size_t o = (size_t)(row0 + ai * 128 + m * 16) * DRNN + ch0;
            const u32x4 xv = xw[ai][m];
            const f32x4 x0 = (f32x4){lo_bf(xv.x), hi_bf(xv.x), lo_bf(xv.y), hi_bf(xv.y)}, x1 = (f32x4){lo_bf(xv.z), hi_bf(xv.z), lo_bf(xv.w), hi_bf(xv.w)};
            const f32x4 r0 = acc[ai][0][m][0] + br0, r1 = acc[ai][0][m][1] + br1, i0 = acc[ai][1][m][0] + bi0, i1 = acc[ai][1][m][1] + bi1;
            u32x4 w0, w1;
#pragma unroll
            for (int e = 0; e < 4; ++e) {
                float la = ls0[e] * sigmoidf_(r0[e]); float bb = sqrtf(fmaxf(-expm1f(2.0f * la), 0.f)) * (sigmoidf_(i0[e]) * x0[e]); w0[e] = pk2(la * 1.4426950408889634f, bb);
                la = ls1[e] * sigmoidf_(r1[e]); bb = sqrtf(fmaxf(-expm1f(2.0f * la), 0.f)) * (sigmoidf_(i1[e]) * x1[e]); w1[e] = pk2(la * 1.4426950408889634f, bb);
            }
            *(u32x4*)(AB + o) = w0; *(u32x4*)(AB + o + 4) = w1;
        }
    }
};

__device__ __forceinline__ const float* inp(const Params& P, int i) { i = __builtin_amdgcn_readfirstlane(i); asm volatile("" : "+s"(i)); return P.in[i]; }
enum { MAP_ID = 0, MAP_NSA = 1, MAP_DIL = 2, MAP_RG = 3 };
struct Job { const float* W; int ldw, K; bf16* WT; int ldt, n_begin, n_rows, map, srcoff; };
__device__ __forceinline__ int srccol(int map, int n, int srcoff) {
    if (map == MAP_ID) return n + srcoff;
    if (map == MAP_NSA) {
        if (n < 2048) return (n & ~127) + sigma_d(n & 127);
        if (n < 3072) return n;
        if (n < 3584) return (n & ~127) + sigma_d(n & 127);
        if (n < 4096) return ((n + 512) & ~127) + sigma_d(n & 127);
        if (n < 4144) return 5120 + (n - 4096);
        if (n < 4352) return -1;
        if (n < 4864) return n - 768;
        return n - 256;
    }
    if (map == MAP_DIL) { const int j = (n >> 11) % 3; return j < 2 ? (n & ~127) + sigma_d(n & 127) : n; }
    if (n < DRNN) return n; if (n < RG_XOFF) return -1; if (n < RG_XOFF + DRNN) return n - (RG_XOFF - DRNN); return -1;
}
__device__ __forceinline__ bool is_sigma(int map, int n) {
    if (map == MAP_NSA) return n < 2048 || (n >= 3072 && n < 4096);
    if (map == MAP_DIL) return ((n >> 11) % 3) < 2;
    return false;
}
__device__ __forceinline__ void conv_item(const Job& J, int item, LAS float* scr, int lane) {
    const int nblk = J.n_rows / 32, kb = item / nblk, nb = item % nblk, k0 = 64 * kb, n0 = J.n_begin + 32 * nb, nl0 = n0 - J.n_begin;
    const int ks = lane >> 3, c4 = lane & 7;
    const bool sig = is_sigma(J.map, nl0);
    const int dl0 = sig ? 8 * (c4 & 3) + (c4 >> 2) : 4 * c4, dstep = sig ? 2 : 1;
    const int sc4 = srccol(J.map, nl0 + dl0, J.srcoff);
    f32x4 v[8];
#pragma unroll
    for (int i = 0; i < 8; ++i) v[i] = sc4 >= 0 ? __builtin_nontemporal_load((const f32x4*)(J.W + (size_t)(k0 + 8 * i + ks) * J.ldw + sc4)) : (f32x4){0.f, 0.f, 0.f, 0.f};
#pragma unroll
    for (int i = 0; i < 8; ++i) { LAS float* d = scr + (8 * i + ks) * 33 + dl0; d[0] = v[i][0]; d[dstep] = v[i][1]; d[2 * dstep] = v[i][2]; d[3 * dstep] = v[i][3]; }
    LDS_WAIT();
    const int c = lane & 7;
#pragma unroll
    for (int j = 0; j < 4; ++j) { const int n = (lane >> 3) + 8 * j; const LAS float* sp = scr + (8 * c) * 33 + n;
        u32x4 o; o.x = pk2(sp[0 * 33], sp[1 * 33]); o.y = pk2(sp[2 * 33], sp[3 * 33]); o.z = pk2(sp[4 * 33], sp[5 * 33]); o.w = pk2(sp[6 * 33], sp[7 * 33]);
        *(u32x4*)(J.WT + (size_t)(n0 + n) * J.ldt + k0 + 8 * c) = o; }
    LDS_WAIT();
}
constexpr int NJOBS = 24;
__device__ __forceinline__ Job get_job(const Params& P, int jid) {
    bf16* WB = (bf16*)(P.ws + WS_W);
    Job J; J.srcoff = 0; J.map = MAP_ID; J.n_begin = 0;
    if (jid < 12) {
        const int slot = jid / 6, r = jid % 6, bi = slot == 0 ? 2 : 34; bf16* base = WB + (size_t)slot * WE_NSA_SZ;
        if (r == 0) { J.W = inp(P, bi + 3); J.ldw = 5168; J.K = 2048; J.WT = base + WE_NSA_WIN; J.ldt = 2048; J.n_rows = NSA_N; J.map = MAP_NSA; }
        else if (r < 5) { const int kv = (r - 1) >> 1, half = (r - 1) & 1;
            J.W = inp(P, bi + 5) + (size_t)kv * 4096 * 512 + (size_t)half * 2048 * 512; J.ldw = 512; J.K = 2048;
            J.WT = base + WE_NSA_W1 + (size_t)kv * 1024 * 2048; J.ldt = 2048; J.n_begin = half * 512; J.n_rows = 512; }
        else { J.W = inp(P, bi + 7); J.ldw = 2048; J.K = 2048; J.WT = base + WE_NSA_WOUT; J.ldt = 2048; J.n_rows = 2048; }
    } else if (jid == 12) { J.W = inp(P, 13 + 3); J.ldw = DIL_N; J.K = 2048; J.WT = WB + WE_DIL; J.ldt = 2048; J.n_rows = DIL_N; J.map = MAP_DIL; }
    else if (jid == 13) { J.W = inp(P, 13 + 4); J.ldw = 2048; J.K = 2048; J.WT = WB + WE_DIL_WOUT; J.ldt = 2048; J.n_rows = 2048; }
    else if (jid == 14) { J.W = inp(P, 21 + 3); J.ldw = 2 * DRNN; J.K = 2048; J.WT = WB + WE_RG; J.ldt = 2048; J.n_rows = RG_N; J.map = MAP_RG; }
    else if (jid == 15) { J.W = inp(P, 21 + 9); J.ldw = 2048; J.K = DRNN; J.WT = WB + WE_RG_WOUT; J.ldt = DRNN; J.n_rows = 2048; }
    else { const int li = (jid - 16) >> 1, w = (jid - 16) & 1, bi = layer_base(li) + ff_off(li);
        if (w == 0) { J.W = inp(P, bi + 1); J.ldw = DFF; J.K = 2048; J.WT = WB + WE_FF + (size_t)li * 33554432; J.ldt = 2048; J.n_rows = DFF; }
        else { J.W = inp(P, bi + 2); J.ldw = 2048; J.K = DFF; J.WT = WB + WE_FF + (size_t)li * 33554432 + 16777216; J.ldt = DFF; J.n_rows = 2048; } }
    return J;
}

namespace fa {
typedef float f32x16 __attribute__((ext_vector_type(16)));
typedef short bf16x8 __attribute__((ext_vector_type(8)));
constexpr int KROW = 272, VROW = 144, KTILE = 64 * KROW, VTILE = 128 * VROW;
constexpr int KBUF0 = 0, VBUF0 = 3 * KTILE, IMP_OFF = VBUF0 + 2 * VTILE, MSK_OFF = RING_BYTES - 1024;
static_assert(IMP_OFF + 32768 <= MSK_OFF, "attention LDS map");
static_assert(MSK_OFF + 1024 <= RING_BYTES, "attention LDS map");
constexpr float C2 = ATT_SCALE * 1.4426950408889634f;
#define FA_MFMA(a, b, c) __builtin_amdgcn_mfma_f32_32x32x16_bf16(a, b, c, 0, 0, 0)
__device__ __forceinline__ float half_max(float v) { auto rr = __builtin_amdgcn_permlane32_swap(__float_as_uint(v), __float_as_uint(v), false, false); return fmaxf(__uint_as_float(rr[0]), __uint_as_float(rr[1])); }
__device__ __forceinline__ float half_sum(float v) { auto rr = __builtin_amdgcn_permlane32_swap(__float_as_uint(v), __float_as_uint(v), false, false); return __uint_as_float(rr[0]) + __uint_as_float(rr[1]); }
struct Src { const bf16* K0; long ldk; const bf16* V0; long ldv; int tsh; };
struct Stage { u32x4 k0, k1, v0, v1; };
__device__ __forceinline__ void stage_load_k(Stage& s, const Src& src, int T, int tid) {
    const int kr = tid >> 4, kc = tid & 15;
    const char* kb = (const char*)(src.K0 + (long)(64 * (T >> src.tsh)) * src.ldk); const char* kb2 = kb + 64 * src.ldk;
    unsigned ko = (unsigned)(kr * (int)src.ldk + kc * 8) * 2u; asm volatile("" : "+v"(ko));
    s.k0 = *(const u32x4*)(kb + ko); s.k1 = *(const u32x4*)(kb2 + ko);
}
__device__ __forceinline__ void stage_load_v(Stage& s, const Src& src, int T, int tid) {
    const int vr = tid >> 3, vp = tid & 7;
    const char* vb = (const char*)(src.V0 + 64 * (T >> src.tsh)); const char* vb2 = vb + 128 * src.ldv;
    unsigned vo = (unsigned)(vr * (int)src.ldv + vp * 8) * 2u; asm volatile("" : "+v"(vo));
    s.v0 = *(const u32x4*)(vb + vo); s.v1 = *(const u32x4*)(vb2 + vo);
}
__device__ __forceinline__ void stage_load(Stage& s, const Src& src, int T, int tid, bool withV) { stage_load_k(s, src, T, tid); if (withV) stage_load_v(s, src, T, tid); }
__device__ __forceinline__ void stage_write_k_at(const Stage& s, LAS unsigned char* ktile, int tid) {
    const int kr = tid >> 4, kc = tid & 15;
    LAS unsigned char* kb = ktile + kr * KROW + kc * 16;
    *(LAS u32x4*)kb = s.k0; *(LAS u32x4*)(kb + 32 * KROW) = s.k1;
}
__device__ __forceinline__ void stage_write_k(const Stage& s, LAS unsigned char* lds, int kbuf, int tid) { stage_write_k_at(s, lds + KBUF0 + kbuf * KTILE, tid); }
__device__ __forceinline__ void stage_write_v_at(const Stage& s, LAS unsigned char* vtile, int tid);
__device__ __forceinline__ void stage_write_v(const Stage& s, LAS unsigned char* lds, int vbuf, int tid) { stage_write_v_at(s, lds + VBUF0 + vbuf * VTILE, tid); }
__device__ __forceinline__ void stage_write_v_at(const Stage& s, LAS unsigned char* vtile, int tid) {
    const int vr = tid >> 3, vp = tid & 7, g16 = vp >> 1, half = vp & 1;
    LAS unsigned char* vb = vtile + vr * VROW + g16 * 32 + half * 8;
    *(LAS u32x2*)(vb) = (u32x2){s.v0.x, s.v0.y}; *(LAS u32x2*)(vb + 16) = (u32x2){s.v0.z, s.v0.w};
    *(LAS u32x2*)(vb + 64 * VROW) = (u32x2){s.v1.x, s.v1.y}; *(LAS u32x2*)(vb + 64 * VROW + 16) = (u32x2){s.v1.z, s.v1.w};
}
__device__ __forceinline__ void stage_write(const Stage& s, LAS unsigned char* lds, int buf, int tid, bool withV) { stage_write_k(s, lds, buf, tid); if (withV) stage_write_v(s, lds, buf, tid); }
__device__ __forceinline__ void load_q(bf16x8 (&qf)[8], const bf16* qrow, int hi) {
#pragma unroll
    for (int kk = 0; kk < 8; ++kk) qf[kk] = *(const bf16x8*)(qrow + kk * 16 + hi * 8);
}
#define FA_PIPE_16() do { __builtin_amdgcn_sched_group_barrier(0x100, 4, 0); \
    _Pragma("unroll") for (int i_ = 0; i_ < 12; ++i_) { __builtin_amdgcn_sched_group_barrier(0x008, 1, 0); __builtin_amdgcn_sched_group_barrier(0x100, 1, 0); } \
    __builtin_amdgcn_sched_group_barrier(0x008, 4, 0); } while (0)
__device__ __forceinline__ void qk_tile_at(f32x16& p0, f32x16& p1, const LAS unsigned char* ktile, const bf16x8 (&qf)[8], int c32, int hi);
__device__ __forceinline__ void qk_tile(f32x16& p0, f32x16& p1, const LAS unsigned char* lds, int buf, const bf16x8 (&qf)[8], int c32, int hi) { qk_tile_at(p0, p1, lds + KBUF0 + buf * KTILE, qf, c32, hi); }
__device__ __forceinline__ void qk_tile_at(f32x16& p0, f32x16& p1, const LAS unsigned char* ktile, const bf16x8 (&qf)[8], int c32, int hi) {
#pragma unroll
    for (int r = 0; r < 16; ++r) { p0[r] = 0.f; p1[r] = 0.f; }
    const LAS unsigned char* kb = ktile + c32 * KROW + hi * 16;
    bf16x8 a[16];
#pragma unroll
    for (int kk = 0; kk < 8; ++kk) { a[2 * kk] = *(const LAS bf16x8*)(kb + 32 * kk); a[2 * kk + 1] = *(const LAS bf16x8*)(kb + 32 * KROW + 32 * kk); }
#pragma unroll
    for (int kk = 0; kk < 8; ++kk) { p0 = FA_MFMA(a[2 * kk], qf[kk], p0); p1 = FA_MFMA(a[2 * kk + 1], qf[kk], p1); }
    FA_PIPE_16();
}
__device__ __forceinline__ void pv_tile_at(f32x16 (&o)[4], const LAS unsigned char* vtile, const bf16x8 (&pa)[4], int c32, int hi);
__device__ __forceinline__ void pv_tile(f32x16 (&o)[4], const LAS unsigned char* lds, int buf, const bf16x8 (&pa)[4], int c32, int hi) { pv_tile_at(o, lds + VBUF0 + buf * VTILE, pa, c32, hi); }
__device__ __forceinline__ void pv_tile_at(f32x16 (&o)[4], const LAS unsigned char* vtile, const bf16x8 (&pa)[4], int c32, int hi) {
    const LAS unsigned char* vb = vtile + c32 * VROW + hi * 16;
    bf16x8 a[16];
#pragma unroll
    for (int S = 0; S < 4; ++S)
#pragma unroll
        for (int db = 0; db < 4; ++db) a[4 * S + db] = *(const LAS bf16x8*)(vb + db * 32 * VROW + 32 * S);
#pragma unroll
    for (int S = 0; S < 4; ++S)
#pragma unroll
        for (int db = 0; db < 4; ++db) o[db] = FA_MFMA(a[4 * S + db], pa[S], o[db]);
    FA_PIPE_16();
}
__device__ __forceinline__ void mask_range(f32x16& p0, f32x16& p1, int lo, int hi_, int hi) {
    const int lo4 = lo - 4 * hi, hi4 = hi_ - 4 * hi;
#pragma unroll
    for (int r = 0; r < 16; ++r) { const int c = (r & 3) + 8 * (r >> 2);
        if (c < lo4 || c > hi4) p0[r] = -INFINITY;
        if (c + 32 < lo4 || c + 32 > hi4) p1[r] = -INFINITY; }
}
template <int B_> __device__ __forceinline__ bf16x8 pack8r(const f32x16& p) {
    u32x4 w; w.x = pk2(p[B_ + 0], p[B_ + 1]); w.y = pk2(p[B_ + 2], p[B_ + 3]); w.z = pk2(p[B_ + 4], p[B_ + 5]); w.w = pk2(p[B_ + 6], p[B_ + 7]);
    return __builtin_bit_cast(bf16x8, w); }
constexpr float THR = 8.0f;
__device__ __forceinline__ void softmax_step(f32x16& p0, f32x16& p1, bool rowoff, float& m, float& l, f32x16 (&o)[4], bf16x8 (&pa)[4]) {
    float mx = fmaxf(fmaxf(p0[0], p0[1]), p0[2]);
#pragma unroll
    for (int r = 3; r < 15; r += 2) mx = fmaxf(fmaxf(mx, p0[r]), p0[r + 1]);
    mx = fmaxf(mx, p0[15]);
#pragma unroll
    for (int r = 0; r < 16; r += 2) mx = fmaxf(fmaxf(mx, p1[r]), p1[r + 1]);
    mx = half_max(mx);
    if (rowoff) mx = -INFINITY;
    if (!__all((mx - m) * C2 <= THR)) {
        const float mn = fmaxf(m, mx), alpha = __builtin_amdgcn_exp2f((m - mn) * C2); m = mn; l *= alpha;
#pragma unroll
        for (int db = 0; db < 4; ++db) o[db] = o[db] * alpha;
    }
    const float mnL = rowoff ? -INFINITY : -m * C2;
    p0 = p0 * C2 + mnL; p1 = p1 * C2 + mnL;
#pragma unroll
    for (int r = 0; r < 16; ++r) { p0[r] = __builtin_amdgcn_exp2f(p0[r]); p1[r] = __builtin_amdgcn_exp2f(p1[r]); }
    f32x16 sv = p0 + p1;
    const float ps = ((sv[0] + sv[1]) + (sv[2] + sv[3])) + ((sv[4] + sv[5]) + (sv[6] + sv[7])) + (((sv[8] + sv[9]) + (sv[10] + sv[11])) + ((sv[12] + sv[13]) + (sv[14] + sv[15])));
    l += half_sum(ps);
    pa[0] = pack8r<0>(p0); pa[1] = pack8r<8>(p0); pa[2] = pack8r<0>(p1); pa[3] = pack8r<8>(p1);
}
struct Msk { int qlo, qhi; const LAS unsigned* sel; };
#define FA_PIPE_8() do { __builtin_amdgcn_sched_group_barrier(0x100, 4, 0); \
    _Pragma("unroll") for (int i_ = 0; i_ < 4; ++i_) { __builtin_amdgcn_sched_group_barrier(0x008, 1, 0); __builtin_amdgcn_sched_group_barrier(0x100, 1, 0); } \
    __builtin_amdgcn_sched_group_barrier(0x008, 4, 0); } while (0)
__device__ __forceinline__ void qk_half(f32x16& p, const LAS unsigned char* lds, int kbuf, int half, const bf16x8 (&qf)[8], int c32, int hi) {
#pragma unroll
    for (int r = 0; r < 16; ++r) p[r] = 0.f;
    const LAS unsigned char* kb = lds + KBUF0 + kbuf * KTILE + half * 32 * KROW + c32 * KROW + hi * 16;
    bf16x8 a[8];
#pragma unroll
    for (int kk = 0; kk < 8; ++kk) a[kk] = *(const LAS bf16x8*)(kb + 32 * kk);
#pragma unroll
    for (int kk = 0; kk < 8; ++kk) p = FA_MFMA(a[kk], qf[kk], p);
    FA_PIPE_8();
}
__device__ __forceinline__ void pv_half(f32x16 (&o)[4], const LAS unsigned char* lds, int vbuf, int half, const bf16x8 (&pa)[2], int c32, int hi) {
    const LAS unsigned char* vb = lds + VBUF0 + vbuf * VTILE + c32 * VROW + hi * 16 + half * 64;
    bf16x8 a[8];
#pragma unroll
    for (int s2 = 0; s2 < 2; ++s2)
#pragma unroll
        for (int db = 0; db < 4; ++db) a[4 * s2 + db] = *(const LAS bf16x8*)(vb + db * 32 * VROW + 32 * s2);
#pragma unroll
    for (int s2 = 0; s2 < 2; ++s2)
#pragma unroll
        for (int db = 0; db < 4; ++db) o[db] = FA_MFMA(a[4 * s2 + db], pa[s2], o[db]);
    FA_PIPE_8();
}
__device__ __forceinline__ void softmax_half(f32x16& p, int half, bool needrange, int lo, int hi_, int hi, bool rowoff, float& m, float& l, f32x16 (&o)[4], bf16x8 (&pa)[2]) {
    if (needrange) { const int lo4 = lo - 4 * hi - 32 * half, hi4 = hi_ - 4 * hi - 32 * half;
#pragma unroll
        for (int r = 0; r < 16; ++r) { const int c = (r & 3) + 8 * (r >> 2); if (c < lo4 || c > hi4) p[r] = -INFINITY; } }
    float mx = fmaxf(fmaxf(p[0], p[1]), p[2]);
#pragma unroll
    for (int r = 3; r < 15; r += 2) mx = fmaxf(fmaxf(mx, p[r]), p[r + 1]);
    mx = half_max(fmaxf(mx, p[15]));
    if (rowoff) mx = -INFINITY;
    if (!__all((mx - m) * C2 <= THR)) {
        const float mn = fmaxf(m, mx), alpha = __builtin_amdgcn_exp2f((m - mn) * C2); m = mn; l *= alpha;
#pragma unroll
        for (int db = 0; db < 4; ++db) o[db] = o[db] * alpha;
    }
    const float mnL = rowoff ? -INFINITY : -m * C2;
#pragma unroll
    for (int r = 0; r < 16; ++r) p[r] = __builtin_amdgcn_exp2f(fmaf(p[r], C2, mnL));
    const float ps = (((p[0] + p[1]) + (p[2] + p[3])) + ((p[4] + p[5]) + (p[6] + p[7]))) + (((p[8] + p[9]) + (p[10] + p[11])) + ((p[12] + p[13]) + (p[14] + p[15])));
    l += half_sum(ps);
    pa[0] = pack8r<0>(p); pa[1] = pack8r<8>(p);
}
__device__ __forceinline__ void flash_flags(const Msk& mk, int Tt, int tsh, int& lo, int& hi_, bool& rowoff) {
    const int T = Tt >> tsh;
    lo = mk.qlo - 64 * T; hi_ = mk.qhi - 64 * T;
    rowoff = !(hi_ >= 0 && lo <= 63);
    if (mk.sel) { const unsigned w = mk.sel[T >> 5]; rowoff = rowoff || (((w >> (T & 31)) & 1u) == 0u); }
}
__device__ __forceinline__ void flash_pass(LAS unsigned char* lds, int tid, int c32, int hi, int T0, int T1, const Src& src, const Msk& mk, const bf16x8 (&qf)[8],
                                           float& m, float& l, f32x16 (&o)[4]) {
    Stage st; f32x16 sA, sB;
    const int n = T1 - T0 + 1; const bool lateqk = __builtin_amdgcn_readfirstlane(tid >> 8) != 0;
    __syncthreads();
    {   Stage st1;
        stage_load(st, src, T0, tid, true); if (n > 1) stage_load_k(st1, src, T0 + 1, tid);
        stage_write(st, lds, 0, tid, true); if (n > 1) stage_write_k(st1, lds, 1, tid); }
    if (n > 2) stage_load_k(st, src, T0 + 2, tid);
    if (n > 1) stage_load_v(st, src, T0 + 1, tid);
    __syncthreads();
    int lo, hi_; bool rowoff; flash_flags(mk, T0, src.tsh, lo, hi_, rowoff);
    bool act = !__all(rowoff);
    if (act) qk_half(sA, lds, 0, 0, qf, c32, hi);
#pragma unroll 1
    for (int i = 0; i < n; ++i) {
        if (i > 0) __syncthreads();
        if (i + 2 < n) stage_write_k(st, lds, (i + 2) % 3, tid);
        if (i + 1 < n) stage_write_v(st, lds, (i + 1) & 1, tid);
        if (i + 3 < n) stage_load_k(st, src, T0 + i + 3, tid);
        if (i + 2 < n) stage_load_v(st, src, T0 + i + 2, tid);
        const bool needrange = __any(!rowoff && !(lo <= 0 && hi_ >= 63));
        bf16x8 pa[2];
        if (act) { if (!lateqk) qk_half(sB, lds, i % 3, 1, qf, c32, hi);
                   softmax_half(sA, 0, needrange, lo, hi_, hi, rowoff, m, l, o, pa); pv_half(o, lds, i & 1, 0, pa, c32, hi);
                   if (lateqk) qk_half(sB, lds, i % 3, 1, qf, c32, hi); }
        int lo2 = 0, hi2 = 0; bool off2 = true, act2 = false;
        if (i + 1 < n) { flash_flags(mk, T0 + i + 1, src.tsh, lo2, hi2, off2); act2 = !__all(off2); }
        if (act2 && !lateqk) qk_half(sA, lds, (i + 1) % 3, 0, qf, c32, hi);
        if (act) { softmax_half(sB, 1, needrange, lo, hi_, hi, rowoff, m, l, o, pa); pv_half(o, lds, i & 1, 1, pa, c32, hi); }
        if (act2 && lateqk) qk_half(sA, lds, (i + 1) % 3, 0, qf, c32, hi);
        lo = lo2; hi_ = hi2; rowoff = off2; act = act2;
    }
}

constexpr int ASLOT = KTILE + VTILE;
constexpr int ANSLOT = 4;
static_assert(ANSLOT * ASLOT <= MSK_OFF, "async ring must not reach the selection masks");
__device__ __forceinline__ void lds_signal(volatile LAS unsigned* w, int lane) {
    asm volatile("s_waitcnt lgkmcnt(0)" ::: "memory");
    if (lane == 0) (void)__hip_atomic_fetch_add((LAS unsigned*)w, 1u, __ATOMIC_RELAXED, __HIP_MEMORY_SCOPE_WORKGROUP);
}
__device__ __forceinline__ void lds_wait(volatile LAS unsigned* w, unsigned target) {
    unsigned spins = 0;
    while ((unsigned)__builtin_amdgcn_readfirstlane(*w) < target) { __builtin_amdgcn_s_sleep(1); if (++spins > (1u << 22)) break; }
    asm volatile("" ::: "memory");
}
__device__ __forceinline__ void flash_pass_async(LAS unsigned char* lds, int tid, int lane, int c32, int hi, int T0, int T1, const Src& src, const Msk& mk, const bf16x8 (&qf)[8],
                                                 float& m, float& l, f32x16 (&o)[4]) {
    volatile LAS unsigned* fill = (volatile LAS unsigned*)(lds + RING_BYTES + 2048); volatile LAS unsigned* done = fill + 8;
    const int n = T1 - T0 + 1;
    Stage st;
    __syncthreads();
    if (tid < 16) fill[tid] = 0u;
    stage_load(st, src, T0, tid, true);
    __syncthreads();
    stage_write_k_at(st, lds, tid); stage_write_v_at(st, lds + KTILE, tid); lds_signal(fill + 0, lane);
    if (n > 1) stage_load(st, src, T0 + 1, tid, true);
#pragma unroll 1
    for (int i = 0; i < n; ++i) {
        const int s0 = i % ANSLOT;
        if (i + 1 < n) { const int s1 = (i + 1) % ANSLOT;
            lds_wait(done + s1, 8u * (unsigned)((i + 1) / ANSLOT));
            stage_write_k_at(st, lds + s1 * ASLOT, tid); stage_write_v_at(st, lds + s1 * ASLOT + KTILE, tid); lds_signal(fill + s1, lane);
            if (i + 2 < n) stage_load(st, src, T0 + i + 2, tid, true); }
        int lo, hi_; bool rowoff; flash_flags(mk, T0 + i, src.tsh, lo, hi_, rowoff);
        if (!__all(rowoff)) {
            lds_wait(fill + s0, 8u * (unsigned)(i / ANSLOT + 1));
            f32x16 p0, p1; bf16x8 pa[4];
            qk_tile_at(p0, p1, lds + s0 * ASLOT, qf, c32, hi);
            if (__any(!rowoff && !(lo <= 0 && hi_ >= 63))) mask_range(p0, p1, lo, hi_, hi);
            softmax_step(p0, p1, rowoff, m, l, o, pa);
            pv_tile_at(o, lds + s0 * ASLOT + KTILE, pa, c32, hi);
        }
        lds_signal(done + s0, lane);
    }
}
}

__device__ __forceinline__ void nsa_item(LAS unsigned char* lds, int wave, int lane, int b, int g, int c, const bf16* Q, const bf16* QR, const bf16* KCB, const bf16* VCT,
                                         const bf16* KS, const bf16* KW, const bf16* VT, const float* GT, float* OACC, bf16* ATT) {
    using namespace fa;
    const int tid = wave * 64 + lane, c32 = lane & 31, hi = lane >> 5;
    const int tl = wave * 8 + (c32 >> 2), head = c32 & 3, t = c * 64 + tl, mrow = b * SEQ + t, hq = g * 4 + head, bg = b * 4 + g;
    LAS float* IMP = (LAS float*)(lds + IMP_OFF); LAS unsigned* MSK = (LAS unsigned*)(lds + MSK_OFF);
    bf16x8 qf[8]; f32x16 o[4]; float m, l; u32x4 pk[8];
#define NSA_PTRS() int mr_ = mrow, hq_ = hq; asm volatile("" : "+v"(mr_), "+v"(hq_)); const float* gp = GT + (size_t)(mr_ * 48 + hq_ * 3); float* oacc = OACC + (size_t)mr_ * 2048 + (unsigned)(hq_ * 128); (void)gp; (void)oacc
    {
        { int mr_ = mrow, hq_ = hq; asm volatile("" : "+v"(mr_), "+v"(hq_)); load_q(qf, Q + (size_t)mr_ * 2048 + (unsigned)(hq_ * 128), hi); }
        const int NTc = (4 * c + 3 + 63) >> 6;
        const int qhi = (t - 31) >> 4;
        const Src src{KCB + (size_t)bg * 512 * 128, 128, VCT + (size_t)bg * 128 * 512, 512, 0};
        m = -1e30f; l = 0.f;
        Stage st;
        __syncthreads();
        stage_load(st, src, 0, tid, false);
#pragma unroll 1
        for (int T = 0; T < NTc; ++T) {
            const int buf = T & 1;
            stage_write(st, lds, buf, tid, false);
            __syncthreads();
            if (T + 1 < NTc) stage_load(st, src, T + 1, tid, false);
            f32x16 p0, p1;
            qk_tile(p0, p1, lds, buf, qf, c32, hi);
            mask_range(p0, p1, 0, qhi - 64 * T, hi);
            float mx = p0[0];
#pragma unroll
            for (int r = 1; r < 16; ++r) mx = fmaxf(mx, p0[r]);
#pragma unroll
            for (int r = 0; r < 16; ++r) mx = fmaxf(mx, p1[r]);
            mx = half_max(mx);
            const float mn = fmaxf(m, mx), alpha = __builtin_amdgcn_exp2f((m - mn) * C2), mnL = -mn * C2; m = mn;
            float ps = 0.f;
#pragma unroll
            for (int r = 0; r < 16; ++r) ps += __builtin_amdgcn_exp2f(fmaf(p0[r], C2, mnL)) + __builtin_amdgcn_exp2f(fmaf(p1[r], C2, mnL));
            l = l * alpha + half_sum(ps);
        }
        const float inv = l > 0.f ? 1.0f / l : 0.f, mnL = -m * C2;
#pragma unroll
        for (int db = 0; db < 4; ++db)
#pragma unroll
            for (int r = 0; r < 16; ++r) o[db][r] = 0.f;
        float carry = 0.f;
        __syncthreads();
        stage_load(st, src, 0, tid, true);
#pragma unroll 1
        for (int T = 0; T < NTc; ++T) {
            const int buf = T & 1;
            stage_write(st, lds, buf, tid, true);
            __syncthreads();
            if (T + 1 < NTc) stage_load(st, src, T + 1, tid, true);
            f32x16 p0, p1; bf16x8 pa[4];
            qk_tile(p0, p1, lds, buf, qf, c32, hi);
            mask_range(p0, p1, 0, qhi - 64 * T, hi);
#pragma unroll
            for (int r = 0; r < 16; ++r) { p0[r] = __builtin_amdgcn_exp2f(fmaf(p0[r], C2, mnL)) * inv; p1[r] = __builtin_amdgcn_exp2f(fmaf(p1[r], C2, mnL)) * inv; }
#pragma unroll
            for (int hf = 0; hf < 2; ++hf) {
                float qs[4], flo[4], fhi[4];
#pragma unroll
                for (int q4 = 0; q4 < 4; ++q4) {
                    const float e0 = hf ? p1[4 * q4] : p0[4 * q4], e1 = hf ? p1[4 * q4 + 1] : p0[4 * q4 + 1], e2 = hf ? p1[4 * q4 + 2] : p0[4 * q4 + 2], e3 = hf ? p1[4 * q4 + 3] : p0[4 * q4 + 3];
                    qs[q4] = (e0 + e1) + (e2 + e3);
                    auto rr = __builtin_amdgcn_permlane32_swap(__float_as_uint(e3), __float_as_uint(e3), false, false);
                    flo[q4] = __uint_as_float(rr[0]); fhi[q4] = __uint_as_float(rr[1]);
                }
#pragma unroll
                for (int q4 = 0; q4 < 4; ++q4) {
                    const float cin = hi ? flo[q4] : (q4 == 0 ? carry : fhi[q4 == 0 ? 0 : q4 - 1]);
                    float v = qs[q4] + cin; v += __shfl_xor(v, 1); v += __shfl_xor(v, 2);
                    if (head == 0) IMP[tl * 128 + 16 * T + 8 * hf + 2 * q4 + hi] = v;
                }
                carry = fhi[3];
            }
            pa[0] = pack8r<0>(p0); pa[1] = pack8r<8>(p0); pa[2] = pack8r<0>(p1); pa[3] = pack8r<8>(p1);
            pv_tile(o, lds, buf, pa, c32, hi);
        }
        NSA_PTRS();
        const float g0 = gp[0];
#pragma unroll
        for (int db = 0; db < 4; ++db)
#pragma unroll
            for (int q4 = 0; q4 < 4; ++q4) { pk[2 * db + (q4 >> 1)][2 * (q4 & 1)] = pk2(o[db][4 * q4] * g0, o[db][4 * q4 + 1] * g0); pk[2 * db + (q4 >> 1)][2 * (q4 & 1) + 1] = pk2(o[db][4 * q4 + 2] * g0, o[db][4 * q4 + 3] * g0); }
    }
    LDS_WAIT();
#ifndef REP_TOPK
#define REP_TOPK 1
#endif
#pragma unroll 1
    for (int rep_ = 0; rep_ < fresh_s(REP_TOPK); ++rep_)
#pragma unroll 1
    for (int tk = 0; tk < 8; ++tk) {
        LAS float* row = IMP + (wave * 8 + tk) * 128;
        const int j0 = lane, j1 = lane + 64;
        const float v0 = row[j0], v1 = row[j1];
        const float val0 = j0 > c ? -INFINITY : ((j0 == 0 || j0 == c || j0 == c - 1) ? 3.0e38f : v0);
        const float val1 = j1 > c ? -INFINITY : ((j1 == c || j1 == c - 1) ? 3.0e38f : v1);
        LDS_WAIT();
        row[j0] = val0; row[j1] = val1;
        LDS_WAIT();
        int cnt0 = 0, cnt1 = 0;
#pragma unroll 4
        for (int i4 = 0; i4 <= (c >> 2); ++i4) {
            const f32x4 x = *(const LAS f32x4*)(row + 4 * i4);
#pragma unroll
            for (int e = 0; e < 4; ++e) { const int i = 4 * i4 + e; cnt0 += (x[e] > val0 || (x[e] == val0 && i < j0)) ? 1 : 0; cnt1 += (x[e] > val1 || (x[e] == val1 && i < j1)) ? 1 : 0; } }
        const unsigned long long m0 = __ballot(j0 <= c && cnt0 < 16), m1 = __ballot(j1 <= c && cnt1 < 16);
        if (lane == 0) { LAS unsigned* mp = MSK + (wave * 8 + tk) * 4; mp[0] = (unsigned)m0; mp[1] = (unsigned)(m0 >> 32); mp[2] = (unsigned)m1; mp[3] = (unsigned)(m1 >> 32); }
    }
    LDS_WAIT();
    { int mr_ = mrow, hq_ = hq; asm volatile("" : "+v"(mr_), "+v"(hq_)); load_q(qf, QR + (size_t)mr_ * 2048 + (unsigned)(hq_ * 128), hi); }
    {
        Msk mk; mk.qlo = 0; mk.qhi = t; mk.sel = MSK + tl * 4;
        #ifdef PROBE_SEL2
        const Src src{KS + (size_t)b * SEQ * 512 + g * 128, 512, VT + (size_t)(g * 128) * LDV + (size_t)b * SEQ, LDV, 1};
#else
        const Src src{KS + (size_t)b * SEQ * 512 + g * 128, 512, VT + (size_t)(g * 128) * LDV + (size_t)b * SEQ, LDV, 0};
#endif
#ifndef REP_SEL
#define REP_SEL 1
#endif
        m = -1e30f; l = 0.f;
#pragma unroll
        for (int db = 0; db < 4; ++db)
#pragma unroll
            for (int r = 0; r < 16; ++r) o[db][r] = 0.f;
#ifdef PROBE_SEL2
        flash_pass(lds, tid, c32, hi, 0, 2 * c + 1, src, mk, qf, m, l, o);
#else
        flash_pass_async(lds, tid, lane, c32, hi, 0, c, src, mk, qf, m, l, o);
#endif
        NSA_PTRS();
        const float sc = gp[1] / l;
#pragma unroll
        for (int db = 0; db < 4; ++db)
#pragma unroll
            for (int q4 = 0; q4 < 4; ++q4) { const unsigned w0 = pk[2 * db + (q4 >> 1)][2 * (q4 & 1)], w1 = pk[2 * db + (q4 >> 1)][2 * (q4 & 1) + 1];
                pk[2 * db + (q4 >> 1)][2 * (q4 & 1)] = pk2(lo_bf(w0) + o[db][4 * q4] * sc, hi_bf(w0) + o[db][4 * q4 + 1] * sc);
                pk[2 * db + (q4 >> 1)][2 * (q4 & 1) + 1] = pk2(lo_bf(w1) + o[db][4 * q4 + 2] * sc, hi_bf(w1) + o[db][4 * q4 + 3] * sc); }
    }
    {
        Msk mk; mk.qlo = t - 511; mk.qhi = t; mk.sel = nullptr;
        const Src src{KW + (size_t)b * SEQ * 512 + g * 128, 512, VT + (size_t)(512 + g * 128) * LDV + (size_t)b * SEQ, LDV, 0};
        m = -1e30f; l = 0.f;
#pragma unroll
        for (int db = 0; db < 4; ++db)
#pragma unroll
            for (int r = 0; r < 16; ++r) o[db][r] = 0.f;
        flash_pass(lds, tid, c32, hi, c >= 8 ? c - 8 : 0, c, src, mk, qf, m, l, o);
        NSA_PTRS();
        const float sc = gp[2] / l;
        bf16* arow = ATT + (size_t)mr_ * 2048 + (unsigned)(hq_ * 128);
#pragma unroll
        for (int db = 0; db < 4; ++db)
#pragma unroll
            for (int qp = 0; qp < 2; ++qp) {
                unsigned f[2][2];
#pragma unroll
                for (int e = 0; e < 2; ++e) { const int q4 = 2 * qp + e; const unsigned w0 = pk[2 * db + qp][2 * e], w1 = pk[2 * db + qp][2 * e + 1];
                    f[e][0] = pk2(lo_bf(w0) + o[db][4 * q4] * sc, hi_bf(w0) + o[db][4 * q4 + 1] * sc); f[e][1] = pk2(lo_bf(w1) + o[db][4 * q4 + 2] * sc, hi_bf(w1) + o[db][4 * q4 + 3] * sc); }
                auto r0 = __builtin_amdgcn_permlane32_swap(f[0][0], f[1][0], false, false); auto r1 = __builtin_amdgcn_permlane32_swap(f[0][1], f[1][1], false, false);
                u32x4 w; w.x = r0[0]; w.y = r1[0]; w.z = r0[1]; w.w = r1[1];
                *(u32x4*)(arow + 32 * db + 16 * qp + 8 * hi) = w; }
    }
#undef NSA_PTRS
}

__device__ __forceinline__ void dil_item(LAS unsigned char* lds, int wave, int lane, int p, int sq, int h, int qb, const bf16* QK, const bf16* VT, bf16* OB, float* ML, bf16* ATT) {
    using namespace fa;
    const int tid = wave * 64 + lane, c32 = lane & 31, hi = lane >> 5, dsh = 2 * p, L = SEQ >> dsh;
    const int b = sq >> dsh, r = sq & ((1 << dsh) - 1), q = qb * 256 + wave * 32 + c32, mrow = b * SEQ + (q << dsh) + r;
    const size_t seqbase = (size_t)sq * L;
    bf16x8 qf[8]; f32x16 o[4]; float m = -1e30f, l = 0.f;
    load_q(qf, QK + (seqbase + q) * 4096 + h * 128, hi);
#pragma unroll
    for (int db = 0; db < 4; ++db)
#pragma unroll
        for (int rr = 0; rr < 16; ++rr) o[db][rr] = 0.f;
    Msk mk; mk.qlo = q - 128; mk.qhi = q; mk.sel = nullptr;
    const Src src{QK + seqbase * 4096 + 2048 + h * 128, 4096, VT + (size_t)(h * 128) * LDV + seqbase, LDV, 0};
    flash_pass(lds, tid, c32, hi, qb * 4 >= 2 ? qb * 4 - 2 : 0, qb * 4 + 3, src, mk, qf, m, l, o);
    int mr_ = mrow; asm volatile("" : "+v"(mr_));
    float sc2 = 1.0f / l, u0 = 0.f, u1 = 0.f;
    const bf16* ob0 = OB + (size_t)mr_ * 2048 + h * 128; const bf16* ob1 = ob0 + (size_t)M * 2048;
    if (p == 2) {
        const f32x2 ml0 = *(const f32x2*)(ML + ((size_t)mr_ * 16 + h) * 2), ml1 = *(const f32x2*)(ML + (size_t)M * 32 + ((size_t)mr_ * 16 + h) * 2);
        const float Mx = fmaxf(fmaxf(ml0[0], ml1[0]), m);
        u0 = ml0[1] * __builtin_amdgcn_exp2f((ml0[0] - Mx) * C2); u1 = ml1[1] * __builtin_amdgcn_exp2f((ml1[0] - Mx) * C2);
        const float e2 = __builtin_amdgcn_exp2f((m - Mx) * C2), iw = 1.0f / (u0 + u1 + l * e2);
        sc2 = e2 * iw; u0 *= iw; u1 *= iw;
    }
    bf16* orow = (p == 2 ? ATT : OB + (size_t)p * M * 2048) + (size_t)mr_ * 2048 + h * 128;
#pragma unroll
    for (int db = 0; db < 4; ++db)
#pragma unroll
        for (int qp = 0; qp < 2; ++qp) {
            f32x4 v[2];
#pragma unroll
            for (int e = 0; e < 2; ++e) { const int q4 = 2 * qp + e; v[e] = (f32x4){o[db][4 * q4] * sc2, o[db][4 * q4 + 1] * sc2, o[db][4 * q4 + 2] * sc2, o[db][4 * q4 + 3] * sc2}; }
            if (p == 2) {
                const u32x4 w0 = *(const u32x4*)(ob0 + 32 * db + 16 * qp + 8 * hi), w1 = *(const u32x4*)(ob1 + 32 * db + 16 * qp + 8 * hi);
                auto a0 = __builtin_amdgcn_permlane32_swap(w0.x, w0.z, false, false); auto a1 = __builtin_amdgcn_permlane32_swap(w0.y, w0.w, false, false);
                auto b0 = __builtin_amdgcn_permlane32_swap(w1.x, w1.z, false, false); auto b1 = __builtin_amdgcn_permlane32_swap(w1.y, w1.w, false, false);
#pragma unroll
                for (int e = 0; e < 2; ++e) {
                    v[e][0] += u0 * lo_bf(a0[e]) + u1 * lo_bf(b0[e]); v[e][1] += u0 * hi_bf(a0[e]) + u1 * hi_bf(b0[e]);
                    v[e][2] += u0 * lo_bf(a1[e]) + u1 * lo_bf(b1[e]); v[e][3] += u0 * hi_bf(a1[e]) + u1 * hi_bf(b1[e]); }
            }
            unsigned f[2][2];
#pragma unroll
            for (int e = 0; e < 2; ++e) { f[e][0] = pk2(v[e][0], v[e][1]); f[e][1] = pk2(v[e][2], v[e][3]); }
            auto r0 = __builtin_amdgcn_permlane32_swap(f[0][0], f[1][0], false, false); auto r1 = __builtin_amdgcn_permlane32_swap(f[0][1], f[1][1], false, false);
            u32x4 w; w.x = r0[0]; w.y = r1[0]; w.z = r0[1]; w.w = r1[1];
            *(u32x4*)(orow + 32 * db + 16 * qp + 8 * hi) = w; }
    if (p < 2 && hi == 0) *(f32x2*)(ML + (size_t)p * M * 32 + ((size_t)mr_ * 16 + h) * 2) = (f32x2){m, l};
}

__device__ __forceinline__ void modulate_row(const float* x32, const bf16* x16, const float* gain, const float* shift, const float* scale, bf16* orow, float* frow, int lane) {
    f32x4 v[8]; float ss = 0.f;
    if (x32) {
#pragma unroll
        for (int j = 0; j < 8; ++j) v[j] = *(const f32x4*)(x32 + 4 * lane + 256 * j);
    } else {
        u32x2 w[8];
#pragma unroll
        for (int j = 0; j < 8; ++j) w[j] = *(const u32x2*)(x16 + 4 * lane + 256 * j);
#pragma unroll
        for (int j = 0; j < 8; ++j) v[j] = (f32x4){lo_bf(w[j].x), hi_bf(w[j].x), lo_bf(w[j].y), hi_bf(w[j].y)};
    }
#pragma unroll
    for (int j = 0; j < 8; ++j) ss += (v[j][0] * v[j][0] + v[j][1] * v[j][1]) + (v[j][2] * v[j][2] + v[j][3] * v[j][3]);
    const float rinv = rsqrtf(wave_sum(ss) * (1.0f / D) + NORM_EPS);
#pragma unroll
    for (int j = 0; j < 8; ++j) {
        const int col = 4 * lane + 256 * j;
        const f32x4 gn = *(const f32x4*)(gain + col);
        f32x4 r = v[j] * rinv * gn;
        if (shift) { const f32x4 sh = *(const f32x4*)(shift + col), sc = *(const f32x4*)(scale + col); r = r * (1.0f + sc) + sh;
            u32x2 w; w.x = pk2(r[0], r[1]); w.y = pk2(r[2], r[3]); *(u32x2*)(orow + col) = w; }
        else *(f32x4*)(frow + col) = r;
    }
}

__device__ __forceinline__ unsigned char* wsp_(unsigned char* ws, size_t off) { asm volatile("" : "+s"(off)); return ws + off; }
#define FRESH_IDS() const int wave = fresh_s(wave_s), lane = lane_id_asm(), tid = wave * 64 + lane; (void)tid; \
    const int Gf_ = fresh_s(G), bx_ = fresh_s((int)blockIdx.x); const int gw = bx_ * NWAVES + wave, NGW = Gf_ * NWAVES, gtid = bx_ * NTHREADS + tid, NGT = Gf_ * NTHREADS; \
    LAS float* wl = (LAS float*)(lds + wave * 16384); (void)lane; (void)gw; (void)NGW; (void)gtid; (void)NGT; (void)wl
__global__ void __launch_bounds__(NTHREADS, 2) mega_fwd(Params P) {
    extern __shared__ __attribute__((aligned(16))) unsigned char lds_raw[];
    LAS unsigned char* lds = (LAS unsigned char*)lds_raw;
    volatile LAS unsigned* MISC = (volatile LAS unsigned*)(lds + MISC_OFF);
    const int G = gridDim.x;
    unsigned char* ws = P.ws;
    for (int u = threadIdx.x; u < (LDS_BYTES - RING_BYTES) / 4; u += NTHREADS) ((LAS unsigned*)(lds + RING_BYTES))[u] = 0u;
    __syncthreads();
    const int wave_s = __builtin_amdgcn_readfirstlane(threadIdx.x >> 6);
    XcdBarrier bar = xcd_barrier_post((unsigned*)(ws + WS_CTL) + 4096, MISC + 8); bar.wave = wave_s;
#define GRID_BAR() xcd_barrier(bar)
#define WSP(T, off) ((T*)wsp_(ws, (off)))

    {
        FRESH_IDS();
        float* MODP = WSP(float, WS_MODP); float* COS = WSP(float, WS_COS); float* SIN = WSP(float, WS_SIN); float* BPEP = WSP(float, WS_BPEP); float* LSP = WSP(float, WS_LSP);
        const float* cv = inp(P, IN_C);
        for (int task = gw; task < 4 * 48 * 8; task += NGW) {
            const int kc = task & 7, cg = (task >> 3) % 48, l = task / (8 * 48);
            const float* w = inp(P, layer_base(l)) + (size_t)cg * 256 + lane * 4;
            f32x4 a0 = {0.f, 0.f, 0.f, 0.f}, a1 = {0.f, 0.f, 0.f, 0.f};
#pragma unroll 8
            for (int k = kc * 256; k < kc * 256 + 256; ++k) {
                const float c0 = cv[k], c1 = cv[2048 + k];
                const float s0 = c0 / (1.0f + __expf(-c0)), s1 = c1 / (1.0f + __expf(-c1));
                const f32x4 wv = __builtin_nontemporal_load((const f32x4*)(w + (size_t)k * 12288));
                a0 += s0 * wv; a1 += s1 * wv;
            }
            *(f32x4*)(MODP + ((size_t)((kc * 4 + l) * 2 + 0)) * 12288 + cg * 256 + lane * 4) = a0;
            *(f32x4*)(MODP + ((size_t)((kc * 4 + l) * 2 + 1)) * 12288 + cg * 256 + lane * 4) = a1;
        }
        for (int i = gtid; i < SEQ * 64; i += NGT) {
            const int t = i >> 6, f = i & 63;
            const double invf = exp2(-(double)f * (13.287712379549449 / 64.0));
            const double ang = (double)t * invf;
            const double n = rint(ang * 0.15915494309189535);
            const double r = (ang - n * 6.283185307179586) - n * 2.4492935982947064e-16;
            COS[i] = (float)cos(r); SIN[i] = (float)sin(r);
        }
        for (int task = gw; task < 2 * 2 * 2 * 16; task += NGW) {
            const int kc = task & 15, cg = (task >> 4) & 1, kv = (task >> 5) & 1, slot = task >> 6;
            const int bi = slot == 0 ? 2 : 34;
            const float* pe = inp(P, bi + 4) + kv * 4096; const float* w = inp(P, bi + 5) + (size_t)kv * 4096 * 512 + cg * 256 + lane * 4;
            f32x4 a = {0.f, 0.f, 0.f, 0.f};
#pragma unroll 8
            for (int k = kc * 256; k < kc * 256 + 256; ++k) a += pe[k] * *(const f32x4*)(w + (size_t)k * 512);
            *(f32x4*)(BPEP + (size_t)((kc * 2 + slot) * 2 + kv) * 512 + cg * 256 + lane * 4) = a;
        }
        { const float* lamp = inp(P, 21 + 8);
          for (int i = gtid; i < DRNN; i += NGT) { const double lam = (double)lamp[i]; LSP[i] = (float)(-8.0 * log1p(exp(-lam))); } }
    }
    GRID_BAR();
    {
        FRESH_IDS();
#pragma unroll 1
        for (int jid = 0; jid < NJOBS; ++jid) {
            const Job J = get_job(P, jid);
            const int nitems = (J.K / 64) * (J.n_rows / 32);
            for (int it = gw; it < nitems; it += NGW) conv_item(J, it, wl, lane);
        }
        {
            const float* wg = inp(P, 21 + 6); bf16* WG = WSP(bf16, WS_W) + WE_RG_WG;
            for (long i = gtid; i < (long)5376 * (DRNN / 8); i += NGT) {
                const int row = (int)(i / (DRNN / 8)), k8 = (int)(i % (DRNN / 8)) * 8;
                const int gate = (row >> 7) & 1, ch = (row >> 8) * 128 + (row & 127), nb = ch / 168, dd = ch % 168;
                float v[8];
#pragma unroll
                for (int e = 0; e < 8; ++e) { const int k = k8 + e; v[e] = (k / 168 == nb) ? wg[((size_t)(gate * 16 + nb) * 168 + (k % 168)) * 168 + dd] : 0.f; }
                u32x4 o; o.x = pk2(v[0], v[1]); o.y = pk2(v[2], v[3]); o.z = pk2(v[4], v[5]); o.w = pk2(v[6], v[7]);
                *(u32x4*)(WG + (size_t)row * DRNN + k8) = o;
            }
        }
        {   const float* MODP = WSP(float, WS_MODP); float* MOD = WSP(float, WS_MOD);
#pragma unroll 1
            for (int l = 0; l < 4; ++l) { const float* bias = inp(P, layer_base(l) + 1);
                for (int i = gtid; i < 2 * 12288; i += NGT) {
                    const int col = i % 12288, lb = l * 2 + i / 12288;
                    float a = bias[col];
#pragma unroll
                    for (int kc = 0; kc < 8; ++kc) a += MODP[(size_t)(kc * 8 + lb) * 12288 + col];
                    MOD[(size_t)lb * 12288 + col] = a;
                } }
            const float* BPEP = WSP(float, WS_BPEP); float* BPE = WSP(float, WS_BPE);
            for (int i = gtid; i < 2 * 2 * 512; i += NGT) { float a = 0.f;
#pragma unroll
                for (int kc = 0; kc < 16; ++kc) a += BPEP[(size_t)kc * 2048 + i];
                BPE[i] = a; }
        }
    }
    GRID_BAR();

#pragma unroll 1
    for (int li = 0; li < 4; ++li) {
        const int kind = li % 3, bi = layer_base(li);
        {   FRESH_IDS();
            const float* x32 = li == 0 ? inp(P, IN_X) : (const float*)nullptr; const bf16* XR = WSP(bf16, WS_XR); const float* gain = inp(P, bi + 2);
            const float* modl = WSP(float, WS_MOD) + (size_t)li * 2 * 12288; bf16* HN = WSP(bf16, WS_HN);
            for (int r = gw; r < M; r += NGW) { const int b = r >> 13;
                modulate_row(x32 ? x32 + (size_t)r * D : (const float*)nullptr, XR + (size_t)r * D, gain, modl + (size_t)b * 12288, modl + (size_t)b * 12288 + 2048, HN + (size_t)r * D, nullptr, lane); } }
        GRID_BAR();
        if (kind == 0) {
            const int slot = li == 0 ? 0 : 1;
            {   bf16* wbase = WSP(bf16, WS_W) + (size_t)slot * WE_NSA_SZ;
                pg8::Gemm g{WSP(bf16, WS_HN), wbase + WE_NSA_WIN, M, NSA_N1, D}; pg8::StaticOrder S; S.init(M, NSA_N1, fresh_s(G), fresh_s((int)blockIdx.x));
                EpiNsaIn E{WSP(bf16, NS_Q), WSP(bf16, NS_QR), WSP(bf16, NS_PK), WSP(bf16, NS_PV), WSP(bf16, NS_KS), WSP(bf16, NS_KW), WSP(float, NS_GT), WSP(float, WS_COS), WSP(float, WS_SIN)};
                pg8::gemm_phase<EpiNsaIn, pg8::StaticOrder, true, true>(lds, g, S, E, wave_s); }
            {
                bf16* wbase = WSP(bf16, WS_W) + (size_t)slot * WE_NSA_SZ;
                pg8::Gemm g{wbase + WE_NSA_WIN + (size_t)4352 * D, WSP(bf16, WS_HN), 1024, M, D}; pg8::StaticOrder S; S.init(1024, M, fresh_s(G), fresh_s((int)blockIdx.x));
                EpiBf16<0> E{WSP(bf16, NS_VT), LDV, 0};
                pg8::gemm_phase<EpiBf16<0>, pg8::StaticOrder, true, true>(lds, g, S, E, wave_s); }
            GRID_BAR();
#pragma unroll 1
            for (int kv = 0; kv < 2; ++kv) {
                bf16* wbase = WSP(bf16, WS_W) + (size_t)slot * WE_NSA_SZ;
                pg8::Gemm g{kv ? WSP(bf16, NS_PV) : WSP(bf16, NS_PK), wbase + WE_NSA_W1 + (size_t)kv * 1024 * 2048, 4096, 1024, 2048}; pg8::StaticOrder S; S.init(4096, 1024, fresh_s(G), fresh_s((int)((blockIdx.x + 128 * kv) % G)));
                EpiF32 E{WSP(float, NS_HC) + (size_t)kv * 4096 * 1024, 1024};
                pg8::gemm_phase<EpiF32, pg8::StaticOrder, true, true>(lds, g, S, E, wave_s); }
            {
                bf16* wbase = WSP(bf16, WS_W) + (size_t)slot * WE_NSA_SZ;
                pg8::Gemm g{WSP(bf16, WS_HN), wbase + WE_NSA_WIN + (size_t)4096 * D, M, 256, D}; pg8::StaticOrder S; S.init(M, 256, fresh_s(G), fresh_s((int)((blockIdx.x + 192) % G)));
                EpiGates E{WSP(float, NS_GT)};
                pg8::gemm_phase<EpiGates, pg8::StaticOrder, true, true>(lds, g, S, E, wave_s); }
            GRID_BAR();
            {
                FRESH_IDS();
                const float* w2 = inp(P, bi + 6); const float* bpe = WSP(float, WS_BPE) + slot * 1024; const float* HCb = WSP(float, NS_HC); bf16* KCb = WSP(bf16, NS_KC); bf16* VCt = WSP(bf16, NS_VCT);
                for (int task = gw; task < 2 * 8 * 128; task += NGW) {
                    const int n0 = (task & 127) * 4, bg = (task >> 7) & 7, kv = task >> 10;
                    const float* hrow = HCb + ((size_t)kv * 4096 + bg * 512 + n0) * 1024;
#pragma unroll
                    for (int q = 0; q < 2; ++q) { const int c = lane * 8 + q * 4; const f32x4 pb = *(const f32x4*)(bpe + kv * 512 + c);
                        f32x4 hv[4];
#pragma unroll
                        for (int r = 0; r < 4; ++r) { const f32x4 a = *(const f32x4*)(hrow + (size_t)r * 1024 + c), bb = n0 + r < 511 ? *(const f32x4*)(hrow + (size_t)(r + 1) * 1024 + 512 + c) : (f32x4){0.f, 0.f, 0.f, 0.f};
#pragma unroll
                            for (int e = 0; e < 4; ++e) hv[r][e] = n0 + r < 511 ? gelu_tanh(a[e] + bb[e] + pb[e]) : 0.f; }
#pragma unroll
                        for (int e = 0; e < 4; ++e) *(LAS f32x4*)(wl + (c + e) * 4) = (f32x4){hv[0][e], hv[1][e], hv[2][e], hv[3][e]}; }
                    LDS_WAIT();
                    const float* wp = w2 + (size_t)kv * 512 * 128 + 2 * lane; f32x4 o0 = {0.f, 0.f, 0.f, 0.f}, o1 = {0.f, 0.f, 0.f, 0.f};
#pragma unroll 16
                    for (int c = 0; c < 512; ++c) { const f32x2 wv = *(const f32x2*)(wp + (size_t)c * 128); const f32x4 hv = *(const LAS f32x4*)(wl + c * 4); o0 += hv * wv[0]; o1 += hv * wv[1]; }
                    const int d0 = 2 * lane, d1 = 2 * lane + 1;
                    if (kv == 0) {
#pragma unroll
                        for (int r = 0; r < 4; ++r) { bf16* dst = KCb + ((size_t)bg * 512 + n0 + r) * 128; dst[(d0 & 63) * 2 + (d0 >> 6)] = (bf16)(pk2(o0[r], 0.f) & 0xffffu); dst[(d1 & 63) * 2 + (d1 >> 6)] = (bf16)(pk2(o1[r], 0.f) & 0xffffu); } }
                    else { bf16* dst = VCt + (size_t)bg * 128 * 512 + n0;
                        u32x2 w0; w0.x = pk2(o0[0], o0[1]); w0.y = pk2(o0[2], o0[3]); *(u32x2*)(dst + (size_t)d0 * 512) = w0;
                        u32x2 w1; w1.x = pk2(o1[0], o1[1]); w1.y = pk2(o1[2], o1[3]); *(u32x2*)(dst + (size_t)d1 * 512) = w1; }
                    LDS_WAIT();
                }
            }
            GRID_BAR();
#ifndef REP_NSA
#define REP_NSA 1
#endif
#pragma unroll 1
            for (int rep = 0; rep < fresh_s(REP_NSA); ++rep)
            {   FRESH_IDS();
#pragma unroll 1
                for (int pi = bx_; pi < 512; pi += Gf_) {
                    const int bg = Gf_ == 256 ? (pi & 7) : (pi >> 6), cc = Gf_ == 256 ? ((pi & 255) >> 3) + 32 * (pi >> 8) : (pi & 63);
#pragma unroll 1
                    for (int e = 0; e < 2; ++e)
                        nsa_item(lds, wave, lane, bg >> 2, bg & 3, e ? cc : 127 - cc, WSP(bf16, NS_Q), WSP(bf16, NS_QR), WSP(bf16, NS_KC), WSP(bf16, NS_VCT), WSP(bf16, NS_KS), WSP(bf16, NS_KW),
                                 WSP(bf16, NS_VT), WSP(float, NS_GT), P.out, WSP(bf16, WS_ATT));
                }
                __syncthreads();
            }
            GRID_BAR();
        } else if (kind == 1) {
#pragma unroll 1
            for (int p = 0; p < 3; ++p) {
                {   pg8::Gemm g{WSP(bf16, WS_HN), WSP(bf16, WS_W) + WE_DIL + (size_t)p * 6144 * D, M, 4096, D, 2 * p, 0}; pg8::StaticOrder S; S.init(M, 4096, fresh_s(G), fresh_s((int)blockIdx.x));
                    EpiDilQK E{WSP(bf16, DL_QK) + (size_t)p * M * 4096, WSP(float, WS_COS), WSP(float, WS_SIN), 2 * p};
                    pg8::gemm_phase<EpiDilQK, pg8::StaticOrder, true, true>(lds, g, S, E, wave_s); }
                {   pg8::Gemm g{WSP(bf16, WS_W) + WE_DIL + ((size_t)p * 6144 + 4096) * D, WSP(bf16, WS_HN), 2048, M, D, 0, 2 * p}; pg8::StaticOrder S; S.init(2048, M, fresh_s(G), fresh_s((int)blockIdx.x));
                    EpiBf16<0> E{(bf16*)(WSP(unsigned char, DL_VT) + (size_t)p * DL_VT_STRIDE), LDV, 0};
                    pg8::gemm_phase<EpiBf16<0>, pg8::StaticOrder, true, true>(lds, g, S, E, wave_s); }
            }
            GRID_BAR();
#pragma unroll 1
            for (int p = 0; p < 3; ++p) {
                {   FRESH_IDS();
                    const int dsh = 2 * p, nqb = (SEQ >> dsh) >> 8;
#pragma unroll 1
                    for (int it = bx_; it < 1024; it += Gf_) {
                        const int qb = it % nqb, h = (it / nqb) & 15, sq = it / (nqb * 16);
                        dil_item(lds, wave, lane, p, sq, h, qb, WSP(bf16, DL_QK) + (size_t)p * M * 4096, (const bf16*)(WSP(unsigned char, DL_VT) + (size_t)p * DL_VT_STRIDE), (bf16*)P.out, WSP(float, DL_ML), WSP(bf16, WS_ATT));
                    }
                    __syncthreads();
                }
                if (p >= 1) GRID_BAR();
            }
        } else {
            {   pg8::Gemm g{WSP(bf16, WS_HN), WSP(bf16, WS_W) + WE_RG, M, RG_N, D}; pg8::StaticOrder S; S.init(M, RG_N, fresh_s(G), fresh_s((int)blockIdx.x));
                EpiBf16<2> E{WSP(bf16, RG_YX), RG_N, 11};
                pg8::gemm_phase<EpiBf16<2>, pg8::StaticOrder, true, true>(lds, g, S, E, wave_s); }
            GRID_BAR();
            {
                FRESH_IDS();
                const float* cw = inp(P, bi + 4); const float* cb = inp(P, bi + 5); const bf16* YX = WSP(bf16, RG_YX); bf16* Xc = WSP(bf16, RG_X);
                for (long i = gtid; i < (long)(M / 4) * (DRNN / 8); i += NGT) {
                    const int r4 = (int)(i / (DRNN / 8)) * 4, c8 = (int)(i % (DRNN / 8)) * 8, t0 = r4 & (SEQ - 1);
                    u32x4 xr[7];
#pragma unroll
                    for (int j = 0; j < 7; ++j) xr[j] = (t0 - 3 + j >= 0) ? *(const u32x4*)(YX + (size_t)(r4 - 3 + j) * RG_N + RG_XOFF + c8) : (u32x4){0u, 0u, 0u, 0u};
                    f32x4 w0[4], w1[4];
#pragma unroll
                    for (int j = 0; j < 4; ++j) { w0[j] = *(const f32x4*)(cw + j * DRNN + c8); w1[j] = *(const f32x4*)(cw + j * DRNN + c8 + 4); }
                    const f32x4 b0 = *(const f32x4*)(cb + c8), b1 = *(const f32x4*)(cb + c8 + 4);
#pragma unroll
                    for (int rr = 0; rr < 4; ++rr) {
                        f32x4 a0 = b0, a1 = b1;
#pragma unroll
                        for (int j = 0; j < 4; ++j) { const u32x4 xw = xr[rr + j];
                            a0 += w0[j] * (f32x4){lo_bf(xw.x), hi_bf(xw.x), lo_bf(xw.y), hi_bf(xw.y)}; a1 += w1[j] * (f32x4){lo_bf(xw.z), hi_bf(xw.z), lo_bf(xw.w), hi_bf(xw.w)}; }
                        u32x4 o; o.x = pk2(a0[0], a0[1]); o.y = pk2(a0[2], a0[3]); o.z = pk2(a1[0], a1[1]); o.w = pk2(a1[2], a1[3]);
                        *(u32x4*)(Xc + (size_t)(r4 + rr) * DRNN + c8) = o;
                    }
                }
            }
            GRID_BAR();
            {   pg8::Gemm g{WSP(bf16, RG_X), WSP(bf16, WS_W) + WE_RG_WG, M, 5376, DRNN}; pg8::GateOrder S; S.init(M, 5376, fresh_s(G), fresh_s((int)blockIdx.x));
                EpiRgGate E{WSP(bf16, RG_X), inp(P, bi + 7), WSP(float, WS_LSP), WSP(unsigned, RG_A)};
                pg8::gemm_phase<EpiRgGate, pg8::GateOrder, true, true>(lds, g, S, E, wave_s); }
            GRID_BAR();
            {
                FRESH_IDS();
                const unsigned* AB = WSP(unsigned, RG_A); float* CA = WSP(float, RG_CA); float* CB = WSP(float, RG_CB);
                for (int task = gw; task < 2 * 128 * 21; task += NGW) {
                    const int cg = task % 21, k = (task / 21) & 127, b = task / (21 * 128), ch = cg * 128 + 2 * lane;
                    const size_t o = (size_t)(b * SEQ + k * 64) * DRNN + ch; f32x2 pa = {1.f, 1.f}, hb = {0.f, 0.f};
#pragma unroll 16
                    for (int s = 0; s < 64; ++s) { const u32x2 w = *(const u32x2*)(AB + o + (size_t)s * DRNN);
                        const f32x2 a = {__builtin_amdgcn_exp2f(lo_bf(w.x)), __builtin_amdgcn_exp2f(lo_bf(w.y))}, bv = {hi_bf(w.x), hi_bf(w.y)}; hb = a * hb + bv; pa = pa * a; }
                    *(f32x2*)(CA + (size_t)(b * 128 + k) * DRNN + ch) = pa; *(f32x2*)(CB + (size_t)(b * 128 + k) * DRNN + ch) = hb;
                } }
            GRID_BAR();
            {   FRESH_IDS();
                const unsigned* AB = WSP(unsigned, RG_A); const float* CA = WSP(float, RG_CA); const float* CB = WSP(float, RG_CB);
                const bf16* YX = WSP(bf16, RG_YX); bf16* ATT = WSP(bf16, WS_ATT);
                for (int task = gw; task < 2 * 128 * 21; task += NGW) {
                    const int cg = task % 21, k = (task / 21) & 127, b = task / (21 * 128), ch = cg * 128 + 2 * lane;
                    f32x2 h = {0.f, 0.f};
                    { const size_t co = (size_t)(b * 128) * DRNN + ch;
#pragma unroll 8
                      for (int kk = 0; kk < k; ++kk) { const f32x2 ca = *(const f32x2*)(CA + co + (size_t)kk * DRNN), cb = *(const f32x2*)(CB + co + (size_t)kk * DRNN); h = ca * h + cb; } }
                    const size_t o = (size_t)(b * SEQ + k * 64) * DRNN + ch; const size_t yo = (size_t)(b * SEQ + k * 64) * RG_N + ch;
#pragma unroll 16
                    for (int s = 0; s < 64; ++s) { const u32x2 w = *(const u32x2*)(AB + o + (size_t)s * DRNN);
                        const f32x2 a = {__builtin_amdgcn_exp2f(lo_bf(w.x)), __builtin_amdgcn_exp2f(lo_bf(w.y))}, bv = {hi_bf(w.x), hi_bf(w.y)};
                        const unsigned yw = *(const unsigned*)(YX + yo + (size_t)s * RG_N);
                        h = a * h + bv;
                        *(unsigned*)(ATT + o + (size_t)s * DRNN) = pk2(h[0] * lo_bf(yw), h[1] * hi_bf(yw)); }
                } }
            GRID_BAR();
        }
        {   const int Kd = kind == 2 ? DRNN : D;
            const bf16* wt = kind == 0 ? WSP(bf16, WS_W) + (size_t)(li == 0 ? 0 : 1) * WE_NSA_SZ + WE_NSA_WOUT : kind == 1 ? WSP(bf16, WS_W) + WE_DIL_WOUT : WSP(bf16, WS_W) + WE_RG_WOUT;
            const float* x32 = li == 0 ? inp(P, IN_X) : (const float*)nullptr;
            pg8::Gemm g{WSP(bf16, WS_ATT), wt, M, D, Kd}; pg8::StaticOrder S; S.init(M, D, fresh_s(G), fresh_s((int)blockIdx.x));
            EpiRes E{x32, WSP(bf16, WS_XR), WSP(bf16, WS_XR), WSP(float, WS_MOD) + (size_t)li * 2 * 12288 + 2 * 2048};
            pg8::gemm_phase<EpiRes, pg8::StaticOrder, true, true>(lds, g, S, E, wave_s); }
        GRID_BAR();
        {   FRESH_IDS();
            const float* gain = inp(P, bi + ff_off(li)); const float* modl = WSP(float, WS_MOD) + (size_t)li * 2 * 12288; bf16* HN = WSP(bf16, WS_HN); const bf16* XR = WSP(bf16, WS_XR);
            for (int r = gw; r < M; r += NGW) { const int b = r >> 13;
                modulate_row(nullptr, XR + (size_t)r * D, gain, modl + (size_t)b * 12288 + 3 * 2048, modl + (size_t)b * 12288 + 4 * 2048, HN + (size_t)r * D, nullptr, lane); } }
        GRID_BAR();
#pragma unroll 1
        for (int hfm = 0; hfm < 2; ++hfm) {
            {   pg8::Gemm g{WSP(bf16, WS_HN) + (size_t)hfm * 8192 * D, WSP(bf16, WS_W) + WE_FF + (size_t)li * 33554432, M / 2, DFF, D}; pg8::StaticOrder S; S.init(M / 2, DFF, fresh_s(G), fresh_s((int)blockIdx.x));
                EpiBf16<1> E{WSP(bf16, WS_BIG), DFF, 0};
                pg8::gemm_phase<EpiBf16<1>, pg8::StaticOrder, true, true>(lds, g, S, E, wave_s); }
            GRID_BAR();
            {   pg8::Gemm g{WSP(bf16, WS_BIG), WSP(bf16, WS_W) + WE_FF + (size_t)li * 33554432 + 16777216, M / 2, D, DFF}; pg8::StaticOrder S; S.init(M / 2, D, fresh_s(G), fresh_s((int)blockIdx.x));
                EpiRes E{nullptr, WSP(bf16, WS_XR) + (size_t)hfm * 8192 * D, WSP(bf16, WS_XR) + (size_t)hfm * 8192 * D, WSP(float, WS_MOD) + (size_t)li * 2 * 12288 + 5 * 2048 + (size_t)hfm * 12288};
                pg8::gemm_phase<EpiRes, pg8::StaticOrder, true, true>(lds, g, S, E, wave_s); }
            GRID_BAR();
        }
    }
    {   FRESH_IDS();
        const float* gain = inp(P, IN_NORMF); const bf16* XR = WSP(bf16, WS_XR); float* OUT = P.out;
        for (int r = gw; r < M; r += NGW) modulate_row(nullptr, XR + (size_t)r * D, gain, nullptr, nullptr, nullptr, OUT + (size_t)r * D, lane); }
}

extern "C" void kernel_launch(void* const* d_in, const int* in_sizes, int n_in, void* d_out, int out_size, void* d_ws, size_t ws_size, hipStream_t stream) {
    static int grid = 0;
    if (grid == 0) {
        if (n_in != 46 || out_size != M * D || ws_size < WS_END) { fprintf(stderr, "kernel_launch: unexpected shapes (n_in %d out %d ws %zu need %zu)\n", n_in, out_size, ws_size, (size_t)WS_END); grid = -1; return; }
        int dev = 0, cus = 0, per_cu = 0;
        if (hipGetDevice(&dev) != hipSuccess || hipDeviceGetAttribute(&cus, hipDeviceAttributeMultiprocessorCount, dev) != hipSuccess) { grid = -1; return; }
        if (hipFuncSetAttribute((const void*)mega_fwd, hipFuncAttributeMaxDynamicSharedMemorySize, LDS_BYTES) != hipSuccess) { fprintf(stderr, "kernel_launch: hipFuncSetAttribute failed\n"); grid = -1; return; }
        if (hipOccupancyMaxActiveBlocksPerMultiprocessor(&per_cu, (const void*)mega_fwd, NTHREADS, LDS_BYTES) != hipSuccess || per_cu < 1) { fprintf(stderr, "kernel_launch: occupancy query says %d\n", per_cu); }
        (void)hipGetLastError();
        grid = cus;
    }
    if (grid < 0) return;
    if (hipMemsetAsync((char*)d_ws + WS_CTL, 0, CTL_ZERO_BYTES, stream) != hipSuccess) return;
    Params p{};
    for (int i = 0; i < 46; ++i) p.in[i] = (const float*)d_in[i];
    p.out = (float*)d_out; p.ws = (unsigned char*)d_ws;
    hipLaunchKernelGGL(mega_fwd, dim3(grid), dim3(NTHREADS), LDS_BYTES, stream, p);
}
```

```cpp
#include <hip/hip_runtime.h>
#include <cstdio>
#include <cstdint>

#define GAS __attribute__((address_space(1)))
#define LAS __attribute__((address_space(3)))
typedef unsigned short bf16;
typedef float f32x4 __attribute__((ext_vector_type(4)));
typedef float f32x2 __attribute__((ext_vector_type(2)));
typedef unsigned u32x4 __attribute__((ext_vector_type(4)));
typedef unsigned u32x2 __attribute__((ext_vector_type(2)));
#define LDS_WAIT() asm volatile("s_waitcnt lgkmcnt(0)" ::: "memory")
__device__ __forceinline__ int fresh_s(int v) { asm volatile("" : "+s"(v)); return v; }
__device__ __forceinline__ int lane_id_asm() { int l; asm volatile("v_mbcnt_lo_u32_b32 %0, -1, 0\n\tv_mbcnt_hi_u32_b32 %0, -1, %0" : "=v"(l)); return l; }

namespace pg8 {
#define PG8_LAS __attribute__((address_space(3)))
typedef unsigned short bf16_t;
typedef short bf16x8 __attribute__((ext_vector_type(8)));
constexpr int BM = 256, BK = 64, HALF = 128, HTB = HALF * BK * 2, STAGE_BYTES = 8 * HTB, NXCD = 8, WGM = 8;
__host__ __device__ __forceinline__ int lds_byte(int r, int c) { const int st = (r >> 4) * 2 + (c >> 5), rr = r & 15, cc = c & 31, ob = rr * 64 + cc * 2; return st * 1024 + (ob ^ (((ob >> 9) & 1) << 5)); }
__host__ __device__ __forceinline__ void stage_rc(int b, int& R, int& C) { const int st = b / 1024, sb = b % 1024, swz = sb ^ (((sb >> 9) & 1) << 5); R = (st >> 1) * 16 + swz / 64; C = (st & 1) * 32 + (swz % 64) / 2; }
__host__ __device__ __forceinline__ int perm32(int rho) { const int n = rho >> 4, i = rho & 15; return 8 * (i >> 2) + 4 * n + (i & 3); }
struct Unit { int pm, pn; };
struct Gemm { const bf16_t* A; const bf16_t* Bt; int M, N, K; int dshA, dshB; };
__device__ __forceinline__ long rowbase(int p, int dsh) { const int i0 = p * 256; if (dsh == 0) return i0; const int b = i0 >> 13, rem = i0 & 8191, sh = 13 - dsh; return (long)(b << 13) + ((rem & ((1 << sh) - 1)) << dsh) + (rem >> sh); }
struct StaticOrder {
    int nM, nN, nwg, G, c;
    __host__ __device__ void init(int M, int N, int G_, int c_) { nM = M / BM; nN = N / BM; nwg = nM * nN; G = G_; c = c_; }
    __host__ __device__ bool next(int i, Unit& u) const {
        const long L = (long)i * G + c; if (L >= nwg) return false;
        int wgid = (int)L; { const int q = nwg / NXCD, r = nwg % NXCD, xcd = wgid % NXCD, off = wgid / NXCD; wgid = (xcd < r ? xcd * (q + 1) : r * (q + 1) + (xcd - r) * q) + off; }
        const int nig = WGM * nN, gid = wgid / nig, fm = gid * WGM, gsz = (nM - fm) < WGM ? (nM - fm) : WGM;
        u.pm = fm + ((wgid % nig) % gsz); u.pn = (wgid % nig) / gsz; return true;
    }
    __device__ __forceinline__ void a_ready(const Unit&) const {}
    __device__ __forceinline__ void done(const Unit&) const {}
    __device__ __forceinline__ void krange(const Unit&, int K, int& kbeg, int& nt) const { kbeg = 0; nt = K / BK; }
};
struct GateOrder : StaticOrder {
    __device__ __forceinline__ void krange(const Unit& u, int K, int& kbeg, int& nt) const {
        const int c0 = u.pn * 128, nb0 = c0 / 168, nb1 = (c0 + 127) / 168;
        kbeg = (nb0 * 168) & ~127; int kend = ((nb1 + 1) * 168 + 127) & ~127; if (kend > K) kend = K;
        nt = (kend - kbeg) / BK; }
};
__device__ __forceinline__ unsigned cvt_pk_bf16(float lo, float hi) { unsigned r; asm volatile("v_cvt_pk_bf16_f32 %0, %1, %2" : "=v"(r) : "v"(lo), "v"(hi)); return r; }

template <class Epi, class Sched, bool ALIGN_EPI = false, bool SP2 = false>
__device__ __forceinline__ void gemm_phase(PG8_LAS unsigned char* lds, const Gemm g, const Sched& S, const Epi& E, int wid_in) {
    int wid = wid_in; asm volatile("" : "+s"(wid));
    const int lane = lane_id_asm(), tid = wid * 64 + lane, wr = wid >> 2, wc = wid & 3, fr = lane & 15, fq = lane >> 4;
    const int K = g.K;
    unsigned voffA[2], voffB[2];
#pragma unroll
    for (int i = 0; i < 2; ++i) { int R, C; stage_rc(tid * 16 + i * 8192, R, C); const int Rb = Epi::PERM ? ((R & ~31) + perm32(R & 31)) : R;
        voffA[i] = (unsigned)((R << g.dshA) * K + C) * 2u; voffB[i] = (unsigned)((Rb << g.dshB) * K + C) * 2u; }
    const size_t kstep = (size_t)(BK * 2);
    const size_t hstepA = (size_t)(HALF << g.dshA) * K * 2, hstepB = (size_t)(HALF << g.dshB) * K * 2;
#define PG8_BASEA(u) ((const char*)g.A + (size_t)rowbase((u).pm, g.dshA) * K * 2)
#define PG8_BASEB(u) ((const char*)g.Bt + (size_t)rowbase((u).pn, g.dshB) * K * 2)
    const unsigned ldsw = (unsigned)wid * 1024u;
    const int aoff = lds_byte(wr * 64 + fr, fq * 8), boff = lds_byte(wc * 32 + fr, fq * 8);
#define PG8_SA(b, h) (((b) * 2 + (h)) * HTB)
#define PG8_SB(b, h) ((4 + (b) * 2 + (h)) * HTB)
#define PG8_STAGE(bufoff, gbase, voff) do { _Pragma("unroll") for (int _i = 0; _i < 2; ++_i) \
        __builtin_amdgcn_global_load_lds((const unsigned*)((const char*)(gbase) + (voff)[_i]), (PG8_LAS unsigned*)(lds + (bufoff) + ldsw + _i * 8192), 16, 0, 0); } while (0)
#define PG8_LDA(dst, b, h) do { _Pragma("unroll") for (int m = 0; m < 4; ++m) _Pragma("unroll") for (int k = 0; k < 2; ++k) dst[m][k] = *(const PG8_LAS bf16x8*)(lds + PG8_SA(b, h) + aoff + m * 2048 + k * 1024); } while (0)
#define PG8_LDB(dst, b, h) do { _Pragma("unroll") for (int n = 0; n < 2; ++n) _Pragma("unroll") for (int k = 0; k < 2; ++k) dst[n][k] = *(const PG8_LAS bf16x8*)(lds + PG8_SB(b, h) + boff + n * 2048 + k * 1024); } while (0)
#define PG8_MMA(ai, bj, At, Bt) do { __builtin_amdgcn_s_setprio(1); _Pragma("unroll") for (int m = 0; m < 4; ++m) _Pragma("unroll") for (int n = 0; n < 2; ++n) _Pragma("unroll") for (int k = 0; k < 2; ++k) \
        acc[ai][bj][m][n] = __builtin_amdgcn_mfma_f32_16x16x32_bf16(Bt[n][k], At[m][k], acc[ai][bj][m][n], 0, 0, 0); __builtin_amdgcn_s_setprio(0); } while (0)
#define PG8_WAIT_V(n) asm volatile("s_waitcnt vmcnt(" #n ")" ::: "memory")
#define PG8_WAIT_L(n) asm volatile("s_waitcnt lgkmcnt(" #n ")" ::: "memory")
#define PG8_BAR __builtin_amdgcn_s_barrier()
#define PG8_SCHED __builtin_amdgcn_sched_barrier(0)
    Unit cur, nxt; int ui = 0;
    if (!S.next(0, cur)) return;
    f32x4 acc[2][2][4][2];
#pragma unroll
    for (int a = 0; a < 2; ++a)
#pragma unroll
        for (int b = 0; b < 2; ++b)
#pragma unroll
            for (int m = 0; m < 4; ++m)
#pragma unroll
                for (int n = 0; n < 2; ++n) acc[a][b][m][n] = (f32x4){0.f, 0.f, 0.f, 0.f};
    bf16x8 At[4][2], B0[2][2], B1[2][2];
    int kb_cur, nt; S.krange(cur, K, kb_cur, nt);
    const char* cA = PG8_BASEA(cur) + (size_t)kb_cur * 2; const char* cB = PG8_BASEB(cur) + (size_t)kb_cur * 2;
    S.a_ready(cur);
    if constexpr (SP2) {
        PG8_STAGE(PG8_SB(0, 0), cB, voffB); PG8_STAGE(PG8_SB(0, 1), cB + hstepB, voffB); PG8_STAGE(PG8_SA(0, 0), cA, voffA); PG8_STAGE(PG8_SA(0, 1), cA + hstepA, voffA);
        if (wr == 1) PG8_BAR;
        PG8_WAIT_V(2); PG8_BAR;
        PG8_STAGE(PG8_SB(1, 0), cB + kstep, voffB); PG8_STAGE(PG8_SA(1, 0), cA + kstep, voffA); PG8_STAGE(PG8_SB(1, 1), cB + hstepB + kstep, voffB);
        PG8_WAIT_V(6); PG8_BAR;
    } else {
        PG8_STAGE(PG8_SB(0, 0), cB, voffB); PG8_STAGE(PG8_SA(0, 0), cA, voffA); PG8_STAGE(PG8_SB(0, 1), cB + hstepB, voffB); PG8_STAGE(PG8_SA(0, 1), cA + hstepA, voffA);
        if (wr == 1) PG8_BAR;
        PG8_WAIT_V(4); PG8_BAR;
        PG8_STAGE(PG8_SB(1, 0), cB + kstep, voffB); PG8_STAGE(PG8_SA(1, 0), cA + kstep, voffA); PG8_STAGE(PG8_SB(1, 1), cB + hstepB + kstep, voffB);
        PG8_WAIT_V(6); PG8_BAR;
    }
    for (;;) {
        const bool has_next = S.next(ui + 1, nxt);
        int kb_nxt = 0, nt_nxt = nt; if (has_next) S.krange(nxt, K, kb_nxt, nt_nxt);
        const char* nA = has_next ? PG8_BASEA(nxt) + (size_t)kb_nxt * 2 : cA; const char* nB = has_next ? PG8_BASEB(nxt) + (size_t)kb_nxt * 2 : cB;
        for (int t = 0; t < nt; t += 2) {
            const bool last = (t == nt - 2);
            const char* a1 = cA + (size_t)(t + 1) * kstep;
            const char* a2 = last ? nA : cA + (size_t)(t + 2) * kstep; const char* b2 = last ? nB : cB + (size_t)(t + 2) * kstep;
            const char* a3 = a2 + kstep; const char* b3 = b2 + kstep;
            if (last && has_next) S.a_ready(nxt);
            if constexpr (SP2) {
            PG8_LDB(B0, 0, 0); PG8_LDB(B1, 0, 1); PG8_SCHED; PG8_LDA(At, 0, 0); PG8_STAGE(PG8_SA(1, 1), a1 + hstepA, voffA);
            PG8_WAIT_V(8); PG8_WAIT_L(0); PG8_BAR; PG8_MMA(0, 0, At, B0); PG8_MMA(0, 1, At, B1); PG8_BAR; PG8_SCHED;
            PG8_LDA(At, 0, 1); PG8_STAGE(PG8_SB(0, 0), b2, voffB); PG8_STAGE(PG8_SB(0, 1), b2 + hstepB, voffB); PG8_STAGE(PG8_SA(0, 0), a2, voffA);
            PG8_WAIT_V(8); PG8_WAIT_L(0); PG8_BAR; PG8_MMA(1, 0, At, B0); PG8_MMA(1, 1, At, B1); PG8_BAR; PG8_SCHED;
            PG8_LDB(B0, 1, 0); PG8_LDB(B1, 1, 1); PG8_SCHED; PG8_LDA(At, 1, 0); PG8_STAGE(PG8_SA(0, 1), a2 + hstepA, voffA);
            PG8_WAIT_V(8); PG8_WAIT_L(0); PG8_BAR; PG8_MMA(0, 0, At, B0); PG8_MMA(0, 1, At, B1); PG8_BAR; PG8_SCHED;
            PG8_LDA(At, 1, 1); PG8_STAGE(PG8_SB(1, 0), b3, voffB); PG8_STAGE(PG8_SB(1, 1), b3 + hstepB, voffB); PG8_STAGE(PG8_SA(1, 0), a3, voffA);
            PG8_WAIT_V(8); PG8_WAIT_L(0); PG8_BAR; PG8_MMA(1, 0, At, B0); PG8_MMA(1, 1, At, B1); PG8_BAR; PG8_SCHED;
            } else {
            PG8_LDB(B0, 0, 0); PG8_SCHED; PG8_LDA(At, 0, 0); PG8_STAGE(PG8_SA(1, 1), a1 + hstepA, voffA);
            PG8_WAIT_L(8); PG8_BAR; PG8_WAIT_L(0); PG8_MMA(0, 0, At, B0); PG8_BAR; PG8_SCHED;
            PG8_LDB(B1, 0, 1); PG8_STAGE(PG8_SB(0, 0), b2, voffB);
            PG8_BAR; PG8_WAIT_L(0); PG8_MMA(0, 1, At, B1); PG8_BAR;
            PG8_LDA(At, 0, 1); PG8_STAGE(PG8_SA(0, 0), a2, voffA);
            PG8_BAR; PG8_WAIT_L(0); PG8_MMA(1, 0, At, B0); PG8_BAR; PG8_SCHED;
            PG8_STAGE(PG8_SB(0, 1), b2 + hstepB, voffB);
            PG8_WAIT_V(6); PG8_BAR; PG8_MMA(1, 1, At, B1); PG8_BAR;
            PG8_LDB(B0, 1, 0); PG8_SCHED; PG8_LDA(At, 1, 0); PG8_STAGE(PG8_SA(0, 1), a2 + hstepA, voffA);
            PG8_WAIT_L(8); PG8_BAR; PG8_WAIT_L(0); PG8_MMA(0, 0, At, B0); PG8_BAR; PG8_SCHED;
            PG8_LDB(B1, 1, 1); PG8_STAGE(PG8_SB(1, 0), b3, voffB);
            PG8_BAR; PG8_WAIT_L(0); PG8_MMA(0, 1, At, B1); PG8_BAR;
            PG8_LDA(At, 1, 1); PG8_STAGE(PG8_SA(1, 0), a3, voffA);
            PG8_BAR; PG8_WAIT_L(0); PG8_MMA(1, 0, At, B0); PG8_BAR; PG8_SCHED;
            PG8_STAGE(PG8_SB(1, 1), b3 + hstepB, voffB);
            PG8_WAIT_V(6); PG8_BAR; PG8_MMA(1, 1, At, B1); PG8_BAR;
            }
        }
        if constexpr (ALIGN_EPI) { if (wr == 0) PG8_BAR; }
        E(acc, cur, wr, wc, fr, fq); S.done(cur);
        if (!has_next) break;
#pragma unroll
        for (int a = 0; a < 2; ++a)
#pragma unroll
            for (int b = 0; b < 2; ++b)
#pragma unroll
                for (int m = 0; m < 4; ++m)
#pragma unroll
                    for (int n = 0; n < 2; ++n) acc[a][b][m][n] = (f32x4){0.f, 0.f, 0.f, 0.f};
        cur = nxt; cA = nA; cB = nB; nt = nt_nxt; ++ui;
        if constexpr (ALIGN_EPI) { if (wr == 1) PG8_BAR; }
    }
    PG8_WAIT_V(0);
    if constexpr (!ALIGN_EPI) { if (wr == 0) PG8_BAR; }
    PG8_BAR;
#undef PG8_BASEA
#undef PG8_BASEB
#undef PG8_SA
#undef PG8_SB
#undef PG8_STAGE
#undef PG8_LDA
#undef PG8_LDB
#undef PG8_MMA
#undef PG8_WAIT_V
#undef PG8_WAIT_L
#undef PG8_BAR
#undef PG8_SCHED
}
}

#define XB_TMO      128
#define XB_XCNT(j)  (256  + 64 * (j))
#define XB_XSUB(j)  (1280 + 64 * (j))
#define XB_XGEN(j)  (2304 + 64 * (j))
#define XB_TOP      3328
#define XB_TOPGEN   3392
#define XCD_BAR_WORDS 3456
#define XB_SPIN_CAP (1u << 22)
__device__ __forceinline__ unsigned xb_ld(unsigned* p)              { return __hip_atomic_load(p, __ATOMIC_RELAXED, __HIP_MEMORY_SCOPE_AGENT); }
__device__ __forceinline__ unsigned xb_add(unsigned* p, unsigned v) { return __hip_atomic_fetch_add(p, v, __ATOMIC_RELAXED, __HIP_MEMORY_SCOPE_AGENT); }
__device__ __forceinline__ unsigned xb_xcc_id() { return (unsigned)__builtin_amdgcn_s_getreg((3 << 11) | 20) & 0xFu; }
#define XB_SPIN(cond, bar) do { unsigned _sp = 0; while (cond) { __builtin_amdgcn_s_sleep(1); \
    if ((++_sp & 255u) == 0u) { if (xb_ld(&(bar)[XB_TMO])) break; if (_sp > XB_SPIN_CAP) { atomicAdd(&(bar)[XB_TMO], 1u); break; } } } } while (0)
struct XcdBarrier { unsigned* bar; unsigned x; volatile LAS unsigned* st; int wave; };
__device__ __forceinline__ XcdBarrier xcd_barrier_post(unsigned* bar, volatile LAS unsigned* st) {
    XcdBarrier b; b.bar = bar; b.x = xb_xcc_id(); b.st = st;
    if (threadIdx.x == 0) (void)xb_add(&bar[XB_XCNT(b.x)], 1u);
    return b;
}
__device__ __forceinline__ void xcd_barrier_complete(unsigned* bar, unsigned x, unsigned& nloc, unsigned& nx) {
    const unsigned G = gridDim.x * gridDim.y * gridDim.z;
    unsigned sum, cnt, mine, sp = 0u;
    for (;;) {
        sum = 0u; cnt = 0u; mine = 0u;
#pragma unroll
        for (unsigned j = 0; j < 16; ++j) { const unsigned c = xb_ld(&bar[XB_XCNT(j)]); sum += c; cnt += (c > 0u) ? 1u : 0u; mine = (j == x) ? c : mine; }
        if (sum == G) break;
        __builtin_amdgcn_s_sleep(1);
        if ((++sp & 255u) == 0u) { if (xb_ld(&bar[XB_TMO])) break; if (sp > XB_SPIN_CAP) { atomicAdd(&bar[XB_TMO], 1u); break; } }
    }
    nloc = mine > 0u ? mine : 1u; nx = cnt > 0u ? cnt : 1u;
}
__device__ __forceinline__ void xcd_barrier(const XcdBarrier& b) {
    asm volatile("s_waitcnt vmcnt(0)" ::: "memory");
    __syncthreads();
    if (b.wave == 0 && lane_id_asm() == 0) {
        unsigned* bar = b.bar; unsigned bx = b.x;
        asm volatile("" : "+s"(bar), "+s"(bx));
        __builtin_amdgcn_s_waitcnt(0);
        unsigned nloc = b.st[0], nx = b.st[1];
        if (nloc == 0u) { xcd_barrier_complete(bar, bx, nloc, nx); b.st[0] = nloc; b.st[1] = nx; }
        const unsigned old = xb_add(&bar[XB_XSUB(bx)], 1u);
        const unsigned gen = old / nloc;
        if (old + 1u == (gen + 1u) * nloc) {
            __builtin_amdgcn_fence(__ATOMIC_RELEASE, "agent");
            asm volatile("s_waitcnt vmcnt(0)" ::: "memory");
            const unsigned og = xb_add(&bar[XB_TOP], 1u);
            const unsigned tg = og / nx;
            if (og + 1u == (tg + 1u) * nx) xb_add(&bar[XB_TOPGEN], 1u);
            else XB_SPIN(xb_ld(&bar[XB_TOPGEN]) == tg, bar);
            __builtin_amdgcn_fence(__ATOMIC_ACQUIRE, "agent");
            xb_add(&bar[XB_XGEN(bx)], 1u);
            asm volatile("s_waitcnt vmcnt(0)" ::: "memory");
        } else {
            XB_SPIN(xb_ld(&bar[XB_XGEN(bx)]) == gen, bar);
            __builtin_amdgcn_fence(__ATOMIC_ACQUIRE, "agent");
            asm volatile("s_waitcnt vmcnt(0)" ::: "memory");
        }
    }
    __syncthreads();
}

constexpr int D = 2048, SEQ = 8192, M = 16384, DFF = 8192;
constexpr int NSA_N = 5376;
constexpr int NSA_N1 = 4096;
constexpr int DIL_N = 18432;
constexpr int DRNN = 2688, RG_N = 5632;
constexpr int RG_XOFF = 2816;
constexpr int NWAVES = 8, NTHREADS = 512;
constexpr int LDV = M + 64;
constexpr float ATT_SCALE = 0.08838834764831845f;
constexpr float NORM_EPS = 1e-6f;

constexpr int IN_X = 0, IN_C = 1, IN_NORMF = 45;
__host__ __device__ __forceinline__ constexpr int layer_base(int li) { return li == 0 ? 2 : li == 1 ? 13 : li == 2 ? 21 : 34; }
__host__ __device__ __forceinline__ constexpr int ff_off(int li) { return li == 1 ? 5 : li == 2 ? 10 : 8; }
__host__ __device__ __forceinline__ constexpr int wout_off(int li) { return li == 1 ? 4 : li == 2 ? 9 : 7; }

constexpr size_t MiB = 1u << 20;
constexpr size_t WS_CTL = 0, CTL_ZERO_BYTES = 1 * MiB;
constexpr size_t WS_MODP = 1 * MiB;
constexpr size_t WS_MOD = 4 * MiB;
constexpr size_t WS_COS = 5 * MiB, WS_SIN = 7 * MiB;
constexpr size_t WS_BPEP = 9 * MiB;
constexpr size_t WS_BPE = 9 * MiB + 512 * 1024;
constexpr size_t WS_LSP = 9 * MiB + 768 * 1024;
constexpr size_t WS_W = 10 * MiB;
constexpr size_t WE_NSA_WIN = 0, WE_NSA_W1 = 11010048, WE_NSA_WOUT = 11010048 + 4194304, WE_NSA_SZ = 19398656;
constexpr size_t WE_DIL = 2 * WE_NSA_SZ, WE_DIL_WOUT = WE_DIL + 37748736;
constexpr size_t WE_RG = WE_DIL + 41943040, WE_RG_WG = WE_RG + 11534336, WE_RG_WOUT = WE_RG_WG + 14450688;
constexpr size_t WE_FF = WE_RG + 31490048;
constexpr size_t WE_END = WE_FF + 4 * (size_t)33554432;
static_assert(WE_END == 246448128, "weight map");
constexpr size_t WS_HN = 482 * MiB;
constexpr size_t WS_ATT = 546 * MiB;
constexpr size_t WS_XR = 630 * MiB;
constexpr size_t WS_BIG = 694 * MiB;
static_assert(WS_W + WE_END * 2 <= WS_HN, "ws map");
constexpr size_t NS_Q = WS_BIG, NS_QR = NS_Q + 64 * MiB, NS_PK = NS_QR + 64 * MiB, NS_PV = NS_PK + 16 * MiB, NS_KS = NS_PV + 16 * MiB, NS_KW = NS_KS + 16 * MiB,
                 NS_VT = NS_KW + 16 * MiB  , NS_GT = NS_VT + 34 * MiB, NS_HC = NS_GT + 4 * MiB, NS_KC = NS_HC + 32 * MiB  ,
                 NS_VCT = NS_KC + 1 * MiB  , NS_END = NS_VCT + 1 * MiB;
constexpr size_t RG_YX = WS_BIG, RG_X = RG_YX + 176 * MiB, RG_A = RG_X + 84 * MiB, RG_B = RG_A + 168 * MiB, RG_CA = RG_B + 168 * MiB, RG_CB = RG_CA + 3 * MiB;
constexpr size_t DL_QK = WS_BIG, DL_VT = WS_BIG + 384 * MiB, DL_VT_STRIDE = 66 * MiB, DL_ML = WS_BIG + 582 * MiB;
constexpr size_t WS_END = WS_BIG + 610 * MiB;
static_assert(RG_CB + 3 * MiB <= WS_END && NS_END <= WS_END && DL_ML + 2 * MiB <= WS_END && WS_END <= (size_t)1396 * MiB, "ws map");

constexpr int RING_BYTES = 147456, MISC_OFF = RING_BYTES + 320, LDS_BYTES = 163840;

struct Params { const float* in[46]; float* out; unsigned char* ws; };

__device__ __forceinline__ float lo_bf(unsigned w) { return __uint_as_float(w << 16); }
__device__ __forceinline__ float hi_bf(unsigned w) { return __uint_as_float(w & 0xffff0000u); }
__device__ __forceinline__ unsigned pk2(float lo, float hi) { return pg8::cvt_pk_bf16(lo, hi); }
__device__ __forceinline__ float wave_sum(float v) {
#pragma unroll
    for (int o = 1; o < 64; o <<= 1) v += __shfl_xor(v, o);
    return v;
}
__device__ __forceinline__ float wave_max(float v) {
#pragma unroll
    for (int o = 1; o < 64; o <<= 1) v = fmaxf(v, __shfl_xor(v, o));
    return v;
}
__device__ __forceinline__ float sigmoidf_(float x) { return 1.0f / (1.0f + __expf(-x)); }
__device__ __forceinline__ float gelu_tanh(float x) { const float u = 0.7978845608028654f * (x + 0.044715f * x * x * x); const float e = __expf(2.0f * u); return 0.5f * x * (2.0f - 2.0f / (e + 1.0f)); }
__device__ __forceinline__ int sigma_d(int pos) { return (pos & 1) * 64 + (pos >> 1); }
__device__ __forceinline__ void store8_bf16(bf16* p, const f32x4 v0, const f32x4 v1) {
    u32x4 w; w.x = pk2(v0[0], v0[1]); w.y = pk2(v0[2], v0[3]); w.z = pk2(v1[0], v1[1]); w.w = pk2(v1[2], v1[3]); *(u32x4*)p = w; }
__device__ __forceinline__ void rope8(f32x4& v0, f32x4& v1, const float* cosr, const float* sinr, int i0) {
    const f32x4 cs = *(const f32x4*)(cosr + i0), sn = *(const f32x4*)(sinr + i0);
    const f32x4 a = v0, b = v1;
    v0[0] = a[0] * cs[0] - a[1] * sn[0]; v0[1] = a[0] * sn[0] + a[1] * cs[0];
    v0[2] = a[2] * cs[1] - a[3] * sn[1]; v0[3] = a[2] * sn[1] + a[3] * cs[1];
    v1[0] = b[0] * cs[2] - b[1] * sn[2]; v1[1] = b[0] * sn[2] + b[1] * cs[2];
    v1[2] = b[2] * cs[3] - b[3] * sn[3]; v1[3] = b[2] * sn[3] + b[3] * cs[3];
}

__device__ __forceinline__ void rope8v(f32x4& v0, f32x4& v1, const f32x4 cs, const f32x4 sn) {
    const f32x4 a = v0, b = v1;
    v0[0] = a[0] * cs[0] - a[1] * sn[0]; v0[1] = a[0] * sn[0] + a[1] * cs[0];
    v0[2] = a[2] * cs[1] - a[3] * sn[1]; v0[3] = a[2] * sn[1] + a[3] * cs[1];
    v1[0] = b[0] * cs[2] - b[1] * sn[2]; v1[1] = b[0] * sn[2] + b[1] * cs[2];
    v1[2] = b[2] * cs[3] - b[3] * sn[3]; v1[3] = b[2] * sn[3] + b[3] * cs[3];
}
#define EPI_LOOP_ROWS for (int ai = 0; ai < 2; ++ai) _Pragma("unroll") for (int m = 0; m < 4; ++m)
struct EpiNsaIn {
    static constexpr bool PERM = true, AFTER_DRAIN = false;
    bf16 *Q, *QR, *PK, *PV, *KS, *KW; float* GT; const float *COS, *SIN;
    __device__ __forceinline__ void operator()(const f32x4 (&acc)[2][2][4][2], const pg8::Unit& u, int wr, int wc, int fr, int fq) const {
        const int pn = u.pn, row0 = u.pm * 256 + wr * 64 + fr, cl = wc * 32 + 8 * fq;
        const bool rot = pn < 8 || pn >= 12;
#pragma unroll
        for (int ai = 0; ai < 2; ++ai) {
            f32x4 cs[4], sn[4];
            if (rot) {
#pragma unroll
                for (int m = 0; m < 4; ++m) { const int t = (row0 + ai * 128 + m * 16) & (SEQ - 1); cs[m] = *(const f32x4*)(COS + (size_t)t * 64 + (cl >> 1)); sn[m] = *(const f32x4*)(SIN + (size_t)t * 64 + (cl >> 1)); } }
#pragma unroll
            for (int m = 0; m < 4; ++m) {
                const int row = row0 + ai * 128 + m * 16, t = row & (SEQ - 1), b = row >> 13;
#pragma unroll
                for (int bj = 0; bj < 2; ++bj) {
                    f32x4 v0 = acc[ai][bj][m][0], v1 = acc[ai][bj][m][1];
                    const int hh = (pn & 1) * 2 + bj;
                    if (pn < 8) {
                        const size_t o = (size_t)row * 2048 + pn * 256 + bj * 128 + cl;
                        store8_bf16(Q + o, v0, v1);
                        rope8v(v0, v1, cs[m], sn[m]);
                        store8_bf16(QR + o, v0, v1);
                    } else if (pn < 12) {
                        bf16* P = pn < 10 ? PK : PV;
                        const size_t o = ((size_t)((b * 4 + hh) * 512 + (t >> 4))) * 2048 + (t & 15) * 128 + cl;
                        store8_bf16(P + o, v0, v1);
                    } else {
                        bf16* P = pn < 14 ? KS : KW;
                        rope8v(v0, v1, cs[m], sn[m]);
                        store8_bf16(P + (size_t)row * 512 + hh * 128 + cl, v0, v1);
                    }
                }
            }
        }
    }
};
struct EpiGates {
    static constexpr bool PERM = true, AFTER_DRAIN = false;
    float* GT;
    __device__ __forceinline__ void operator()(const f32x4 (&acc)[2][2][4][2], const pg8::Unit& u, int wr, int wc, int fr, int fq) const {
        const int row0 = u.pm * 256 + wr * 64 + fr, cl = wc * 32 + 8 * fq;
        if (cl < 48) {
#pragma unroll
            EPI_LOOP_ROWS { const int row = row0 + ai * 128 + m * 16; const f32x4 v0 = acc[ai][0][m][0], v1 = acc[ai][0][m][1];
#pragma unroll
                for (int e = 0; e < 4; ++e) { GT[(size_t)row * 48 + cl + e] = sigmoidf_(v0[e]); GT[(size_t)row * 48 + cl + 4 + e] = sigmoidf_(v1[e]); } }
        }
    }
};
struct EpiDilQK {
    static constexpr bool PERM = true, AFTER_DRAIN = false;
    bf16* O; const float *COS, *SIN; int dsh;
    __device__ __forceinline__ void operator()(const f32x4 (&acc)[2][2][4][2], const pg8::Unit& u, int wr, int wc, int fr, int fq) const {
        const int pn = u.pn, row0 = u.pm * 256 + wr * 64 + fr, cl = wc * 32 + 8 * fq, sh = 13 - dsh;
#pragma unroll
        for (int ai = 0; ai < 2; ++ai) {
            f32x4 cs[4], sn[4];
#pragma unroll
            for (int m = 0; m < 4; ++m) { const int row = row0 + ai * 128 + m * 16, rem = row & (SEQ - 1), t = ((rem & ((1 << sh) - 1)) << dsh) + (rem >> sh);
                cs[m] = *(const f32x4*)(COS + (size_t)t * 64 + (cl >> 1)); sn[m] = *(const f32x4*)(SIN + (size_t)t * 64 + (cl >> 1)); }
#pragma unroll
            for (int m = 0; m < 4; ++m) { const int row = row0 + ai * 128 + m * 16;
#pragma unroll
                for (int bj = 0; bj < 2; ++bj) {
                    f32x4 v0 = acc[ai][bj][m][0], v1 = acc[ai][bj][m][1];
                    rope8v(v0, v1, cs[m], sn[m]);
                    store8_bf16(O + (size_t)row * 4096 + pn * 256 + bj * 128 + cl, v0, v1);
                } }
        }
    }
};
template <int ACT> struct EpiBf16 {
    static constexpr bool PERM = true, AFTER_DRAIN = false;
    bf16* O; int ldc; int act_tiles;
    __device__ __forceinline__ void operator()(const f32x4 (&acc)[2][2][4][2], const pg8::Unit& u, int wr, int wc, int fr, int fq) const {
        const int pn = u.pn, row0 = u.pm * 256 + wr * 64 + fr, cl = wc * 32 + 8 * fq;
        const bool act = pn < act_tiles;
#pragma unroll
        EPI_LOOP_ROWS {
            const int row = row0 + ai * 128 + m * 16;
#pragma unroll
            for (int bj = 0; bj < 2; ++bj) {
                f32x4 v0 = acc[ai][bj][m][0], v1 = acc[ai][bj][m][1];
                if (ACT == 1) {
#pragma unroll
                    for (int e = 0; e < 4; ++e) { const float a = fmaxf(v0[e], 0.f), c = fmaxf(v1[e], 0.f); v0[e] = a * a; v1[e] = c * c; }
                }
                if (ACT == 2) { if (act) {
#pragma unroll
                    for (int e = 0; e < 4; ++e) { v0[e] = gelu_tanh(v0[e]); v1[e] = gelu_tanh(v1[e]); } } }
                store8_bf16(O + (size_t)row * ldc + pn * 256 + bj * 128 + cl, v0, v1);
            }
        }
    }
};
struct EpiF32 {
    static constexpr bool PERM = false, AFTER_DRAIN = false;
    float* C; int ldc;
    __device__ __forceinline__ void operator()(const f32x4 (&acc)[2][2][4][2], const pg8::Unit& u, int wr, int wc, int fr, int fq) const {
        const int row0 = u.pm * 256 + wr * 64 + fr, col0 = u.pn * 256 + wc * 32 + 4 * fq;
#pragma unroll
        EPI_LOOP_ROWS {
            float* rowp = C + (size_t)(row0 + ai * 128 + m * 16) * ldc + col0;
#pragma unroll
            for (int bj = 0; bj < 2; ++bj)
#pragma unroll
                for (int n = 0; n < 2; ++n) *(f32x4*)(rowp + bj * 128 + n * 16) = acc[ai][bj][m][n];
        }
    }
};
struct EpiRes {
    static constexpr bool PERM = true, AFTER_DRAIN = false;
    const float* xin32; const bf16* xin16; bf16* out; const float* gate;
    __device__ __forceinline__ void operator()(const f32x4 (&acc)[2][2][4][2], const pg8::Unit& u, int wr, int wc, int fr, int fq) const {
        const int row0 = u.pm * 256 + wr * 64 + fr, cl = wc * 32 + 8 * fq, b = (u.pm * 256) >> 13;
        f32x4 g0[2], g1[2];
#pragma unroll
        for (int bj = 0; bj < 2; ++bj) { const float* gp = gate + (size_t)b * 12288 + u.pn * 256 + bj * 128 + cl; g0[bj] = *(const f32x4*)gp; g1[bj] = *(const f32x4*)(gp + 4); }
#pragma unroll
        for (int ai = 0; ai < 2; ++ai) {
            f32x4 x0[4][2], x1[4][2];
#pragma unroll
            for (int m = 0; m < 4; ++m)
#pragma unroll
                for (int bj = 0; bj < 2; ++bj) { const size_t o = (size_t)(row0 + ai * 128 + m * 16) * D + u.pn * 256 + bj * 128 + cl;
                    if (xin32) { x0[m][bj] = *(const f32x4*)(xin32 + o); x1[m][bj] = *(const f32x4*)(xin32 + o + 4); }
                    else { const u32x4 w = *(const u32x4*)(xin16 + o); x0[m][bj] = (f32x4){lo_bf(w.x), hi_bf(w.x), lo_bf(w.y), hi_bf(w.y)}; x1[m][bj] = (f32x4){lo_bf(w.z), hi_bf(w.z), lo_bf(w.w), hi_bf(w.w)}; } }
#pragma unroll
            for (int m = 0; m < 4; ++m)
#pragma unroll
                for (int bj = 0; bj < 2; ++bj) store8_bf16(out + (size_t)(row0 + ai * 128 + m * 16) * D + u.pn * 256 + bj * 128 + cl, x0[m][bj] + g0[bj] * acc[ai][bj][m][0], x1[m][bj] + g1[bj] * acc[ai][bj][m][1]);
        }
    }
};
struct EpiRgGate {
    static constexpr bool PERM = true, AFTER_DRAIN = false;
    const bf16* X; const float *bgate, *LSP; unsigned* AB;
    __device__ __forceinline__ void operator()(const f32x4 (&acc)[2][2][4][2], const pg8::Unit& u, int wr, int wc, int fr, int fq) const {
        const int row0 = u.pm * 256 + wr * 64 + fr, ch0 = u.pn * 128 + wc * 32 + 8 * fq;
        u32x4 xw[2][4];
#pragma unroll
        for (int ai = 0; ai < 2; ++ai)
#pragma unroll
            for (int m = 0; m < 4; ++m) xw[ai][m] = *(const u32x4*)(X + (size_t)(row0 + ai * 128 + m * 16) * DRNN + ch0);
        const f32x4 br0 = *(const f32x4*)(bgate + ch0), br1 = *(const f32x4*)(bgate + ch0 + 4);
        const f32x4 bi0 = *(const f32x4*)(bgate + DRNN + ch0), bi1 = *(const f32x4*)(bgate + DRNN + ch0 + 4);
        const f32x4 ls0 = *(const f32x4*)(LSP + ch0), ls1 = *(const f32x4*)(LSP + ch0 + 4);
#pragma unroll
        EPI_LOOP_ROWS {
            const size_t o = (size_t)(row0 + ai * 128 + m * 16) * DRNN + ch0;
            const u32x4 xv = xw[ai][m];
            const f32x4 x0 = (f32x4){lo_bf(xv.x), hi_bf(xv.x), lo_bf(xv.y), hi_bf(xv.y)}, x1 = (f32x4){lo_bf(xv.z), hi_bf(xv.z), lo_bf(xv.w), hi_bf(xv.w)};
            const f32x4 r0 = acc[ai][0][m][0] + br0, r1 = acc[ai][0][m][1] + br1, i0 = acc[ai][1][m][0] + bi0, i1 = acc[ai][1][m][1] + bi1;
            u32x4 w0, w1;
#pragma unroll
            for (int e = 0; e < 4; ++e) {
                float la = ls0[e] * sigmoidf_(r0[e]); float bb = sqrtf(fmaxf(-expm1f(2.0f * la), 0.f)) * (sigmoidf_(i0[e]) * x0[e]); w0[e] = pk2(la * 1.4426950408889634f, bb);
                la = ls1[e] * sigmoidf_(r1[e]); bb = sqrtf(fmaxf(-expm1f(2.0f * la), 0.f)) * (sigmoidf_(i1[e]) * x1[e]); w1[e] = pk2(la * 1.4426950408889634f, bb);
            }
            *(u32x4*)(AB + o) = w0; *(u32x4*)(AB + o + 4) = w1;
        }
    }
};

__device__ __forceinline__ const float* inp(const Params& P, int i) { i = __builtin_amdgcn_readfirstlane(i); asm volatile("" : "+s"(i)); return P.in[i]; }
enum { MAP_ID = 0, MAP_NSA = 1, MAP_DIL = 2, MAP_RG = 3 };
struct Job { const float* W; int ldw, K; bf16* WT; int ldt, n_begin, n_rows, map, srcoff; };
__device__ __forceinline__ int srccol(int map, int n, int srcoff) {
    if (map == MAP_ID) return n + srcoff;
    if (map == MAP_NSA) {
        if (n < 2048) return (n & ~127) + sigma_d(n & 127);
        if (n < 3072) return n;
        if (n < 3584) return (n & ~127) + sigma_d(n & 127);
        if (n < 4096) return ((n + 512) & ~127) + sigma_d(n & 127);
        if (n < 4144) return 5120 + (n - 4096);
        if (n < 4352) return -1;
        if (n < 4864) return n - 768;
        return n - 256;
    }
    if (map == MAP_DIL) { const int j = (n >> 11) % 3; return j < 2 ? (n & ~127) + sigma_d(n & 127) : n; }
    if (n < DRNN) return n; if (n < RG_XOFF) return -1; if (n < RG_XOFF + DRNN) return n - (RG_XOFF - DRNN); return -1;
}
__device__ __forceinline__ bool is_sigma(int map, int n) {
    if (map == MAP_NSA) return n < 2048 || (n >= 3072 && n < 4096);
    if (map == MAP_DIL) return ((n >> 11) % 3) < 2;
    return false;
}
__device__ __forceinline__ void conv_item(const Job& J, int item, LAS float* scr, int lane) {
    const int nblk = J.n_rows / 32, kb = item / nblk, nb = item % nblk, k0 = 64 * kb, n0 = J.n_begin + 32 * nb, nl0 = n0 - J.n_begin;
    const int ks = lane >> 3, c4 = lane & 7;
    const bool sig = is_sigma(J.map, nl0);
    const int dl0 = sig ? 8 * (c4 & 3) + (c4 >> 2) : 4 * c4, dstep = sig ? 2 : 1;
    const int sc4 = srccol(J.map, nl0 + dl0, J.srcoff);
    f32x4 v[8];
#pragma unroll
    for (int i = 0; i < 8; ++i) v[i] = sc4 >= 0 ? __builtin_nontemporal_load((const f32x4*)(J.W + (size_t)(k0 + 8 * i + ks) * J.ldw + sc4)) : (f32x4){0.f, 0.f, 0.f, 0.f};
#pragma unroll
    for (int i = 0; i < 8; ++i) { LAS float* d = scr + (8 * i + ks) * 33 + dl0; d[0] = v[i][0]; d[dstep] = v[i][1]; d[2 * dstep] = v[i][2]; d[3 * dstep] = v[i][3]; }
    LDS_WAIT();
    const int c = lane & 7;
#pragma unroll
    for (int j = 0; j < 4; ++j) { const int n = (lane >> 3) + 8 * j; const LAS float* sp = scr + (8 * c) * 33 + n;
        u32x4 o; o.x = pk2(sp[0 * 33], sp[1 * 33]); o.y = pk2(sp[2 * 33], sp[3 * 33]); o.z = pk2(sp[4 * 33], sp[5 * 33]); o.w = pk2(sp[6 * 33], sp[7 * 33]);
        *(u32x4*)(J.WT + (size_t)(n0 + n) * J.ldt + k0 + 8 * c) = o; }
    LDS_WAIT();
}
constexpr int NJOBS = 24;
__device__ __forceinline__ Job get_job(const Params& P, int jid) {
    bf16* WB = (bf16*)(P.ws + WS_W);
    Job J; J.srcoff = 0; J.map = MAP_ID; J.n_begin = 0;
    if (jid < 12) {
        const int slot = jid / 6, r = jid % 6, bi = slot == 0 ? 2 : 34; bf16* base = WB + (size_t)slot * WE_NSA_SZ;
        if (r == 0) { J.W = inp(P, bi + 3); J.ldw = 5168; J.K = 2048; J.WT = base + WE_NSA_WIN; J.ldt = 2048; J.n_rows = NSA_N; J.map = MAP_NSA; }
        else if (r < 5) { const int kv = (r - 1) >> 1, half = (r - 1) & 1;
            J.W = inp(P, bi + 5) + (size_t)kv * 4096 * 512 + (size_t)half * 2048 * 512; J.ldw = 512; J.K = 2048;
            J.WT = base + WE_NSA_W1 + (size_t)kv * 1024 * 2048; J.ldt = 2048; J.n_begin = half * 512; J.n_rows = 512; }
        else { J.W = inp(P, bi + 7); J.ldw = 2048; J.K = 2048; J.WT = base + WE_NSA_WOUT; J.ldt = 2048; J.n_rows = 2048; }
    } else if (jid == 12) { J.W = inp(P, 13 + 3); J.ldw = DIL_N; J.K = 2048; J.WT = WB + WE_DIL; J.ldt = 2048; J.n_rows = DIL_N; J.map = MAP_DIL; }
    else if (jid == 13) { J.W = inp(P, 13 + 4); J.ldw = 2048; J.K = 2048; J.WT = WB + WE_DIL_WOUT; J.ldt = 2048; J.n_rows = 2048; }
    else if (jid == 14) { J.W = inp(P, 21 + 3); J.ldw = 2 * DRNN; J.K = 2048; J.WT = WB + WE_RG; J.ldt = 2048; J.n_rows = RG_N; J.map = MAP_RG; }
    else if (jid == 15) { J.W = inp(P, 21 + 9); J.ldw = 2048; J.K = DRNN; J.WT = WB + WE_RG_WOUT; J.ldt = DRNN; J.n_rows = 2048; }
    else { const int li = (jid - 16) >> 1, w = (jid - 16) & 1, bi = layer_base(li) + ff_off(li);
        if (w == 0) { J.W = inp(P, bi + 1); J.ldw = DFF; J.K = 2048; J.WT = WB + WE_FF + (size_t)li * 33554432; J.ldt = 2048; J.n_rows = DFF; }
        else { J.W = inp(P, bi + 2); J.ldw = 2048; J.K = DFF; J.WT = WB + WE_FF + (size_t)li * 33554432 + 16777216; J.ldt = DFF; J.n_rows = 2048; } }
    return J;
}

namespace fa {
typedef float f32x16 __attribute__((ext_vector_type(16)));
typedef short bf16x8 __attribute__((ext_vector_type(8)));
constexpr int KROW = 272, VROW = 144, KTILE = 64 * KROW, VTILE = 128 * VROW;
constexpr int KBUF0 = 0, VBUF0 = 3 * KTILE, IMP_OFF = VBUF0 + 2 * VTILE, MSK_OFF = RING_BYTES - 1024;
static_assert(IMP_OFF + 32768 <= MSK_OFF, "attention LDS map");
static_assert(MSK_OFF + 1024 <= RING_BYTES, "attention LDS map");
constexpr float C2 = ATT_SCALE * 1.4426950408889634f;
#define FA_MFMA(a, b, c) __builtin_amdgcn_mfma_f32_32x32x16_bf16(a, b, c, 0, 0, 0)
__device__ __forceinline__ float half_max(float v) { auto rr = __builtin_amdgcn_permlane32_swap(__float_as_uint(v), __float_as_uint(v), false, false); return fmaxf(__uint_as_float(rr[0]), __uint_as_float(rr[1])); }
__device__ __forceinline__ float half_sum(float v) { auto rr = __builtin_amdgcn_permlane32_swap(__float_as_uint(v), __float_as_uint(v), false, false); return __uint_as_float(rr[0]) + __uint_as_float(rr[1]); }
struct Src { const bf16* K0; long ldk; const bf16* V0; long ldv; int tsh; };
struct Stage { u32x4 k0, k1, v0, v1; };
__device__ __forceinline__ void stage_load_k(Stage& s, const Src& src, int T, int tid) {
    const int kr = tid >> 4, kc = tid & 15;
    const char* kb = (const char*)(src.K0 + (long)(64 * (T >> src.tsh)) * src.ldk); const char* kb2 = kb + 64 * src.ldk;
    unsigned ko = (unsigned)(kr * (int)src.ldk + kc * 8) * 2u; asm volatile("" : "+v"(ko));
    s.k0 = *(const u32x4*)(kb + ko); s.k1 = *(const u32x4*)(kb2 + ko);
}
__device__ __forceinline__ void stage_load_v(Stage& s, const Src& src, int T, int tid) {
    const int vr = tid >> 3, vp = tid & 7;
    const char* vb = (const char*)(src.V0 + 64 * (T >> src.tsh)); const char* vb2 = vb + 128 * src.ldv;
    unsigned vo = (unsigned)(vr * (int)src.ldv + vp * 8) * 2u; asm volatile("" : "+v"(vo));
    s.v0 = *(const u32x4*)(vb + vo); s.v1 = *(const u32x4*)(vb2 + vo);
}
__device__ __forceinline__ void stage_load(Stage& s, const Src& src, int T, int tid, bool withV) { stage_load_k(s, src, T, tid); if (withV) stage_load_v(s, src, T, tid); }
__device__ __forceinline__ void stage_write_k_at(const Stage& s, LAS unsigned char* ktile, int tid) {
    const int kr = tid >> 4, kc = tid & 15;
    LAS unsigned char* kb = ktile + kr * KROW + kc * 16;
    *(LAS u32x4*)kb = s.k0; *(LAS u32x4*)(kb + 32 * KROW) = s.k1;
}
__device__ __forceinline__ void stage_write_k(const Stage& s, LAS unsigned char* lds, int kbuf, int tid) { stage_write_k_at(s, lds + KBUF0 + kbuf * KTILE, tid); }
__device__ __forceinline__ void stage_write_v_at(const Stage& s, LAS unsigned char* vtile, int tid);
__device__ __forceinline__ void stage_write_v(const Stage& s, LAS unsigned char* lds, int vbuf, int tid) { stage_write_v_at(s, lds + VBUF0 + vbuf * VTILE, tid); }
__device__ __forceinline__ void stage_write_v_at(const Stage& s, LAS unsigned char* vtile, int tid) {
    const int vr = tid >> 3, vp = tid & 7, g16 = vp >> 1, half = vp & 1;
    LAS unsigned char* vb = vtile + vr * VROW + g16 * 32 + half * 8;
    *(LAS u32x2*)(vb) = (u32x2){s.v0.x, s.v0.y}; *(LAS u32x2*)(vb + 16) = (u32x2){s.v0.z, s.v0.w};
    *(LAS u32x2*)(vb + 64 * VROW) = (u32x2){s.v1.x, s.v1.y}; *(LAS u32x2*)(vb + 64 * VROW + 16) = (u32x2){s.v1.z, s.v1.w};
}
__device__ __forceinline__ void stage_write(const Stage& s, LAS unsigned char* lds, int buf, int tid, bool withV) { stage_write_k(s, lds, buf, tid); if (withV) stage_write_v(s, lds, buf, tid); }
__device__ __forceinline__ void load_q(bf16x8 (&qf)[8], const bf16* qrow, int hi) {
#pragma unroll
    for (int kk = 0; kk < 8; ++kk) qf[kk] = *(const bf16x8*)(qrow + kk * 16 + hi * 8);
}
#define FA_PIPE_16() do { __builtin_amdgcn_sched_group_barrier(0x100, 4, 0); \
    _Pragma("unroll") for (int i_ = 0; i_ < 12; ++i_) { __builtin_amdgcn_sched_group_barrier(0x008, 1, 0); __builtin_amdgcn_sched_group_barrier(0x100, 1, 0); } \
    __builtin_amdgcn_sched_group_barrier(0x008, 4, 0); } while (0)
__device__ __forceinline__ void qk_tile_at(f32x16& p0, f32x16& p1, const LAS unsigned char* ktile, const bf16x8 (&qf)[8], int c32, int hi);
__device__ __forceinline__ void qk_tile(f32x16& p0, f32x16& p1, const LAS unsigned char* lds, int buf, const bf16x8 (&qf)[8], int c32, int hi) { qk_tile_at(p0, p1, lds + KBUF0 + buf * KTILE, qf, c32, hi); }
__device__ __forceinline__ void qk_tile_at(f32x16& p0, f32x16& p1, const LAS unsigned char* ktile, const bf16x8 (&qf)[8], int c32, int hi) {
#pragma unroll
    for (int r = 0; r < 16; ++r) { p0[r] = 0.f; p1[r] = 0.f; }
    const LAS unsigned char* kb = ktile + c32 * KROW + hi * 16;
    bf16x8 a[16];
#pragma unroll
    for (int kk = 0; kk < 8; ++kk) { a[2 * kk] = *(const LAS bf16x8*)(kb + 32 * kk); a[2 * kk + 1] = *(const LAS bf16x8*)(kb + 32 * KROW + 32 * kk); }
#pragma unroll
    for (int kk = 0; kk < 8; ++kk) { p0 = FA_MFMA(a[2 * kk], qf[kk], p0); p1 = FA_MFMA(a[2 * kk + 1], qf[kk], p1); }
    FA_PIPE_16();
}
__device__ __forceinline__ void pv_tile_at(f32x16 (&o)[4], const LAS unsigned char* vtile, const bf16x8 (&pa)[4], int c32, int hi);
__device__ __forceinline__ void pv_tile(f32x16 (&o)[4], const LAS unsigned char* lds, int buf, const bf16x8 (&pa)[4], int c32, int hi) { pv_tile_at(o, lds + VBUF0 + buf * VTILE, pa, c32, hi); }
__device__ __forceinline__ void pv_tile_at(f32x16 (&o)[4], const LAS unsigned char* vtile, const bf16x8 (&pa)[4], int c32, int hi) {
    const LAS unsigned char* vb = vtile + c32 * VROW + hi * 16;
    bf16x8 a[16];
#pragma unroll
    for (int S = 0; S < 4; ++S)
#pragma unroll
        for (int db = 0; db < 4; ++db) a[4 * S + db] = *(const LAS bf16x8*)(vb + db * 32 * VROW + 32 * S);
#pragma unroll
    for (int S = 0; S < 4; ++S)
#pragma unroll
        for (int db = 0; db < 4; ++db) o[db] = FA_MFMA(a[4 * S + db], pa[S], o[db]);
    FA_PIPE_16();
}
__device__ __forceinline__ void mask_range(f32x16& p0, f32x16& p1, int lo, int hi_, int hi) {
    const int lo4 = lo - 4 * hi, hi4 = hi_ - 4 * hi;
#pragma unroll
    for (int r = 0; r < 16; ++r) { const int c = (r & 3) + 8 * (r >> 2);
        if (c < lo4 || c > hi4) p0[r] = -INFINITY;
        if (c + 32 < lo4 || c + 32 > hi4) p1[r] = -INFINITY; }
}
template <int B_> __device__ __forceinline__ bf16x8 pack8r(const f32x16& p) {
    u32x4 w; w.x = pk2(p[B_ + 0], p[B_ + 1]); w.y = pk2(p[B_ + 2], p[B_ + 3]); w.z = pk2(p[B_ + 4], p[B_ + 5]); w.w = pk2(p[B_ + 6], p[B_ + 7]);
    return __builtin_bit_cast(bf16x8, w); }
constexpr float THR = 8.0f;
__device__ __forceinline__ void softmax_step(f32x16& p0, f32x16& p1, bool rowoff, float& m, float& l, f32x16 (&o)[4], bf16x8 (&pa)[4]) {
    float mx = fmaxf(fmaxf(p0[0], p0[1]), p0[2]);
#pragma unroll
    for (int r = 3; r < 15; r += 2) mx = fmaxf(fmaxf(mx, p0[r]), p0[r + 1]);
    mx = fmaxf(mx, p0[15]);
#pragma unroll
    for (int r = 0; r < 16; r += 2) mx = fmaxf(fmaxf(mx, p1[r]), p1[r + 1]);
    mx = half_max(mx);
    if (rowoff) mx = -INFINITY;
    if (!__all((mx - m) * C2 <= THR)) {
        const float mn = fmaxf(m, mx), alpha = __builtin_amdgcn_exp2f((m - mn) * C2); m = mn; l *= alpha;
#pragma unroll
        for (int db = 0; db < 4; ++db) o[db] = o[db] * alpha;
    }
    const float mnL = rowoff ? -INFINITY : -m * C2;
    p0 = p0 * C2 + mnL; p1 = p1 * C2 + mnL;
#pragma unroll
    for (int r = 0; r < 16; ++r) { p0[r] = __builtin_amdgcn_exp2f(p0[r]); p1[r] = __builtin_amdgcn_exp2f(p1[r]); }
    f32x16 sv = p0 + p1;
    const float ps = ((sv[0] + sv[1]) + (sv[2] + sv[3])) + ((sv[4] + sv[5]) + (sv[6] + sv[7])) + (((sv[8] + sv[9]) + (sv[10] + sv[11])) + ((sv[12] + sv[13]) + (sv[14] + sv[15])));
    l += half_sum(ps);
    pa[0] = pack8r<0>(p0); pa[1] = pack8r<8>(p0); pa[2] = pack8r<0>(p1); pa[3] = pack8r<8>(p1);
}
struct Msk { int qlo, qhi; const LAS unsigned* sel; };
#define FA_PIPE_8() do { __builtin_amdgcn_sched_group_barrier(0x100, 4, 0); \
    _Pragma("unroll") for (int i_ = 0; i_ < 4; ++i_) { __builtin_amdgcn_sched_group_barrier(0x008, 1, 0); __builtin_amdgcn_sched_group_barrier(0x100, 1, 0); } \
    __builtin_amdgcn_sched_group_barrier(0x008, 4, 0); } while (0)
__device__ __forceinline__ void qk_half(f32x16& p, const LAS unsigned char* lds, int kbuf, int half, const bf16x8 (&qf)[8], int c32, int hi) {
#pragma unroll
    for (int r = 0; r < 16; ++r) p[r] = 0.f;
    const LAS unsigned char* kb = lds + KBUF0 + kbuf * KTILE + half * 32 * KROW + c32 * KROW + hi * 16;
    bf16x8 a[8];
#pragma unroll
    for (int kk = 0; kk < 8; ++kk) a[kk] = *(const LAS bf16x8*)(kb + 32 * kk);
#pragma unroll
    for (int kk = 0; kk < 8; ++kk) p = FA_MFMA(a[kk], qf[kk], p);
    FA_PIPE_8();
}
__device__ __forceinline__ void pv_half(f32x16 (&o)[4], const LAS unsigned char* lds, int vbuf, int half, const bf16x8 (&pa)[2], int c32, int hi) {
    const LAS unsigned char* vb = lds + VBUF0 + vbuf * VTILE + c32 * VROW + hi * 16 + half * 64;
    bf16x8 a[8];
#pragma unroll
    for (int s2 = 0; s2 < 2; ++s2)
#pragma unroll
        for (int db = 0; db < 4; ++db) a[4 * s2 + db] = *(const LAS bf16x8*)(vb + db * 32 * VROW + 32 * s2);
#pragma unroll
    for (int s2 = 0; s2 < 2; ++s2)
#pragma unroll
        for (int db = 0; db < 4; ++db) o[db] = FA_MFMA(a[4 * s2 + db], pa[s2], o[db]);
    FA_PIPE_8();
}
__device__ __forceinline__ void softmax_half(f32x16& p, int half, bool needrange, int lo, int hi_, int hi, bool rowoff, float& m, float& l, f32x16 (&o)[4], bf16x8 (&pa)[2]) {
    if (needrange) { const int lo4 = lo - 4 * hi - 32 * half, hi4 = hi_ - 4 * hi - 32 * half;
#pragma unroll
        for (int r = 0; r < 16; ++r) { const int c = (r & 3) + 8 * (r >> 2); if (c < lo4 || c > hi4) p[r] = -INFINITY; } }
    float mx = fmaxf(fmaxf(p[0], p[1]), p[2]);
#pragma unroll
    for (int r = 3; r < 15; r += 2) mx = fmaxf(fmaxf(mx, p[r]), p[r + 1]);
    mx = half_max(fmaxf(mx, p[15]));
    if (rowoff) mx = -INFINITY;
    if (!__all((mx - m) * C2 <= THR)) {
        const float mn = fmaxf(m, mx), alpha = __builtin_amdgcn_exp2f((m - mn) * C2); m = mn; l *= alpha;
#pragma unroll
        for (int db = 0; db < 4; ++db) o[db] = o[db] * alpha;
    }
    const float mnL = rowoff ? -INFINITY : -m * C2;
#pragma unroll
    for (int r = 0; r < 16; ++r) p[r] = __builtin_amdgcn_exp2f(fmaf(p[r], C2, mnL));
    const float ps = (((p[0] + p[1]) + (p[2] + p[3])) + ((p[4] + p[5]) + (p[6] + p[7]))) + (((p[8] + p[9]) + (p[10] + p[11])) + ((p[12] + p[13]) + (p[14] + p[15])));
    l += half_sum(ps);
    pa[0] = pack8r<0>(p); pa[1] = pack8r<8>(p);
}
__device__ __forceinline__ void flash_flags(const Msk& mk, int Tt, int tsh, int& lo, int& hi_, bool& rowoff) {
    const int T = Tt >> tsh;
    lo = mk.qlo - 64 * T; hi_ = mk.qhi - 64 * T;
    rowoff = !(hi_ >= 0 && lo <= 63);
    if (mk.sel) { const unsigned w = mk.sel[T >> 5]; rowoff = rowoff || (((w >> (T & 31)) & 1u) == 0u); }
}
__device__ __forceinline__ void flash_pass(LAS unsigned char* lds, int tid, int c32, int hi, int T0, int T1, const Src& src, const Msk& mk, const bf16x8 (&qf)[8],
                                           float& m, float& l, f32x16 (&o)[4]) {
    Stage st; f32x16 sA, sB;
    const int n = T1 - T0 + 1; const bool lateqk = __builtin_amdgcn_readfirstlane(tid >> 8) != 0;
    __syncthreads();
    {   Stage st1;
        stage_load(st, src, T0, tid, true); if (n > 1) stage_load_k(st1, src, T0 + 1, tid);
        stage_write(st, lds, 0, tid, true); if (n > 1) stage_write_k(st1, lds, 1, tid); }
    if (n > 2) stage_load_k(st, src, T0 + 2, tid);
    if (n > 1) stage_load_v(st, src, T0 + 1, tid);
    __syncthreads();
    int lo, hi_; bool rowoff; flash_flags(mk, T0, src.tsh, lo, hi_, rowoff);
    bool act = !__all(rowoff);
    if (act) qk_half(sA, lds, 0, 0, qf, c32, hi);
#pragma unroll 1
    for (int i = 0; i < n; ++i) {
        if (i > 0) __syncthreads();
        if (i + 2 < n) stage_write_k(st, lds, (i + 2) % 3, tid);
        if (i + 1 < n) stage_write_v(st, lds, (i + 1) & 1, tid);
        if (i + 3 < n) stage_load_k(st, src, T0 + i + 3, tid);
        if (i + 2 < n) stage_load_v(st, src, T0 + i + 2, tid);
        const bool needrange = __any(!rowoff && !(lo <= 0 && hi_ >= 63));
        bf16x8 pa[2];
        if (act) { if (!lateqk) qk_half(sB, lds, i % 3, 1, qf, c32, hi);
                   softmax_half(sA, 0, needrange, lo, hi_, hi, rowoff, m, l, o, pa); pv_half(o, lds, i & 1, 0, pa, c32, hi);
                   if (lateqk) qk_half(sB, lds, i % 3, 1, qf, c32, hi); }
        int lo2 = 0, hi2 = 0; bool off2 = true, act2 = false;
        if (i + 1 < n) { flash_flags(mk, T0 + i + 1, src.tsh, lo2, hi2, off2); act2 = !__all(off2); }
        if (act2 && !lateqk) qk_half(sA, lds, (i + 1) % 3, 0, qf, c32, hi);
        if (act) { softmax_half(sB, 1, needrange, lo, hi_, hi, rowoff, m, l, o, pa); pv_half(o, lds, i & 1, 1, pa, c32, hi); }
        if (act2 && lateqk) qk_half(sA, lds, (i + 1) % 3, 0, qf, c32, hi);
        lo = lo2; hi_ = hi2; rowoff = off2; act = act2;
    }
}

constexpr int ASLOT = KTILE + VTILE;
constexpr int ANSLOT = 4;
static_assert(ANSLOT * ASLOT <= MSK_OFF, "async ring must not reach the selection masks");
__device__ __forceinline__ void lds_signal(volatile LAS unsigned* w, int lane) {
    asm volatile("s_waitcnt lgkmcnt(0)" ::: "memory");
    if (lane == 0) (void)__hip_atomic_fetch_add((LAS unsigned*)w, 1u, __ATOMIC_RELAXED, __HIP_MEMORY_SCOPE_WORKGROUP);
}
__device__ __forceinline__ void lds_wait(volatile LAS unsigned* w, unsigned target) {
    unsigned spins = 0;
    while ((unsigned)__builtin_amdgcn_readfirstlane(*w) < target) { __builtin_amdgcn_s_sleep(1); if (++spins > (1u << 22)) break; }
    asm volatile("" ::: "memory");
}
__device__ __forceinline__ void flash_pass_async(LAS unsigned char* lds, int tid, int lane, int c32, int hi, int T0, int T1, const Src& src, const Msk& mk, const bf16x8 (&qf)[8],
                                                 float& m, float& l, f32x16 (&o)[4]) {
    volatile LAS unsigned* fill = (volatile LAS unsigned*)(lds + RING_BYTES + 2048); volatile LAS unsigned* done = fill + 8;
    const int n = T1 - T0 + 1;
    Stage st;
    __syncthreads();
    if (tid < 16) fill[tid] = 0u;
    stage_load(st, src, T0, tid, true);
    __syncthreads();
    stage_write_k_at(st, lds, tid); stage_write_v_at(st, lds + KTILE, tid); lds_signal(fill + 0, lane);
    if (n > 1) stage_load(st, src, T0 + 1, tid, true);
#pragma unroll 1
    for (int i = 0; i < n; ++i) {
        const int s0 = i % ANSLOT;
        if (i + 1 < n) { const int s1 = (i + 1) % ANSLOT;
            lds_wait(done + s1, 8u * (unsigned)((i + 1) / ANSLOT));
            stage_write_k_at(st, lds + s1 * ASLOT, tid); stage_write_v_at(st, lds + s1 * ASLOT + KTILE, tid); lds_signal(fill + s1, lane);
            if (i + 2 < n) stage_load(st, src, T0 + i + 2, tid, true); }
        int lo, hi_; bool rowoff; flash_flags(mk, T0 + i, src.tsh, lo, hi_, rowoff);
        if (!__all(rowoff)) {
            lds_wait(fill + s0, 8u * (unsigned)(i / ANSLOT + 1));
            f32x16 p0, p1; bf16x8 pa[4];
            qk_tile_at(p0, p1, lds + s0 * ASLOT, qf, c32, hi);
            if (__any(!rowoff && !(lo <= 0 && hi_ >= 63))) mask_range(p0, p1, lo, hi_, hi);
            softmax_step(p0, p1, rowoff, m, l, o, pa);
            pv_tile_at(o, lds + s0 * ASLOT + KTILE, pa, c32, hi);
        }
        lds_signal(done + s0, lane);
    }
}
}

__device__ __forceinline__ void nsa_item(LAS unsigned char* lds, int wave, int lane, int b, int g, int c, const bf16* Q, const bf16* QR, const bf16* KCB, const bf16* VCT,
                                         const bf16* KS, const bf16* KW, const bf16* VT, const float* GT, float* OACC, bf16* ATT) {
    using namespace fa;
    const int tid = wave * 64 + lane, c32 = lane & 31, hi = lane >> 5;
    const int tl = wave * 8 + (c32 >> 2), head = c32 & 3, t = c * 64 + tl, mrow = b * SEQ + t, hq = g * 4 + head, bg = b * 4 + g;
    LAS float* IMP = (LAS float*)(lds + IMP_OFF); LAS unsigned* MSK = (LAS unsigned*)(lds + MSK_OFF);
    bf16x8 qf[8]; f32x16 o[4]; float m, l; u32x4 pk[8];
#define NSA_PTRS() int mr_ = mrow, hq_ = hq; asm volatile("" : "+v"(mr_), "+v"(hq_)); const float* gp = GT + (size_t)(mr_ * 48 + hq_ * 3); float* oacc = OACC + (size_t)mr_ * 2048 + (unsigned)(hq_ * 128); (void)gp; (void)oacc
    {
        { int mr_ = mrow, hq_ = hq; asm volatile("" : "+v"(mr_), "+v"(hq_)); load_q(qf, Q + (size_t)mr_ * 2048 + (unsigned)(hq_ * 128), hi); }
        const int NTc = (4 * c + 3 + 63) >> 6;
        const int qhi = (t - 31) >> 4;
        const Src src{KCB + (size_t)bg * 512 * 128, 128, VCT + (size_t)bg * 128 * 512, 512, 0};
        m = -1e30f; l = 0.f;
        Stage st;
        __syncthreads();
        stage_load(st, src, 0, tid, false);
#pragma unroll 1
        for (int T = 0; T < NTc; ++T) {
            const int buf = T & 1;
            stage_write(st, lds, buf, tid, false);
            __syncthreads();
            if (T + 1 < NTc) stage_load(st, src, T + 1, tid, false);
            f32x16 p0, p1;
            qk_tile(p0, p1, lds, buf, qf, c32, hi);
            mask_range(p0, p1, 0, qhi - 64 * T, hi);
            float mx = p0[0];
#pragma unroll
            for (int r = 1; r < 16; ++r) mx = fmaxf(mx, p0[r]);
#pragma unroll
            for (int r = 0; r < 16; ++r) mx = fmaxf(mx, p1[r]);
            mx = half_max(mx);
            const float mn = fmaxf(m, mx), alpha = __builtin_amdgcn_exp2f((m - mn) * C2), mnL = -mn * C2; m = mn;
            float ps = 0.f;
#pragma unroll
            for (int r = 0; r < 16; ++r) ps += __builtin_amdgcn_exp2f(fmaf(p0[r], C2, mnL)) + __builtin_amdgcn_exp2f(fmaf(p1[r], C2, mnL));
            l = l * alpha + half_sum(ps);
        }
        const float inv = l > 0.f ? 1.0f / l : 0.f, mnL = -m * C2;
#pragma unroll
        for (int db = 0; db < 4; ++db)
#pragma unroll
            for (int r = 0; r < 16; ++r) o[db][r] = 0.f;
        float carry = 0.f;
        __syncthreads();
        stage_load(st, src, 0, tid, true);
#pragma unroll 1
        for (int T = 0; T < NTc; ++T) {
            const int buf = T & 1;
            stage_write(st, lds, buf, tid, true);
            __syncthreads();
            if (T + 1 < NTc) stage_load(st, src, T + 1, tid, true);
            f32x16 p0, p1; bf16x8 pa[4];
            qk_tile(p0, p1, lds, buf, qf, c32, hi);
            mask_range(p0, p1, 0, qhi - 64 * T, hi);
#pragma unroll
            for (int r = 0; r < 16; ++r) { p0[r] = __builtin_amdgcn_exp2f(fmaf(p0[r], C2, mnL)) * inv; p1[r] = __builtin_amdgcn_exp2f(fmaf(p1[r], C2, mnL)) * inv; }
#pragma unroll
            for (int hf = 0; hf < 2; ++hf) {
                float qs[4], flo[4], fhi[4];
#pragma unroll
                for (int q4 = 0; q4 < 4; ++q4) {
                    const float e0 = hf ? p1[4 * q4] : p0[4 * q4], e1 = hf ? p1[4 * q4 + 1] : p0[4 * q4 + 1], e2 = hf ? p1[4 * q4 + 2] : p0[4 * q4 + 2], e3 = hf ? p1[4 * q4 + 3] : p0[4 * q4 + 3];
                    qs[q4] = (e0 + e1) + (e2 + e3);
                    auto rr = __builtin_amdgcn_permlane32_swap(__float_as_uint(e3), __float_as_uint(e3), false, false);
                    flo[q4] = __uint_as_float(rr[0]); fhi[q4] = __uint_as_float(rr[1]);
                }
#pragma unroll
                for (int q4 = 0; q4 < 4; ++q4) {
                    const float cin = hi ? flo[q4] : (q4 == 0 ? carry : fhi[q4 == 0 ? 0 : q4 - 1]);
                    float v = qs[q4] + cin; v += __shfl_xor(v, 1); v += __shfl_xor(v, 2);
                    if (head == 0) IMP[tl * 128 + 16 * T + 8 * hf + 2 * q4 + hi] = v;
                }
                carry = fhi[3];
            }
            pa[0] = pack8r<0>(p0); pa[1] = pack8r<8>(p0); pa[2] = pack8r<0>(p1); pa[3] = pack8r<8>(p1);
            pv_tile(o, lds, buf, pa, c32, hi);
        }
        NSA_PTRS();
        const float g0 = gp[0];
#pragma unroll
        for (int db = 0; db < 4; ++db)
#pragma unroll
            for (int q4 = 0; q4 < 4; ++q4) { pk[2 * db + (q4 >> 1)][2 * (q4 & 1)] = pk2(o[db][4 * q4] * g0, o[db][4 * q4 + 1] * g0); pk[2 * db + (q4 >> 1)][2 * (q4 & 1) + 1] = pk2(o[db][4 * q4 + 2] * g0, o[db][4 * q4 + 3] * g0); }
    }
    LDS_WAIT();
#ifndef REP_TOPK
#define REP_TOPK 1
#endif
#pragma unroll 1
    for (int rep_ = 0; rep_ < fresh_s(REP_TOPK); ++rep_)
#pragma unroll 1
    for (int tk = 0; tk < 8; ++tk) {
        LAS float* row = IMP + (wave * 8 + tk) * 128;
        const int j0 = lane, j1 = lane + 64;
        const float v0 = row[j0], v1 = row[j1];
        const float val0 = j0 > c ? -INFINITY : ((j0 == 0 || j0 == c || j0 == c - 1) ? 3.0e38f : v0);
        const float val1 = j1 > c ? -INFINITY : ((j1 == c || j1 == c - 1) ? 3.0e38f : v1);
        LDS_WAIT();
        row[j0] = val0; row[j1] = val1;
        LDS_WAIT();
        int cnt0 = 0, cnt1 = 0;
#pragma unroll 4
        for (int i4 = 0; i4 <= (c >> 2); ++i4) {
            const f32x4 x = *(const LAS f32x4*)(row + 4 * i4);
#pragma unroll
            for (int e = 0; e < 4; ++e) { const int i = 4 * i4 + e; cnt0 += (x[e] > val0 || (x[e] == val0 && i < j0)) ? 1 : 0; cnt1 += (x[e] > val1 || (x[e] == val1 && i < j1)) ? 1 : 0; } }
        const unsigned long long m0 = __ballot(j0 <= c && cnt0 < 16), m1 = __ballot(j1 <= c && cnt1 < 16);
        if (lane == 0) { LAS unsigned* mp = MSK + (wave * 8 + tk) * 4; mp[0] = (unsigned)m0; mp[1] = (unsigned)(m0 >> 32); mp[2] = (unsigned)m1; mp[3] = (unsigned)(m1 >> 32); }
    }
    LDS_WAIT();
    { int mr_ = mrow, hq_ = hq; asm volatile("" : "+v"(mr_), "+v"(hq_)); load_q(qf, QR + (size_t)mr_ * 2048 + (unsigned)(hq_ * 128), hi); }
    {
        Msk mk; mk.qlo = 0; mk.qhi = t; mk.sel = MSK + tl * 4;
        #ifdef PROBE_SEL2
        const Src src{KS + (size_t)b * SEQ * 512 + g * 128, 512, VT + (size_t)(g * 128) * LDV + (size_t)b * SEQ, LDV, 1};
#else
        const Src src{KS + (size_t)b * SEQ * 512 + g * 128, 512, VT + (size_t)(g * 128) * LDV + (size_t)b * SEQ, LDV, 0};
#endif
#ifndef REP_SEL
#define REP_SEL 1
#endif
        m = -1e30f; l = 0.f;
#pragma unroll
        for (int db = 0; db < 4; ++db)
#pragma unroll
            for (int r = 0; r < 16; ++r) o[db][r] = 0.f;
#ifdef PROBE_SEL2
        flash_pass(lds, tid, c32, hi, 0, 2 * c + 1, src, mk, qf, m, l, o);
#else
        flash_pass_async(lds, tid, lane, c32, hi, 0, c, src, mk, qf, m, l, o);
#endif
        NSA_PTRS();
        const float sc = gp[1] / l;
#pragma unroll
        for (int db = 0; db < 4; ++db)
#pragma unroll
            for (int q4 = 0; q4 < 4; ++q4) { const unsigned w0 = pk[2 * db + (q4 >> 1)][2 * (q4 & 1)], w1 = pk[2 * db + (q4 >> 1)][2 * (q4 & 1) + 1];
                pk[2 * db + (q4 >> 1)][2 * (q4 & 1)] = pk2(lo_bf(w0) + o[db][4 * q4] * sc, hi_bf(w0) + o[db][4 * q4 + 1] * sc);
                pk[2 * db + (q4 >> 1)][2 * (q4 & 1) + 1] = pk2(lo_bf(w1) + o[db][4 * q4 + 2] * sc, hi_bf(w1) + o[db][4 * q4 + 3] * sc); }
    }
    {
        Msk mk; mk.qlo = t - 511; mk.qhi = t; mk.sel = nullptr;
        const Src src{KW + (size_t)b * SEQ * 512 + g * 128, 512, VT + (size_t)(512 + g * 128) * LDV + (size_t)b * SEQ, LDV, 0};
        m = -1e30f; l = 0.f;
#pragma unroll
        for (int db = 0; db < 4; ++db)
#pragma unroll
            for (int r = 0; r < 16; ++r) o[db][r] = 0.f;
        flash_pass(lds, tid, c32, hi, c >= 8 ? c - 8 : 0, c, src, mk, qf, m, l, o);
        NSA_PTRS();
        const float sc = gp[2] / l;
        bf16* arow = ATT + (size_t)mr_ * 2048 + (unsigned)(hq_ * 128);
#pragma unroll
        for (int db = 0; db < 4; ++db)
#pragma unroll
            for (int qp = 0; qp < 2; ++qp) {
                unsigned f[2][2];
#pragma unroll
                for (int e = 0; e < 2; ++e) { const int q4 = 2 * qp + e; const unsigned w0 = pk[2 * db + qp][2 * e], w1 = pk[2 * db + qp][2 * e + 1];
                    f[e][0] = pk2(lo_bf(w0) + o[db][4 * q4] * sc, hi_bf(w0) + o[db][4 * q4 + 1] * sc); f[e][1] = pk2(lo_bf(w1) + o[db][4 * q4 + 2] * sc, hi_bf(w1) + o[db][4 * q4 + 3] * sc); }
                auto r0 = __builtin_amdgcn_permlane32_swap(f[0][0], f[1][0], false, false); auto r1 = __builtin_amdgcn_permlane32_swap(f[0][1], f[1][1], false, false);
                u32x4 w; w.x = r0[0]; w.y = r1[0]; w.z = r0[1]; w.w = r1[1];
                *(u32x4*)(arow + 32 * db + 16 * qp + 8 * hi) = w; }
    }
#undef NSA_PTRS
}

__device__ __forceinline__ void dil_item(LAS unsigned char* lds, int wave, int lane, int p, int sq, int h, int qb, const bf16* QK, const bf16* VT, bf16* OB, float* ML, bf16* ATT) {
    using namespace fa;
    const int tid = wave * 64 + lane, c32 = lane & 31, hi = lane >> 5, dsh = 2 * p, L = SEQ >> dsh;
    const int b = sq >> dsh, r = sq & ((1 << dsh) - 1), q = qb * 256 + wave * 32 + c32, mrow = b * SEQ + (q << dsh) + r;
    const size_t seqbase = (size_t)sq * L;
    bf16x8 qf[8]; f32x16 o[4]; float m = -1e30f, l = 0.f;
    load_q(qf, QK + (seqbase + q) * 4096 + h * 128, hi);
#pragma unroll
    for (int db = 0; db < 4; ++db)
#pragma unroll
        for (int rr = 0; rr < 16; ++rr) o[db][rr] = 0.f;
    Msk mk; mk.qlo = q - 128; mk.qhi = q; mk.sel = nullptr;
    const Src src{QK + seqbase * 4096 + 2048 + h * 128, 4096, VT + (size_t)(h * 128) * LDV + seqbase, LDV, 0};
    flash_pass(lds, tid, c32, hi, qb * 4 >= 2 ? qb * 4 - 2 : 0, qb * 4 + 3, src, mk, qf, m, l, o);
    int mr_ = mrow; asm volatile("" : "+v"(mr_));
    float sc2 = 1.0f / l, u0 = 0.f, u1 = 0.f;
    const bf16* ob0 = OB + (size_t)mr_ * 2048 + h * 128; const bf16* ob1 = ob0 + (size_t)M * 2048;
    if (p == 2) {
        const f32x2 ml0 = *(const f32x2*)(ML + ((size_t)mr_ * 16 + h) * 2), ml1 = *(const f32x2*)(ML + (size_t)M * 32 + ((size_t)mr_ * 16 + h) * 2);
        const float Mx = fmaxf(fmaxf(ml0[0], ml1[0]), m);
        u0 = ml0[1] * __builtin_amdgcn_exp2f((ml0[0] - Mx) * C2); u1 = ml1[1] * __builtin_amdgcn_exp2f((ml1[0] - Mx) * C2);
        const float e2 = __builtin_amdgcn_exp2f((m - Mx) * C2), iw = 1.0f / (u0 + u1 + l * e2);
        sc2 = e2 * iw; u0 *= iw; u1 *= iw;
    }
    bf16* orow = (p == 2 ? ATT : OB + (size_t)p * M * 2048) + (size_t)mr_ * 2048 + h * 128;
#pragma unroll
    for (int db = 0; db < 4; ++db)
#pragma unroll
        for (int qp = 0; qp < 2; ++qp) {
            f32x4 v[2];
#pragma unroll
            for (int e = 0; e < 2; ++e) { const int q4 = 2 * qp + e; v[e] = (f32x4){o[db][4 * q4] * sc2, o[db][4 * q4 + 1] * sc2, o[db][4 * q4 + 2] * sc2, o[db][4 * q4 + 3] * sc2}; }
            if (p == 2) {
                const u32x4 w0 = *(const u32x4*)(ob0 + 32 * db + 16 * qp + 8 * hi), w1 = *(const u32x4*)(ob1 + 32 * db + 16 * qp + 8 * hi);
                auto a0 = __builtin_amdgcn_permlane32_swap(w0.x, w0.z, false, false); auto a1 = __builtin_amdgcn_permlane32_swap(w0.y, w0.w, false, false);
                auto b0 = __builtin_amdgcn_permlane32_swap(w1.x, w1.z, false, false); auto b1 = __builtin_amdgcn_permlane32_swap(w1.y, w1.w, false, false);
#pragma unroll
                for (int e = 0; e < 2; ++e) {
                    v[e][0] += u0 * lo_bf(a0[e]) + u1 * lo_bf(b0[e]); v[e][1] += u0 * hi_bf(a0[e]) + u1 * hi_bf(b0[e]);
                    v[e][2] += u0 * lo_bf(a1[e]) + u1 * lo_bf(b1[e]); v[e][3] += u0 * hi_bf(a1[e]) + u1 * hi_bf(b1[e]); }
            }
            unsigned f[2][2];
#pragma unroll
            for (int e = 0; e < 2; ++e) { f[e][0] = pk2(v[e][0], v[e][1]); f[e][1] = pk2(v[e][2], v[e][3]); }
            auto r0 = __builtin_amdgcn_permlane32_swap(f[0][0], f[1][0], false, false); auto r1 = __builtin_amdgcn_permlane32_swap(f[0][1], f[1][1], false, false);
            u32x4 w; w.x = r0[0]; w.y = r1[0]; w.z = r0[1]; w.w = r1[1];
            *(u32x4*)(orow + 32 * db + 16 * qp + 8 * hi) = w; }
    if (p < 2 && hi == 0) *(f32x2*)(ML + (size_t)p * M * 32 + ((size_t)mr_ * 16 + h) * 2) = (f32x2){m, l};
}

__device__ __forceinline__ void modulate_row(const float* x32, const bf16* x16, const float* gain, const float* shift, const float* scale, bf16* orow, float* frow, int lane) {
    f32x4 v[8]; float ss = 0.f;
    if (x32) {
#pragma unroll
        for (int j = 0; j < 8; ++j) v[j] = *(const f32x4*)(x32 + 4 * lane + 256 * j);
    } else {
        u32x2 w[8];
#pragma unroll
        for (int j = 0; j < 8; ++j) w[j] = *(const u32x2*)(x16 + 4 * lane + 256 * j);
#pragma unroll
        for (int j = 0; j < 8; ++j) v[j] = (f32x4){lo_bf(w[j].x), hi_bf(w[j].x), lo_bf(w[j].y), hi_bf(w[j].y)};
    }
#pragma unroll
    for (int j = 0; j < 8; ++j) ss += (v[j][0] * v[j][0] + v[j][1] * v[j][1]) + (v[j][2] * v[j][2] + v[j][3] * v[j][3]);
    const float rinv = rsqrtf(wave_sum(ss) * (1.0f / D) + NORM_EPS);
#pragma unroll
    for (int j = 0; j < 8; ++j) {
        const int col = 4 * lane + 256 * j;
        const f32x4 gn = *(const f32x4*)(gain + col);
        f32x4 r = v[j] * rinv * gn;
        if (shift) { const f32x4 sh = *(const f32x4*)(shift + col), sc = *(const f32x4*)(scale + col); r = r * (1.0f + sc) + sh;
            u32x2 w; w.x = pk2(r[0], r[1]); w.y = pk2(r[2], r[3]); *(u32x2*)(orow + col) = w; }
        else *(f32x4*)(frow + col) = r;
    }
}

__device__ __forceinline__ unsigned char* wsp_(unsigned char* ws, size_t off) { asm volatile("" : "+s"(off)); return ws + off; }
#define FRESH_IDS() const int wave = fresh_s(wave_s), lane = lane_id_asm(), tid = wave * 64 + lane; (void)tid; \
    const int Gf_ = fresh_s(G), bx_ = fresh_s((int)blockIdx.x); const int gw = bx_ * NWAVES + wave, NGW = Gf_ * NWAVES, gtid = bx_ * NTHREADS + tid, NGT = Gf_ * NTHREADS; \
    LAS float* wl = (LAS float*)(lds + wave * 16384); (void)lane; (void)gw; (void)NGW; (void)gtid; (void)NGT; (void)wl
__global__ void __launch_bounds__(NTHREADS, 2) mega_fwd(Params P) {
    extern __shared__ __attribute__((aligned(16))) unsigned char lds_raw[];
    LAS unsigned char* lds = (LAS unsigned char*)lds_raw;
    volatile LAS unsigned* MISC = (volatile LAS unsigned*)(lds + MISC_OFF);
    const int G = gridDim.x;
    unsigned char* ws = P.ws;
    for (int u = threadIdx.x; u < (LDS_BYTES - RING_BYTES) / 4; u += NTHREADS) ((LAS unsigned*)(lds + RING_BYTES))[u] = 0u;
    __syncthreads();
    const int wave_s = __builtin_amdgcn_readfirstlane(threadIdx.x >> 6);
    XcdBarrier bar = xcd_barrier_post((unsigned*)(ws + WS_CTL) + 4096, MISC + 8); bar.wave = wave_s;
#define GRID_BAR() xcd_barrier(bar)
#define WSP(T, off) ((T*)wsp_(ws, (off)))

    {
        FRESH_IDS();
        float* MODP = WSP(float, WS_MODP); float* COS = WSP(float, WS_COS); float* SIN = WSP(float, WS_SIN); float* BPEP = WSP(float, WS_BPEP); float* LSP = WSP(float, WS_LSP);
        const float* cv = inp(P, IN_C);
        for (int task = gw; task < 4 * 48 * 8; task += NGW) {
            const int kc = task & 7, cg = (task >> 3) % 48, l = task / (8 * 48);
            const float* w = inp(P, layer_base(l)) + (size_t)cg * 256 + lane * 4;
            f32x4 a0 = {0.f, 0.f, 0.f, 0.f}, a1 = {0.f, 0.f, 0.f, 0.f};
#pragma unroll 8
            for (int k = kc * 256; k < kc * 256 + 256; ++k) {
                const float c0 = cv[k], c1 = cv[2048 + k];
                const float s0 = c0 / (1.0f + __expf(-c0)), s1 = c1 / (1.0f + __expf(-c1));
                const f32x4 wv = __builtin_nontemporal_load((const f32x4*)(w + (size_t)k * 12288));
                a0 += s0 * wv; a1 += s1 * wv;
            }
            *(f32x4*)(MODP + ((size_t)((kc * 4 + l) * 2 + 0)) * 12288 + cg * 256 + lane * 4) = a0;
            *(f32x4*)(MODP + ((size_t)((kc * 4 + l) * 2 + 1)) * 12288 + cg * 256 + lane * 4) = a1;
        }
        for (int i = gtid; i < SEQ * 64; i += NGT) {
            const int t = i >> 6, f = i & 63;
            const double invf = exp2(-(double)f * (13.287712379549449 / 64.0));
            const double ang = (double)t * invf;
            const double n = rint(ang * 0.15915494309189535);
            const double r = (ang - n * 6.283185307179586) - n * 2.4492935982947064e-16;
            COS[i] = (float)cos(r); SIN[i] = (float)sin(r);
        }
        for (int task = gw; task < 2 * 2 * 2 * 16; task += NGW) {
            const int kc = task & 15, cg = (task >> 4) & 1, kv = (task >> 5) & 1, slot = task >> 6;
            const int bi = slot == 0 ? 2 : 34;
            const float* pe = inp(P, bi + 4) + kv * 4096; const float* w = inp(P, bi + 5) + (size_t)kv * 4096 * 512 + cg * 256 + lane * 4;
            f32x4 a = {0.f, 0.f, 0.f, 0.f};
#pragma unroll 8
            for (int k = kc * 256; k < kc * 256 + 256; ++k) a += pe[k] * *(const f32x4*)(w + (size_t)k * 512);
            *(f32x4*)(BPEP + (size_t)((kc * 2 + slot) * 2 + kv) * 512 + cg * 256 + lane * 4) = a;
        }
        { const float* lamp = inp(P, 21 + 8);
          for (int i = gtid; i < DRNN; i += NGT) { const double lam = (double)lamp[i]; LSP[i] = (float)(-8.0 * log1p(exp(-lam))); } }
    }
    GRID_BAR();
    {
        FRESH_IDS();
#pragma unroll 1
        for (int jid = 0; jid < NJOBS; ++jid) {
            const Job J = get_job(P, jid);
            const int nitems = (J.K / 64) * (J.n_rows / 32);
            for (int it = gw; it < nitems; it += NGW) conv_item(J, it, wl, lane);
        }
        {
            const float* wg = inp(P, 21 + 6); bf16* WG = WSP(bf16, WS_W) + WE_RG_WG;
            for (long i = gtid; i < (long)5376 * (DRNN / 8); i += NGT) {
                const int row = (int)(i / (DRNN / 8)), k8 = (int)(i % (DRNN / 8)) * 8;
                const int gate = (row >> 7) & 1, ch = (row >> 8) * 128 + (row & 127), nb = ch / 168, dd = ch % 168;
                float v[8];
#pragma unroll
                for (int e = 0; e < 8; ++e) { const int k = k8 + e; v[e] = (k / 168 == nb) ? wg[((size_t)(gate * 16 + nb) * 168 + (k % 168)) * 168 + dd] : 0.f; }
                u32x4 o; o.x = pk2(v[0], v[1]); o.y = pk2(v[2], v[3]); o.z = pk2(v[4], v[5]); o.w = pk2(v[6], v[7]);
                *(u32x4*)(WG + (size_t)row * DRNN + k8) = o;
            }
        }
        {   const float* MODP = WSP(float, WS_MODP); float* MOD = WSP(float, WS_MOD);
#pragma unroll 1
            for (int l = 0; l < 4; ++l) { const float* bias = inp(P, layer_base(l) + 1);
                for (int i = gtid; i < 2 * 12288; i += NGT) {
                    const int col = i % 12288, lb = l * 2 + i / 12288;
                    float a = bias[col];
#pragma unroll
                    for (int kc = 0; kc < 8; ++kc) a += MODP[(size_t)(kc * 8 + lb) * 12288 + col];
                    MOD[(size_t)lb * 12288 + col] = a;
                } }
            const float* BPEP = WSP(float, WS_BPEP); float* BPE = WSP(float, WS_BPE);
            for (int i = gtid; i < 2 * 2 * 512; i += NGT) { float a = 0.f;
#pragma unroll
                for (int kc = 0; kc < 16; ++kc) a += BPEP[(size_t)kc * 2048 + i];
                BPE[i] = a; }
        }
    }
    GRID_BAR();

#pragma unroll 1
    for (int li = 0; li < 4; ++li) {
        const int kind = li % 3, bi = layer_base(li);
        {   FRESH_IDS();
            const float* x32 = li == 0 ? inp(P, IN_X) : (const float*)nullptr; const bf16* XR = WSP(bf16, WS_XR); const float* gain = inp(P, bi + 2);
            const float* modl = WSP(float, WS_MOD) + (size_t)li * 2 * 12288; bf16* HN = WSP(bf16, WS_HN);
            for (int r = gw; r < M; r += NGW) { const int b = r >> 13;
                modulate_row(x32 ? x32 + (size_t)r * D : (const float*)nullptr, XR + (size_t)r * D, gain, modl + (size_t)b * 12288, modl + (size_t)b * 12288 + 2048, HN + (size_t)r * D, nullptr, lane); } }
        GRID_BAR();
        if (kind == 0) {
            const int slot = li == 0 ? 0 : 1;
            {   bf16* wbase = WSP(bf16, WS_W) + (size_t)slot * WE_NSA_SZ;
                pg8::Gemm g{WSP(bf16, WS_HN), wbase + WE_NSA_WIN, M, NSA_N1, D}; pg8::StaticOrder S; S.init(M, NSA_N1, fresh_s(G), fresh_s((int)blockIdx.x));
                EpiNsaIn E{WSP(bf16, NS_Q), WSP(bf16, NS_QR), WSP(bf16, NS_PK), WSP(bf16, NS_PV), WSP(bf16, NS_KS), WSP(bf16, NS_KW), WSP(float, NS_GT), WSP(float, WS_COS), WSP(float, WS_SIN)};
                pg8::gemm_phase<EpiNsaIn, pg8::StaticOrder, true, true>(lds, g, S, E, wave_s); }
            {
                bf16* wbase = WSP(bf16, WS_W) + (size_t)slot * WE_NSA_SZ;
                pg8::Gemm g{wbase + WE_NSA_WIN + (size_t)4352 * D, WSP(bf16, WS_HN), 1024, M, D}; pg8::StaticOrder S; S.init(1024, M, fresh_s(G), fresh_s((int)blockIdx.x));
                EpiBf16<0> E{WSP(bf16, NS_VT), LDV, 0};
                pg8::gemm_phase<EpiBf16<0>, pg8::StaticOrder, true, true>(lds, g, S, E, wave_s); }
            GRID_BAR();
#pragma unroll 1
            for (int kv = 0; kv < 2; ++kv) {
                bf16* wbase = WSP(bf16, WS_W) + (size_t)slot * WE_NSA_SZ;
                pg8::Gemm g{kv ? WSP(bf16, NS_PV) : WSP(bf16, NS_PK), wbase + WE_NSA_W1 + (size_t)kv * 1024 * 2048, 4096, 1024, 2048}; pg8::StaticOrder S; S.init(4096, 1024, fresh_s(G), fresh_s((int)((blockIdx.x + 128 * kv) % G)));
                EpiF32 E{WSP(float, NS_HC) + (size_t)kv * 4096 * 1024, 1024};
                pg8::gemm_phase<EpiF32, pg8::StaticOrder, true, true>(lds, g, S, E, wave_s); }
            {
                bf16* wbase = WSP(bf16, WS_W) + (size_t)slot * WE_NSA_SZ;
                pg8::Gemm g{WSP(bf16, WS_HN), wbase + WE_NSA_WIN + (size_t)4096 * D, M, 256, D}; pg8::StaticOrder S; S.init(M, 256, fresh_s(G), fresh_s((int)((blockIdx.x + 192) % G)));
                EpiGates E{WSP(float, NS_GT)};
                pg8::gemm_phase<EpiGates, pg8::StaticOrder, true, true>(lds, g, S, E, wave_s); }
            GRID_BAR();
            {
                FRESH_IDS();
                const float* w2 = inp(P, bi + 6); const float* bpe = WSP(float, WS_BPE) + slot * 1024; const float* HCb = WSP(float, NS_HC); bf16* KCb = WSP(bf16, NS_KC); bf16* VCt = WSP(bf16, NS_VCT);
                for (int task = gw; task < 2 * 8 * 128; task += NGW) {
                    const int n0 = (task & 127) * 4, bg = (task >> 7) & 7, kv = task >> 10;
                    const float* hrow = HCb + ((size_t)kv * 4096 + bg * 512 + n0) * 1024;
#pragma unroll
                    for (int q = 0; q < 2; ++q) { const int c = lane * 8 + q * 4; const f32x4 pb = *(const f32x4*)(bpe + kv * 512 + c);
                        f32x4 hv[4];
#pragma unroll
                        for (int r = 0; r < 4; ++r) { const f32x4 a = *(const f32x4*)(hrow + (size_t)r * 1024 + c), bb = n0 + r < 511 ? *(const f32x4*)(hrow + (size_t)(r + 1) * 1024 + 512 + c) : (f32x4){0.f, 0.f, 0.f, 0.f};
#pragma unroll
                            for (int e = 0; e < 4; ++e) hv[r][e] = n0 + r < 511 ? gelu_tanh(a[e] + bb[e] + pb[e]) : 0.f; }
#pragma unroll
                        for (int e = 0; e < 4; ++e) *(LAS f32x4*)(wl + (c + e) * 4) = (f32x4){hv[0][e], hv[1][e], hv[2][e], hv[3][e]}; }
                    LDS_WAIT();
                    const float* wp = w2 + (size_t)kv * 512 * 128 + 2 * lane; f32x4 o0 = {0.f, 0.f, 0.f, 0.f}, o1 = {0.f, 0.f, 0.f, 0.f};
#pragma unroll 16
                    for (int c = 0; c < 512; ++c) { const f32x2 wv = *(const f32x2*)(wp + (size_t)c * 128); const f32x4 hv = *(const LAS f32x4*)(wl + c * 4); o0 += hv * wv[0]; o1 += hv * wv[1]; }
                    const int d0 = 2 * lane, d1 = 2 * lane + 1;
                    if (kv == 0) {
#pragma unroll
                        for (int r = 0; r < 4; ++r) { bf16* dst = KCb + ((size_t)bg * 512 + n0 + r) * 128; dst[(d0 & 63) * 2 + (d0 >> 6)] = (bf16)(pk2(o0[r], 0.f) & 0xffffu); dst[(d1 & 63) * 2 + (d1 >> 6)] = (bf16)(pk2(o1[r], 0.f) & 0xffffu); } }
                    else { bf16* dst = VCt + (size_t)bg * 128 * 512 + n0;
                        u32x2 w0; w0.x = pk2(o0[0], o0[1]); w0.y = pk2(o0[2], o0[3]); *(u32x2*)(dst + (size_t)d0 * 512) = w0;
                        u32x2 w1; w1.x = pk2(o1[0], o1[1]); w1.y = pk2(o1[2], o1[3]); *(u32x2*)(dst + (size_t)d1 * 512) = w1; }
                    LDS_WAIT();
                }
            }
            GRID_BAR();
#ifndef REP_NSA
#define REP_NSA 1
#endif
#pragma unroll 1
            for (int rep = 0; rep < fresh_s(REP_NSA); ++rep)
            {   FRESH_IDS();
#pragma unroll 1
                for (int pi = bx_; pi < 512; pi += Gf_) {
                    const int bg = Gf_ == 256 ? (pi & 7) : (pi >> 6), cc = Gf_ == 256 ? ((pi & 255) >> 3) + 32 * (pi >> 8) : (pi & 63);
#pragma unroll 1
                    for (int e = 0; e < 2; ++e)
                        nsa_item(lds, wave, lane, bg >> 2, bg & 3, e ? cc : 127 - cc, WSP(bf16, NS_Q), WSP(bf16, NS_QR), WSP(bf16, NS_KC), WSP(bf16, NS_VCT), WSP(bf16, NS_KS), WSP(bf16, NS_KW),
                                 WSP(bf16, NS_VT), WSP(float, NS_GT), P.out, WSP(bf16, WS_ATT));
                }
                __syncthreads();
            }
            GRID_BAR();
        } else if (kind == 1) {
#pragma unroll 1
            for (int st = 0; st < 4; ++st) {
                if (st >= 1) {
                    const int p = st - 1;
                    FRESH_IDS();
                    const int dsh = 2 * p, nqb = (SEQ >> dsh) >> 8;
#pragma unroll 1
                    for (int it = bx_; it < 1024; it += Gf_) {
                        const int qb = it % nqb, h = (it / nqb) & 15, sq = it / (nqb * 16);
                        dil_item(lds, wave, lane, p, sq, h, qb, WSP(bf16, DL_QK) + (size_t)p * M * 4096, (const bf16*)(WSP(unsigned char, DL_VT) + (size_t)p * DL_VT_STRIDE), (bf16*)P.out, WSP(float, DL_ML), WSP(bf16, WS_ATT));
                    }
                    __syncthreads();
                }
                if (st < 3) {
                    const int p = st;
                    {   pg8::Gemm g{WSP(bf16, WS_HN), WSP(bf16, WS_W) + WE_DIL + (size_t)p * 6144 * D, M, 4096, D, 2 * p, 0}; pg8::StaticOrder S; S.init(M, 4096, fresh_s(G), fresh_s((int)blockIdx.x));
                        EpiDilQK E{WSP(bf16, DL_QK) + (size_t)p * M * 4096, WSP(float, WS_COS), WSP(float, WS_SIN), 2 * p};
                        pg8::gemm_phase<EpiDilQK, pg8::StaticOrder, true, true>(lds, g, S, E, wave_s); }
                    {   pg8::Gemm g{WSP(bf16, WS_W) + WE_DIL + ((size_t)p * 6144 + 4096) * D, WSP(bf16, WS_HN), 2048, M, D, 0, 2 * p}; pg8::StaticOrder S; S.init(2048, M, fresh_s(G), fresh_s((int)blockIdx.x));
                        EpiBf16<0> E{(bf16*)(WSP(unsigned char, DL_VT) + (size_t)p * DL_VT_STRIDE), LDV, 0};
                        pg8::gemm_phase<EpiBf16<0>, pg8::StaticOrder, true, true>(lds, g, S, E, wave_s); }
                }
                GRID_BAR();
            }
        } else {
            {   pg8::Gemm g{WSP(bf16, WS_HN), WSP(bf16, WS_W) + WE_RG, M, RG_N, D}; pg8::StaticOrder S; S.init(M, RG_N, fresh_s(G), fresh_s((int)blockIdx.x));
                EpiBf16<2> E{WSP(bf16, RG_YX), RG_N, 11};
                pg8::gemm_phase<EpiBf16<2>, pg8::StaticOrder, true, true>(lds, g, S, E, wave_s); }
            GRID_BAR();
            {
                FRESH_IDS();
                const float* cw = inp(P, bi + 4); const float* cb = inp(P, bi + 5); const bf16* YX = WSP(bf16, RG_YX); bf16* Xc = WSP(bf16, RG_X);
                for (long i = gtid; i < (long)(M / 4) * (DRNN / 8); i += NGT) {
                    const int r4 = (int)(i / (DRNN / 8)) * 4, c8 = (int)(i % (DRNN / 8)) * 8, t0 = r4 & (SEQ - 1);
                    u32x4 xr[7];
#pragma unroll
                    for (int j = 0; j < 7; ++j) xr[j] = (t0 - 3 + j >= 0) ? *(const u32x4*)(YX + (size_t)(r4 - 3 + j) * RG_N + RG_XOFF + c8) : (u32x4){0u, 0u, 0u, 0u};
                    f32x4 w0[4], w1[4];
#pragma unroll
                    for (int j = 0; j < 4; ++j) { w0[j] = *(const f32x4*)(cw + j * DRNN + c8); w1[j] = *(const f32x4*)(cw + j * DRNN + c8 + 4); }
                    const f32x4 b0 = *(const f32x4*)(cb + c8), b1 = *(const f32x4*)(cb + c8 + 4);
#pragma unroll
                    for (int rr = 0; rr < 4; ++rr) {
                        f32x4 a0 = b0, a1 = b1;
#pragma unroll
                        for (int j = 0; j < 4; ++j) { const u32x4 xw = xr[rr + j];
                            a0 += w0[j] * (f32x4){lo_bf(xw.x), hi_bf(xw.x), lo_bf(xw.y), hi_bf(xw.y)}; a1 += w1[j] * (f32x4){lo_bf(xw.z), hi_bf(xw.z), lo_bf(xw.w), hi_bf(xw.w)}; }
                        u32x4 o; o.x = pk2(a0[0], a0[1]); o.y = pk2(a0[2], a0[3]); o.z = pk2(a1[0], a1[1]); o.w = pk2(a1[2], a1[3]);
                        *(u32x4*)(Xc + (size_t)(r4 + rr) * DRNN + c8) = o;
                    }
                }
            }
            GRID_BAR();
            {   pg8::Gemm g{WSP(bf16, RG_X), WSP(bf16, WS_W) + WE_RG_WG, M, 5376, DRNN}; pg8::GateOrder S; S.init(M, 5376, fresh_s(G), fresh_s((int)blockIdx.x));
                EpiRgGate E{WSP(bf16, RG_X), inp(P, bi + 7), WSP(float, WS_LSP), WSP(unsigned, RG_A)};
                pg8::gemm_phase<EpiRgGate, pg8::GateOrder, true, true>(lds, g, S, E, wave_s); }
            GRID_BAR();
            {
                FRESH_IDS();
                const unsigned* AB = WSP(unsigned, RG_A); float* CA = WSP(float, RG_CA); float* CB = WSP(float, RG_CB);
                for (int task = gw; task < 2 * 128 * 21; task += NGW) {
                    const int cg = task % 21, k = (task / 21) & 127, b = task / (21 * 128), ch = cg * 128 + 2 * lane;
                    const size_t o = (size_t)(b * SEQ + k * 64) * DRNN + ch; f32x2 pa = {1.f, 1.f}, hb = {0.f, 0.f};
#pragma unroll 16
                    for (int s = 0; s < 64; ++s) { const u32x2 w = *(const u32x2*)(AB + o + (size_t)s * DRNN);
                        const f32x2 a = {__builtin_amdgcn_exp2f(lo_bf(w.x)), __builtin_amdgcn_exp2f(lo_bf(w.y))}, bv = {hi_bf(w.x), hi_bf(w.y)}; hb = a * hb + bv; pa = pa * a; }
                    *(f32x2*)(CA + (size_t)(b * 128 + k) * DRNN + ch) = pa; *(f32x2*)(CB + (size_t)(b * 128 + k) * DRNN + ch) = hb;
                } }
            GRID_BAR();
            {   FRESH_IDS();
                const unsigned* AB = WSP(unsigned, RG_A); const float* CA = WSP(float, RG_CA); const float* CB = WSP(float, RG_CB);
                const bf16* YX = WSP(bf16, RG_YX); bf16* ATT = WSP(bf16, WS_ATT);
                for (int task = gw; task < 2 * 128 * 21; task += NGW) {
                    const int cg = task % 21, k = (task / 21) & 127, b = task / (21 * 128), ch = cg * 128 + 2 * lane;
                    f32x2 h = {0.f, 0.f};
                    { const size_t co = (size_t)(b * 128) * DRNN + ch;
#pragma unroll 8
                      for (int kk = 0; kk < k; ++kk) { const f32x2 ca = *(const f32x2*)(CA + co + (size_t)kk * DRNN), cb = *(const f32x2*)(CB + co + (size_t)kk * DRNN); h = ca * h + cb; } }
                    const size_t o = (size_t)(b * SEQ + k * 64) * DRNN + ch; const size_t yo = (size_t)(b * SEQ + k * 64) * RG_N + ch;
#pragma unroll 16
                    for (int s = 0; s < 64; ++s) { const u32x2 w = *(const u32x2*)(AB + o + (size_t)s * DRNN);
                        const f32x2 a = {__builtin_amdgcn_exp2f(lo_bf(w.x)), __builtin_amdgcn_exp2f(lo_bf(w.y))}, bv = {hi_bf(w.x), hi_bf(w.y)};
                        const unsigned yw = *(const unsigned*)(YX + yo + (size_t)s * RG_N);
                        h = a * h + bv;
                        *(unsigned*)(ATT + o + (size_t)s * DRNN) = pk2(h[0] * lo_bf(yw), h[1] * hi_bf(yw)); }
                } }
            GRID_BAR();
        }
        {   const int Kd = kind == 2 ? DRNN : D;
            const bf16* wt = kind == 0 ? WSP(bf16, WS_W) + (size_t)(li == 0 ? 0 : 1) * WE_NSA_SZ + WE_NSA_WOUT : kind == 1 ? WSP(bf16, WS_W) + WE_DIL_WOUT : WSP(bf16, WS_W) + WE_RG_WOUT;
            const float* x32 = li == 0 ? inp(P, IN_X) : (const float*)nullptr;
            pg8::Gemm g{WSP(bf16, WS_ATT), wt, M, D, Kd}; pg8::StaticOrder S; S.init(M, D, fresh_s(G), fresh_s((int)blockIdx.x));
            EpiRes E{x32, WSP(bf16, WS_XR), WSP(bf16, WS_XR), WSP(float, WS_MOD) + (size_t)li * 2 * 12288 + 2 * 2048};
            pg8::gemm_phase<EpiRes, pg8::StaticOrder, true, true>(lds, g, S, E, wave_s); }
        GRID_BAR();
        {   FRESH_IDS();
            const float* gain = inp(P, bi + ff_off(li)); const float* modl = WSP(float, WS_MOD) + (size_t)li * 2 * 12288; bf16* HN = WSP(bf16, WS_HN); const bf16* XR = WSP(bf16, WS_XR);
            for (int r = gw; r < M; r += NGW) { const int b = r >> 13;
                modulate_row(nullptr, XR + (size_t)r * D, gain, modl + (size_t)b * 12288 + 3 * 2048, modl + (size_t)b * 12288 + 4 * 2048, HN + (size_t)r * D, nullptr, lane); } }
        GRID_BAR();
#pragma unroll 1
        for (int hfm = 0; hfm < 2; ++hfm) {
            {   pg8::Gemm g{WSP(bf16, WS_HN) + (size_t)hfm * 8192 * D, WSP(bf16, WS_W) + WE_FF + (size_t)li * 33554432, M / 2, DFF, D}; pg8::StaticOrder S; S.init(M / 2, DFF, fresh_s(G), fresh_s((int)blockIdx.x));
                EpiBf16<1> E{WSP(bf16, WS_BIG), DFF, 0};
                pg8::gemm_phase<EpiBf16<1>, pg8::StaticOrder, true, true>(lds, g, S, E, wave_s); }
            GRID_BAR();
            {   pg8::Gemm g{WSP(bf16, WS_BIG), WSP(bf16, WS_W) + WE_FF + (size_t)li * 33554432 + 16777216, M / 2, D, DFF}; pg8::StaticOrder S; S.init(M / 2, D, fresh_s(G), fresh_s((int)blockIdx.x));
                EpiRes E{nullptr, WSP(bf16, WS_XR) + (size_t)hfm * 8192 * D, WSP(bf16, WS_XR) + (size_t)hfm * 8192 * D, WSP(float, WS_MOD) + (size_t)li * 2 * 12288 + 5 * 2048 + (size_t)hfm * 12288};
                pg8::gemm_phase<EpiRes, pg8::StaticOrder, true, true>(lds, g, S, E, wave_s); }
            GRID_BAR();
        }
    }
    {   FRESH_IDS();
        const float* gain = inp(P, IN_NORMF); const bf16* XR = WSP(bf16, WS_XR); float* OUT = P.out;
        for (int r = gw; r < M; r += NGW) modulate_row(nullptr, XR + (size_t)r * D, gain, nullptr, nullptr, nullptr, OUT + (size_t)r * D, lane); }
}

extern "C" void kernel_launch(void* const* d_in, const int* in_sizes, int n_in, void* d_out, int out_size, void* d_ws, size_t ws_size, hipStream_t stream) {
    static int grid = 0;
    if (grid == 0) {
        if (n_in != 46 || out_size != M * D || ws_size < WS_END) { fprintf(stderr, "kernel_launch: unexpected shapes (n_in %d out %d ws %zu need %zu)\n", n_in, out_size, ws_size, (size_t)WS_END); grid = -1; return; }
        int dev = 0, cus = 0, per_cu = 0;
        if (hipGetDevice(&dev) != hipSuccess || hipDeviceGetAttribute(&cus, hipDeviceAttributeMultiprocessorCount, dev) != hipSuccess) { grid = -1; return; }
        if (hipFuncSetAttribute((const void*)mega_fwd, hipFuncAttributeMaxDynamicSharedMemorySize, LDS_BYTES) != hipSuccess) { fprintf(stderr, "kernel_launch: hipFuncSetAttribute failed\n"); grid = -1; return; }
        if (hipOccupancyMaxActiveBlocksPerMultiprocessor(&per_cu, (const void*)mega_fwd, NTHREADS, LDS_BYTES) != hipSuccess || per_cu < 1) { fprintf(stderr, "kernel_launch: occupancy query says %d\n", per_cu); }
        (void)hipGetLastError();
        grid = cus;
    }
    if (grid < 0) return;
    if (hipMemsetAsync((char*)d_ws + WS_CTL, 0, CTL_ZERO_BYTES, stream) != hipSuccess) return;
    Params p{};
    for (int i = 0; i < 46; ++i) p.in[i] = (const float*)d_in[i];
    p.out = (float*)d_out; p.ws = (unsigned char*)d_ws;
    hipLaunchKernelGGL(mega_fwd, dim3(grid), dim3(NTHREADS), LDS_BYTES, stream, p);
}
```

```cpp
#include <hip/hip_runtime.h>
#include <cstdio>
#include <cstdint>

#define GAS __attribute__((address_space(1)))
#define LAS __attribute__((address_space(3)))
typedef unsigned short bf16;
typedef float f32x4 __attribute__((ext_vector_type(4)));
typedef float f32x2 __attribute__((ext_vector_type(2)));
typedef unsigned u32x4 __attribute__((ext_vector_type(4)));
typedef unsigned u32x2 __attribute__((ext_vector_type(2)));
#define LDS_WAIT() asm volatile("s_waitcnt lgkmcnt(0)" ::: "memory")
__device__ __forceinline__ int fresh_s(int v) { asm volatile("" : "+s"(v)); return v; }
__device__ __forceinline__ int lane_id_asm() { int l; asm volatile("v_mbcnt_lo_u32_b32 %0, -1, 0\n\tv_mbcnt_hi_u32_b32 %0, -1, %0" : "=v"(l)); return l; }

namespace pg8 {
#define PG8_LAS __attribute__((address_space(3)))
typedef unsigned short bf16_t;
typedef short bf16x8 __attribute__((ext_vector_type(8)));
constexpr int BM = 256, BK = 64, HALF = 128, HTB = HALF * BK * 2, STAGE_BYTES = 8 * HTB, NXCD = 8, WGM = 8;
__host__ __device__ __forceinline__ int lds_byte(int r, int c) { const int st = (r >> 4) * 2 + (c >> 5), rr = r & 15, cc = c & 31, ob = rr * 64 + cc * 2; return st * 1024 + (ob ^ (((ob >> 9) & 1) << 5)); }
__host__ __device__ __forceinline__ void stage_rc(int b, int& R, int& C) { const int st = b / 1024, sb = b % 1024, swz = sb ^ (((sb >> 9) & 1) << 5); R = (st >> 1) * 16 + swz / 64; C = (st & 1) * 32 + (swz % 64) / 2; }
__host__ __device__ __forceinline__ int perm32(int rho) { const int n = rho >> 4, i = rho & 15; return 8 * (i >> 2) + 4 * n + (i & 3); }
struct Unit { int pm, pn; };
struct Gemm { const bf16_t* A; const bf16_t* Bt; int M, N, K; int dshA, dshB; };
__device__ __forceinline__ long rowbase(int p, int dsh) { const int i0 = p * 256; if (dsh == 0) return i0; const int b = i0 >> 13, rem = i0 & 8191, sh = 13 - dsh; return (long)(b << 13) + ((rem & ((1 << sh) - 1)) << dsh) + (rem >> sh); }
struct StaticOrder {
    int nM, nN, nwg, G, c;
    __host__ __device__ void init(int M, int N, int G_, int c_) { nM = M / BM; nN = N / BM; nwg = nM * nN; G = G_; c = c_; }
    __host__ __device__ bool next(int i, Unit& u) const {
        const long L = (long)i * G + c; if (L >= nwg) return false;
        int wgid = (int)L; { const int q = nwg / NXCD, r = nwg % NXCD, xcd = wgid % NXCD, off = wgid / NXCD; wgid = (xcd < r ? xcd * (q + 1) : r * (q + 1) + (xcd - r) * q) + off; }
        const int nig = WGM * nN, gid = wgid / nig, fm = gid * WGM, gsz = (nM - fm) < WGM ? (nM - fm) : WGM;
        u.pm = fm + ((wgid % nig) % gsz); u.pn = (wgid % nig) / gsz; return true;
    }
    __device__ __forceinline__ void a_ready(const Unit&) const {}
    __device__ __forceinline__ void done(const Unit&) const {}
    __device__ __forceinline__ void krange(const Unit&, int K, int& kbeg, int& nt) const { kbeg = 0; nt = K / BK; }
};
struct GateOrder : StaticOrder {
    __device__ __forceinline__ void krange(const Unit& u, int K, int& kbeg, int& nt) const {
        const int c0 = u.pn * 128, nb0 = c0 / 168, nb1 = (c0 + 127) / 168;
        kbeg = (nb0 * 168) & ~127; int kend = ((nb1 + 1) * 168 + 127) & ~127; if (kend > K) kend = K;
        nt = (kend - kbeg) / BK; }
};
__device__ __forceinline__ unsigned cvt_pk_bf16(float lo, float hi) { unsigned r; asm volatile("v_cvt_pk_bf16_f32 %0, %1, %2" : "=v"(r) : "v"(lo), "v"(hi)); return r; }

template <class Epi, class Sched, bool ALIGN_EPI = false, bool SP2 = false>
__device__ __forceinline__ void gemm_phase(PG8_LAS unsigned char* lds, const Gemm g, const Sched& S, const Epi& E, int wid_in) {
    int wid = wid_in; asm volatile("" : "+s"(wid));
    const int lane = lane_id_asm(), tid = wid * 64 + lane, wr = wid >> 2, wc = wid & 3, fr = lane & 15, fq = lane >> 4;
    const int K = g.K;
    unsigned voffA[2], voffB[2];
#pragma unroll
    for (int i = 0; i < 2; ++i) { int R, C; stage_rc(tid * 16 + i * 8192, R, C); const int Rb = Epi::PERM ? ((R & ~31) + perm32(R & 31)) : R;
        voffA[i] = (unsigned)((R << g.dshA) * K + C) * 2u; voffB[i] = (unsigned)((Rb << g.dshB) * K + C) * 2u; }
    const size_t kstep = (size_t)(BK * 2);
    const size_t hstepA = (size_t)(HALF << g.dshA) * K * 2, hstepB = (size_t)(HALF << g.dshB) * K * 2;
#define PG8_BASEA(u) ((const char*)g.A + (size_t)rowbase((u).pm, g.dshA) * K * 2)
#define PG8_BASEB(u) ((const char*)g.Bt + (size_t)rowbase((u).pn, g.dshB) * K * 2)
    const unsigned ldsw = (unsigned)wid * 1024u;
    const int aoff = lds_byte(wr * 64 + fr, fq * 8), boff = lds_byte(wc * 32 + fr, fq * 8);
#define PG8_SA(b, h) (((b) * 2 + (h)) * HTB)
#define PG8_SB(b, h) ((4 + (b) * 2 + (h)) * HTB)
#define PG8_STAGE(bufoff, gbase, voff) do { _Pragma("unroll") for (int _i = 0; _i < 2; ++_i) \
        __builtin_amdgcn_global_load_lds((const unsigned*)((const char*)(gbase) + (voff)[_i]), (PG8_LAS unsigned*)(lds + (bufoff) + ldsw + _i * 8192), 16, 0, 0); } while (0)
#define PG8_LDA(dst, b, h) do { _Pragma("unroll") for (int m = 0; m < 4; ++m) _Pragma("unroll") for (int k = 0; k < 2; ++k) dst[m][k] = *(const PG8_LAS bf16x8*)(lds + PG8_SA(b, h) + aoff + m * 2048 + k * 1024); } while (0)
#define PG8_LDB(dst, b, h) do { _Pragma("unroll") for (int n = 0; n < 2; ++n) _Pragma("unroll") for (int k = 0; k < 2; ++k) dst[n][k] = *(const PG8_LAS bf16x8*)(lds + PG8_SB(b, h) + boff + n * 2048 + k * 1024); } while (0)
#define PG8_MMA(ai, bj, At, Bt) do { __builtin_amdgcn_s_setprio(1); _Pragma("unroll") for (int m = 0; m < 4; ++m) _Pragma("unroll") for (int n = 0; n < 2; ++n) _Pragma("unroll") for (int k = 0; k < 2; ++k) \
        acc[ai][bj][m][n] = __builtin_amdgcn_mfma_f32_16x16x32_bf16(Bt[n][k], At[m][k], acc[ai][bj][m][n], 0, 0, 0); __builtin_amdgcn_s_setprio(0); } while (0)
#define PG8_WAIT_V(n) asm volatile("s_waitcnt vmcnt(" #n ")" ::: "memory")
#define PG8_WAIT_L(n) asm volatile("s_waitcnt lgkmcnt(" #n ")" ::: "memory")
#define PG8_BAR __builtin_amdgcn_s_barrier()
#define PG8_SCHED __builtin_amdgcn_sched_barrier(0)
    Unit cur, nxt; int ui = 0;
    if (!S.next(0, cur)) return;
    f32x4 acc[2][2][4][2];
#pragma unroll
    for (int a = 0; a < 2; ++a)
#pragma unroll
        for (int b = 0; b < 2; ++b)
#pragma unroll
            for (int m = 0; m < 4; ++m)
#pragma unroll
                for (int n = 0; n < 2; ++n) acc[a][b][m][n] = (f32x4){0.f, 0.f, 0.f, 0.f};
    bf16x8 At[4][2], B0[2][2], B1[2][2];
    int kb_cur, nt; S.krange(cur, K, kb_cur, nt);
    const char* cA = PG8_BASEA(cur) + (size_t)kb_cur * 2; const char* cB = PG8_BASEB(cur) + (size_t)kb_cur * 2;
    S.a_ready(cur);
    if constexpr (SP2) {
        PG8_STAGE(PG8_SB(0, 0), cB, voffB); PG8_STAGE(PG8_SB(0, 1), cB + hstepB, voffB); PG8_STAGE(PG8_SA(0, 0), cA, voffA); PG8_STAGE(PG8_SA(0, 1), cA + hstepA, voffA);
        if (wr == 1) PG8_BAR;
        PG8_WAIT_V(2); PG8_BAR;
        PG8_STAGE(PG8_SB(1, 0), cB + kstep, voffB); PG8_STAGE(PG8_SA(1, 0), cA + kstep, voffA); PG8_STAGE(PG8_SB(1, 1), cB + hstepB + kstep, voffB);
        PG8_WAIT_V(6); PG8_BAR;
    } else {
        PG8_STAGE(PG8_SB(0, 0), cB, voffB); PG8_STAGE(PG8_SA(0, 0), cA, voffA); PG8_STAGE(PG8_SB(0, 1), cB + hstepB, voffB); PG8_STAGE(PG8_SA(0, 1), cA + hstepA, voffA);
        if (wr == 1) PG8_BAR;
        PG8_WAIT_V(4); PG8_BAR;
        PG8_STAGE(PG8_SB(1, 0), cB + kstep, voffB); PG8_STAGE(PG8_SA(1, 0), cA + kstep, voffA); PG8_STAGE(PG8_SB(1, 1), cB + hstepB + kstep, voffB);
        PG8_WAIT_V(6); PG8_BAR;
    }
    for (;;) {
        const bool has_next = S.next(ui + 1, nxt);
        int kb_nxt = 0, nt_nxt = nt; if (has_next) S.krange(nxt, K, kb_nxt, nt_nxt);
        const char* nA = has_next ? PG8_BASEA(nxt) + (size_t)kb_nxt * 2 : cA; const char* nB = has_next ? PG8_BASEB(nxt) + (size_t)kb_nxt * 2 : cB;
        for (int t = 0; t < nt; t += 2) {
            const bool last = (t == nt - 2);
            const char* a1 = cA + (size_t)(t + 1) * kstep;
            const char* a2 = last ? nA : cA + (size_t)(t + 2) * kstep; const char* b2 = last ? nB : cB + (size_t)(t + 2) * kstep;
            const char* a3 = a2 + kstep; const char* b3 = b2 + kstep;
            if (last && has_next) S.a_ready(nxt);
            if constexpr (SP2) {
            PG8_LDB(B0, 0, 0); PG8_LDB(B1, 0, 1); PG8_SCHED; PG8_LDA(At, 0, 0); PG8_STAGE(PG8_SA(1, 1), a1 + hstepA, voffA);
            PG8_WAIT_V(8); PG8_WAIT_L(0); PG8_BAR; PG8_MMA(0, 0, At, B0); PG8_MMA(0, 1, At, B1); PG8_BAR; PG8_SCHED;
            PG8_LDA(At, 0, 1); PG8_STAGE(PG8_SB(0, 0), b2, voffB); PG8_STAGE(PG8_SB(0, 1), b2 + hstepB, voffB); PG8_STAGE(PG8_SA(0, 0), a2, voffA);
            PG8_WAIT_V(8); PG8_WAIT_L(0); PG8_BAR; PG8_MMA(1, 0, At, B0); PG8_MMA(1, 1, At, B1); PG8_BAR; PG8_SCHED;
            PG8_LDB(B0, 1, 0); PG8_LDB(B1, 1, 1); PG8_SCHED; PG8_LDA(At, 1, 0); PG8_STAGE(PG8_SA(0, 1), a2 + hstepA, voffA);
            PG8_WAIT_V(8); PG8_WAIT_L(0); PG8_BAR; PG8_MMA(0, 0, At, B0); PG8_MMA(0, 1, At, B1); PG8_BAR; PG8_SCHED;
            PG8_LDA(At, 1, 1); PG8_STAGE(PG8_SB(1, 0), b3, voffB); PG8_STAGE(PG8_SB(1, 1), b3 + hstepB, voffB); PG8_STAGE(PG8_SA(1, 0), a3, voffA);
            PG8_WAIT_V(8); PG8_WAIT_L(0); PG8_BAR; PG8_MMA(1, 0, At, B0); PG8_MMA(1, 1, At, B1); PG8_BAR; PG8_SCHED;
            } else {
            PG8_LDB(B0, 0, 0); PG8_SCHED; PG8_LDA(At, 0, 0); PG8_STAGE(PG8_SA(1, 1), a1 + hstepA, voffA);
            PG8_WAIT_L(8); PG8_BAR; PG8_WAIT_L(0); PG8_MMA(0, 0, At, B0); PG8_BAR; PG8_SCHED;
            PG8_LDB(B1, 0, 1); PG8_STAGE(PG8_SB(0, 0), b2, voffB);
            PG8_BAR; PG8_WAIT_L(0); PG8_MMA(0, 1, At, B1); PG8_BAR;
            PG8_LDA(At, 0, 1); PG8_STAGE(PG8_SA(0, 0), a2, voffA);
            PG8_BAR; PG8_WAIT_L(0); PG8_MMA(1, 0, At, B0); PG8_BAR; PG8_SCHED;
            PG8_STAGE(PG8_SB(0, 1), b2 + hstepB, voffB);
            PG8_WAIT_V(6); PG8_BAR; PG8_MMA(1, 1, At, B1); PG8_BAR;
            PG8_LDB(B0, 1, 0); PG8_SCHED; PG8_LDA(At, 1, 0); PG8_STAGE(PG8_SA(0, 1), a2 + hstepA, voffA);
            PG8_WAIT_L(8); PG8_BAR; PG8_WAIT_L(0); PG8_MMA(0, 0, At, B0); PG8_BAR; PG8_SCHED;
            PG8_LDB(B1, 1, 1); PG8_STAGE(PG8_SB(1, 0), b3, voffB);
            PG8_BAR; PG8_WAIT_L(0); PG8_MMA(0, 1, At, B1); PG8_BAR;
            PG8_LDA(At, 1, 1); PG8_STAGE(PG8_SA(1, 0), a3, voffA);
            PG8_BAR; PG8_WAIT_L(0); PG8_MMA(1, 0, At, B0); PG8_BAR; PG8_SCHED;
            PG8_STAGE(PG8_SB(1, 1), b3 + hstepB, voffB);
            PG8_WAIT_V(6); PG8_BAR; PG8_MMA(1, 1, At, B1); PG8_BAR;
            }
        }
        if constexpr (ALIGN_EPI) { if (wr == 0) PG8_BAR; }
        E(acc, cur, wr, wc, fr, fq); S.done(cur);
        if (!has_next) break;
#pragma unroll
        for (int a = 0; a < 2; ++a)
#pragma unroll
            for (int b = 0; b < 2; ++b)
#pragma unroll
                for (int m = 0; m < 4; ++m)
#pragma unroll
                    for (int n = 0; n < 2; ++n) acc[a][b][m][n] = (f32x4){0.f, 0.f, 0.f, 0.f};
        cur = nxt; cA = nA; cB = nB; nt = nt_nxt; ++ui;
        if constexpr (ALIGN_EPI) { if (wr == 1) PG8_BAR; }
    }
    PG8_WAIT_V(0);
    if constexpr (!ALIGN_EPI) { if (wr == 0) PG8_BAR; }
    PG8_BAR;
#undef PG8_BASEA
#undef PG8_BASEB
#undef PG8_SA
#undef PG8_SB
#undef PG8_STAGE
#undef PG8_LDA
#undef PG8_LDB
#undef PG8_MMA
#undef PG8_WAIT_V
#undef PG8_WAIT_L
#undef PG8_BAR
#undef PG8_SCHED
}
}

#define XB_TMO      128
#define XB_XCNT(j)  (256  + 64 * (j))
#define XB_XSUB(j)  (1280 + 64 * (j))
#define XB_XGEN(j)  (2304 + 64 * (j))
#define XB_TOP      3328
#define XB_TOPGEN   3392
#define XCD_BAR_WORDS 3456
#define XB_SPIN_CAP (1u << 22)
__device__ __forceinline__ unsigned xb_ld(unsigned* p)              { return __hip_atomic_load(p, __ATOMIC_RELAXED, __HIP_MEMORY_SCOPE_AGENT); }
__device__ __forceinline__ unsigned xb_add(unsigned* p, unsigned v) { return __hip_atomic_fetch_add(p, v, __ATOMIC_RELAXED, __HIP_MEMORY_SCOPE_AGENT); }
__device__ __forceinline__ unsigned xb_xcc_id() { return (unsigned)__builtin_amdgcn_s_getreg((3 << 11) | 20) & 0xFu; }
#define XB_SPIN(cond, bar) do { unsigned _sp = 0; while (cond) { __builtin_amdgcn_s_sleep(1); \
    if ((++_sp & 255u) == 0u) { if (xb_ld(&(bar)[XB_TMO])) break; if (_sp > XB_SPIN_CAP) { atomicAdd(&(bar)[XB_TMO], 1u); break; } } } } while (0)
struct XcdBarrier { unsigned* bar; unsigned x; volatile LAS unsigned* st; int wave; };
__device__ __forceinline__ XcdBarrier xcd_barrier_post(unsigned* bar, volatile LAS unsigned* st) {
    XcdBarrier b; b.bar = bar; b.x = xb_xcc_id(); b.st = st;
    if (threadIdx.x == 0) (void)xb_add(&bar[XB_XCNT(b.x)], 1u);
    return b;
}
__device__ __forceinline__ void xcd_barrier_complete(unsigned* bar, unsigned x, unsigned& nloc, unsigned& nx) {
    const unsigned G = gridDim.x * gridDim.y * gridDim.z;
    unsigned sum, cnt, mine, sp = 0u;
    for (;;) {
        sum = 0u; cnt = 0u; mine = 0u;
#pragma unroll
        for (unsigned j = 0; j < 16; ++j) { const unsigned c = xb_ld(&bar[XB_XCNT(j)]); sum += c; cnt += (c > 0u) ? 1u : 0u; mine = (j == x) ? c : mine; }
        if (sum == G) break;
        __builtin_amdgcn_s_sleep(1);
        if ((++sp & 255u) == 0u) { if (xb_ld(&bar[XB_TMO])) break; if (sp > XB_SPIN_CAP) { atomicAdd(&bar[XB_TMO], 1u); break; } }
    }
    nloc = mine > 0u ? mine : 1u; nx = cnt > 0u ? cnt : 1u;
}
__device__ __forceinline__ void xcd_barrier(const XcdBarrier& b) {
    asm volatile("s_waitcnt vmcnt(0)" ::: "memory");
    __syncthreads();
    if (b.wave == 0 && lane_id_asm() == 0) {
        unsigned* bar = b.bar; unsigned bx = b.x;
        asm volatile("" : "+s"(bar), "+s"(bx));
        __builtin_amdgcn_s_waitcnt(0);
        unsigned nloc = b.st[0], nx = b.st[1];
        if (nloc == 0u) { xcd_barrier_complete(bar, bx, nloc, nx); b.st[0] = nloc; b.st[1] = nx; }
        const unsigned old = xb_add(&bar[XB_XSUB(bx)], 1u);
        const unsigned gen = old / nloc;
        if (old + 1u == (gen + 1u) * nloc) {
            __builtin_amdgcn_fence(__ATOMIC_RELEASE, "agent");
            asm volatile("s_waitcnt vmcnt(0)" ::: "memory");
            const unsigned og = xb_add(&bar[XB_TOP], 1u);
            const unsigned tg = og / nx;
            if (og + 1u == (tg + 1u) * nx) xb_add(&bar[XB_TOPGEN], 1u);
            else XB_SPIN(xb_ld(&bar[XB_TOPGEN]) == tg, bar);
            __builtin_amdgcn_fence(__ATOMIC_ACQUIRE, "agent");
            xb_add(&bar[XB_XGEN(bx)], 1u);
            asm volatile("s_waitcnt vmcnt(0)" ::: "memory");
        } else {
            XB_SPIN(xb_ld(&bar[XB_XGEN(bx)]) == gen, bar);
            __builtin_amdgcn_fence(__ATOMIC_ACQUIRE, "agent");
            asm volatile("s_waitcnt vmcnt(0)" ::: "memory");
        }
    }
    __syncthreads();
}

constexpr int D = 2048, SEQ = 8192, M = 16384, DFF = 8192;
constexpr int NSA_N = 5376;
constexpr int NSA_N1 = 4096;
constexpr int DIL_N = 18432;
constexpr int DRNN = 2688, RG_N = 5632;
constexpr int RG_XOFF = 2816;
constexpr int NWAVES = 8, NTHREADS = 512;
constexpr int LDV = M + 64;
constexpr float ATT_SCALE = 0.08838834764831845f;
constexpr float NORM_EPS = 1e-6f;

constexpr int IN_X = 0, IN_C = 1, IN_NORMF = 45;
__host__ __device__ __forceinline__ constexpr int layer_base(int li) { return li == 0 ? 2 : li == 1 ? 13 : li == 2 ? 21 : 34; }
__host__ __device__ __forceinline__ constexpr int ff_off(int li) { return li == 1 ? 5 : li == 2 ? 10 : 8; }
__host__ __device__ __forceinline__ constexpr int wout_off(int li) { return li == 1 ? 4 : li == 2 ? 9 : 7; }

constexpr size_t MiB = 1u << 20;
constexpr size_t WS_CTL = 0, CTL_ZERO_BYTES = 1 * MiB;
constexpr size_t WS_MODP = 1 * MiB;
constexpr size_t WS_MOD = 4 * MiB;
constexpr size_t WS_COS = 5 * MiB, WS_SIN = 7 * MiB;
constexpr size_t WS_BPEP = 9 * MiB;
constexpr size_t WS_BPE = 9 * MiB + 512 * 1024;
constexpr size_t WS_LSP = 9 * MiB + 768 * 1024;
constexpr size_t WS_W = 10 * MiB;
constexpr size_t WE_NSA_WIN = 0, WE_NSA_W1 = 11010048, WE_NSA_WOUT = 11010048 + 4194304, WE_NSA_SZ = 19398656;
constexpr size_t WE_DIL = 2 * WE_NSA_SZ, WE_DIL_WOUT = WE_DIL + 37748736;
constexpr size_t WE_RG = WE_DIL + 41943040, WE_RG_WG = WE_RG + 11534336, WE_RG_WOUT = WE_RG_WG + 14450688;
constexpr size_t WE_FF = WE_RG + 31490048;
constexpr size_t WE_END = WE_FF + 4 * (size_t)33554432;
static_assert(WE_END == 246448128, "weight map");
constexpr size_t WS_HN = 482 * MiB;
constexpr size_t WS_ATT = 546 * MiB;
constexpr size_t WS_XR = 630 * MiB;
constexpr size_t WS_BIG = 694 * MiB;
static_assert(WS_W + WE_END * 2 <= WS_HN, "ws map");
constexpr size_t NS_Q = WS_BIG, NS_QR = NS_Q + 64 * MiB, NS_PK = NS_QR + 64 * MiB, NS_PV = NS_PK + 16 * MiB, NS_KS = NS_PV + 16 * MiB, NS_KW = NS_KS + 16 * MiB,
                 NS_VT = NS_KW + 16 * MiB  , NS_GT = NS_VT + 34 * MiB, NS_HC = NS_GT + 4 * MiB, NS_KC = NS_HC + 32 * MiB  ,
                 NS_VCT = NS_KC + 1 * MiB  , NS_END = NS_VCT + 1 * MiB;
constexpr size_t RG_YX = WS_BIG, RG_X = RG_YX + 176 * MiB, RG_A = RG_X + 84 * MiB, RG_B = RG_A + 168 * MiB, RG_CA = RG_B + 168 * MiB, RG_CB = RG_CA + 3 * MiB;
constexpr size_t DL_QK = WS_BIG, DL_VT = WS_BIG + 384 * MiB, DL_VT_STRIDE = 66 * MiB, DL_ML = WS_BIG + 582 * MiB;
constexpr size_t WS_END = WS_BIG + 610 * MiB;
static_assert(RG_CB + 3 * MiB <= WS_END && NS_END <= WS_END && DL_ML + 2 * MiB <= WS_END && WS_END <= (size_t)1396 * MiB, "ws map");

constexpr int RING_BYTES = 147456, MISC_OFF = RING_BYTES + 320, LDS_BYTES = 163840;

struct Params { const float* in[46]; float* out; unsigned char* ws; };

__device__ __forceinline__ float lo_bf(unsigned w) { return __uint_as_float(w << 16); }
__device__ __forceinline__ float hi_bf(unsigned w) { return __uint_as_float(w & 0xffff0000u); }
__device__ __forceinline__ unsigned pk2(float lo, float hi) { return pg8::cvt_pk_bf16(lo, hi); }
__device__ __forceinline__ float wave_sum(float v) {
#pragma unroll
    for (int o = 1; o < 64; o <<= 1) v += __shfl_xor(v, o);
    return v;
}
__device__ __forceinline__ float wave_max(float v) {
#pragma unroll
    for (int o = 1; o < 64; o <<= 1) v = fmaxf(v, __shfl_xor(v, o));
    return v;
}
__device__ __forceinline__ float sigmoidf_(float x) { return 1.0f / (1.0f + __expf(-x)); }
__device__ __forceinline__ float gelu_tanh(float x) { const float u = 0.7978845608028654f * (x + 0.044715f * x * x * x); const float e = __expf(2.0f * u); return 0.5f * x * (2.0f - 2.0f / (e + 1.0f)); }
__device__ __forceinline__ int sigma_d(int pos) { return (pos & 1) * 64 + (pos >> 1); }
__device__ __forceinline__ void store8_bf16(bf16* p, const f32x4 v0, const f32x4 v1) {
    u32x4 w; w.x = pk2(v0[0], v0[1]); w.y = pk2(v0[2], v0[3]); w.z = pk2(v1[0], v1[1]); w.w = pk2(v1[2], v1[3]); *(u32x4*)p = w; }
__device__ __forceinline__ void rope8(f32x4& v0, f32x4& v1, const float* cosr, const float* sinr, int i0) {
    const f32x4 cs = *(const f32x4*)(cosr + i0), sn = *(const f32x4*)(sinr + i0);
    const f32x4 a = v0, b = v1;
    v0[0] = a[0] * cs[0] - a[1] * sn[0]; v0[1] = a[0] * sn[0] + a[1] * cs[0];
    v0[2] = a[2] * cs[1] - a[3] * sn[1]; v0[3] = a[2] * sn[1] + a[3] * cs[1];
    v1[0] = b[0] * cs[2] - b[1] * sn[2]; v1[1] = b[0] * sn[2] + b[1] * cs[2];
    v1[2] = b[2] * cs[3] - b[3] * sn[3]; v1[3] = b[2] * sn[3] + b[3] * cs[3];
}

__device__ __forceinline__ void rope8v(f32x4& v0, f32x4& v1, const f32x4 cs, const f32x4 sn) {
    const f32x4 a = v0, b = v1;
    v0[0] = a[0] * cs[0] - a[1] * sn[0]; v0[1] = a[0] * sn[0] + a[1] * cs[0];
    v0[2] = a[2] * cs[1] - a[3] * sn[1]; v0[3] = a[2] * sn[1] + a[3] * cs[1];
    v1[0] = b[0] * cs[2] - b[1] * sn[2]; v1[1] = b[0] * sn[2] + b[1] * cs[2];
    v1[2] = b[2] * cs[3] - b[3] * sn[3]; v1[3] = b[2] * sn[3] + b[3] * cs[3];
}
#define EPI_LOOP_ROWS for (int ai = 0; ai < 2; ++ai) _Pragma("unroll") for (int m = 0; m < 4; ++m)
struct EpiNsaIn {
    static constexpr bool PERM = true, AFTER_DRAIN = false;
    bf16 *Q, *QR, *PK, *PV, *KS, *KW; float* GT; const float *COS, *SIN;
    __device__ __forceinline__ void operator()(const f32x4 (&acc)[2][2][4][2], const pg8::Unit& u, int wr, int wc, int fr, int fq) const {
        const int pn = u.pn, row0 = u.pm * 256 + wr * 64 + fr, cl = wc * 32 + 8 * fq;
        const bool rot = pn < 8 || pn >= 12;
#pragma unroll
        for (int ai = 0; ai < 2; ++ai) {
            f32x4 cs[4], sn[4];
            if (rot) {
#pragma unroll
                for (int m = 0; m < 4; ++m) { const int t = (row0 + ai * 128 + m * 16) & (SEQ - 1); cs[m] = *(const f32x4*)(COS + (size_t)t * 64 + (cl >> 1)); sn[m] = *(const f32x4*)(SIN + (size_t)t * 64 + (cl >> 1)); } }
#pragma unroll
            for (int m = 0; m < 4; ++m) {
                const int row = row0 + ai * 128 + m * 16, t = row & (SEQ - 1), b = row >> 13;
#pragma unroll
                for (int bj = 0; bj < 2; ++bj) {
                    f32x4 v0 = acc[ai][bj][m][0], v1 = acc[ai][bj][m][1];
                    const int hh = (pn & 1) * 2 + bj;
                    if (pn < 8) {
                        const size_t o = (size_t)row * 2048 + pn * 256 + bj * 128 + cl;
                        store8_bf16(Q + o, v0, v1);
                        rope8v(v0, v1, cs[m], sn[m]);
                        store8_bf16(QR + o, v0, v1);
                    } else if (pn < 12) {
                        bf16* P = pn < 10 ? PK : PV;
                        const size_t o = ((size_t)((b * 4 + hh) * 512 + (t >> 4))) * 2048 + (t & 15) * 128 + cl;
                        store8_bf16(P + o, v0, v1);
                    } else {
                        bf16* P = pn < 14 ? KS : KW;
                        rope8v(v0, v1, cs[m], sn[m]);
                        store8_bf16(P + (size_t)row * 512 + hh * 128 + cl, v0, v1);
                    }
                }
            }
        }
    }
};
struct EpiGates {
    static constexpr bool PERM = true, AFTER_DRAIN = false;
    float* GT;
    __device__ __forceinline__ void operator()(const f32x4 (&acc)[2][2][4][2], const pg8::Unit& u, int wr, int wc, int fr, int fq) const {
        const int row0 = u.pm * 256 + wr * 64 + fr, cl = wc * 32 + 8 * fq;
        if (cl < 48) {
#pragma unroll
            EPI_LOOP_ROWS { const int row = row0 + ai * 128 + m * 16; const f32x4 v0 = acc[ai][0][m][0], v1 = acc[ai][0][m][1];
#pragma unroll
                for (int e = 0; e < 4; ++e) { GT[(size_t)row * 48 + cl + e] = sigmoidf_(v0[e]); GT[(size_t)row * 48 + cl + 4 + e] = sigmoidf_(v1[e]); } }
        }
    }
};
struct EpiDilQK {
    static constexpr bool PERM = true, AFTER_DRAIN = false;
    bf16* O; const float *COS, *SIN; int dsh;
    __device__ __forceinline__ void operator()(const f32x4 (&acc)[2][2][4][2], const pg8::Unit& u, int wr, int wc, int fr, int fq) const {
        const int pn = u.pn, row0 = u.pm * 256 + wr * 64 + fr, cl = wc * 32 + 8 * fq, sh = 13 - dsh;
#pragma unroll
        for (int ai = 0; ai < 2; ++ai) {
            f32x4 cs[4], sn[4];
#pragma unroll
            for (int m = 0; m < 4; ++m) { const int row = row0 + ai * 128 + m * 16, rem = row & (SEQ - 1), t = ((rem & ((1 << sh) - 1)) << dsh) + (rem >> sh);
                cs[m] = *(const f32x4*)(COS + (size_t)t * 64 + (cl >> 1)); sn[m] = *(const f32x4*)(SIN + (size_t)t * 64 + (cl >> 1)); }
#pragma unroll
            for (int m = 0; m < 4; ++m) { const int row = row0 + ai * 128 + m * 16;
#pragma unroll
                for (int bj = 0; bj < 2; ++bj) {
                    f32x4 v0 = acc[ai][bj][m][0], v1 = acc[ai][bj][m][1];
                    rope8v(v0, v1, cs[m], sn[m]);
                    store8_bf16(O + (size_t)row * 4096 + pn * 256 + bj * 128 + cl, v0, v1);
                } }
        }
    }
};
template <int ACT> struct EpiBf16 {
    static constexpr bool PERM = true, AFTER_DRAIN = false;
    bf16* O; int ldc; int act_tiles;
    __device__ __forceinline__ void operator()(const f32x4 (&acc)[2][2][4][2], const pg8::Unit& u, int wr, int wc, int fr, int fq) const {
        const int pn = u.pn, row0 = u.pm * 256 + wr * 64 + fr, cl = wc * 32 + 8 * fq;
        const bool act = pn < act_tiles;
#pragma unroll
        EPI_LOOP_ROWS {
            const int row = row0 + ai * 128 + m * 16;
#pragma unroll
            for (int bj = 0; bj < 2; ++bj) {
                f32x4 v0 = acc[ai][bj][m][0], v1 = acc[ai][bj][m][1];
                if (ACT == 1) {
#pragma unroll
                    for (int e = 0; e < 4; ++e) { const float a = fmaxf(v0[e], 0.f), c = fmaxf(v1[e], 0.f); v0[e] = a * a; v1[e] = c * c; }
                }
                if (ACT == 2) { if (act) {
#pragma unroll
                    for (int e = 0; e < 4; ++e) { v0[e] = gelu_tanh(v0[e]); v1[e] = gelu_tanh(v1[e]); } } }
                store8_bf16(O + (size_t)row * ldc + pn * 256 + bj * 128 + cl, v0, v1);
            }
        }
    }
};
struct EpiF32 {
    static constexpr bool PERM = false, AFTER_DRAIN = false;
    float* C; int ldc;
    __device__ __forceinline__ void operator()(const f32x4 (&acc)[2][2][4][2], const pg8::Unit& u, int wr, int wc, int fr, int fq) const {
        const int row0 = u.pm * 256 + wr * 64 + fr, col0 = u.pn * 256 + wc * 32 + 4 * fq;
#pragma unroll
        EPI_LOOP_ROWS {
            float* rowp = C + (size_t)(row0 + ai * 128 + m * 16) * ldc + col0;
#pragma unroll
            for (int bj = 0; bj < 2; ++bj)
#pragma unroll
                for (int n = 0; n < 2; ++n) *(f32x4*)(rowp + bj * 128 + n * 16) = acc[ai][bj][m][n];
        }
    }
};
struct EpiRes {
    static constexpr bool PERM = true, AFTER_DRAIN = false;
    const float* xin32; const bf16* xin16; bf16* out; const float* gate;
    __device__ __forceinline__ void operator()(const f32x4 (&acc)[2][2][4][2], const pg8::Unit& u, int wr, int wc, int fr, int fq) const {
        const int row0 = u.pm * 256 + wr * 64 + fr, cl = wc * 32 + 8 * fq, b = (u.pm * 256) >> 13;
        f32x4 g0[2], g1[2];
#pragma unroll
        for (int bj = 0; bj < 2; ++bj) { const float* gp = gate + (size_t)b * 12288 + u.pn * 256 + bj * 128 + cl; g0[bj] = *(const f32x4*)gp; g1[bj] = *(const f32x4*)(gp + 4); }
#pragma unroll
        for (int ai = 0; ai < 2; ++ai) {
            f32x4 x0[4][2], x1[4][2];
#pragma unroll
            for (int m = 0; m < 4; ++m)
#pragma unroll
                for (int bj = 0; bj < 2; ++bj) { const size_t o = (size_t)(row0 + ai * 128 + m * 16) * D + u.pn * 256 + bj * 128 + cl;
                    if (xin32) { x0[m][bj] = *(const f32x4*)(xin32 + o); x1[m][bj] = *(const f32x4*)(xin32 + o + 4); }
                    else { const u32x4 w = *(const u32x4*)(xin16 + o); x0[m][bj] = (f32x4){lo_bf(w.x), hi_bf(w.x), lo_bf(w.y), hi_bf(w.y)}; x1[m][bj] = (f32x4){lo_bf(w.z), hi_bf(w.z), lo_bf(w.w), hi_bf(w.w)}; } }
#pragma unroll
            for (int m = 0; m < 4; ++m)
#pragma unroll
                for (int bj = 0; bj < 2; ++bj) store8_bf16(out + (size_t)(row0 + ai * 128 + m * 16) * D + u.pn * 256 + bj * 128 + cl, x0[m][bj] + g0[bj] * acc[ai][bj][m][0], x1[m][bj] + g1[bj] * acc[ai][bj][m][1]);
        }
    }
};
struct EpiRgGate {
    static constexpr bool PERM = true, AFTER_DRAIN = false;
    const bf16* X; const float *bgate, *LSP; unsigned* AB;
    __device__ __forceinline__ void operator()(const f32x4 (&acc)[2][2][4][2], const pg8::Unit& u, int wr, int wc, int fr, int fq) const {
        const int row0 = u.pm * 256 + wr * 64 + fr, ch0 = u.pn * 128 + wc * 32 + 8 * fq;
        u32x4 xw[2][4];
#pragma unroll
        for (int ai = 0; ai < 2; ++ai)
#pragma unroll
            for (int m = 0; m < 4; ++m) xw[ai][m] = *(const u32x4*)(X + (size_t)(row0 + ai * 128 + m * 16) * DRNN + ch0);
        const f32x4 br0 = *(const f32x4*)(bgate + ch0), br1 = *(const f32x4*)(bgate + ch0 + 4);
        const f32x4 bi0 = *(const f32x4*)(bgate + DRNN + ch0), bi1 = *(const f32x4*)(bgate + DRNN + ch0 + 4);
        const f32x4 ls0 = *(const f32x4*)(LSP + ch0), ls1 = *(const f32x4*)(LSP + ch0 + 4);
#pragma unroll
        EPI_LOOP_ROWS {
            const size_t o = (size_t)(row0 + ai * 128 + m * 16) * DRNN + ch0;
            const u32x4 xv = xw[ai][m];
            const f32x4 x0 = (f32x4){lo_bf(xv.x), hi_bf(xv.x), lo_bf(xv.y), hi_bf(xv.y)}, x1 = (f32x4){lo_bf(xv.z), hi_bf(xv.z), lo_bf(xv.w), hi_bf(xv.w)};
            const f32x4 r0 = acc[ai][0][m][0] + br0, r1 = acc[ai][0][m][1] + br1, i0 = acc[ai][1][m][0] + bi0, i1 = acc[ai][1][m][1] + bi1;
            u32x4 w0, w1;
#pragma unroll
            for (int e = 0; e < 4; ++e) {
                float la = ls0[e] * sigmoidf_(r0[e]); float bb = sqrtf(fmaxf(-expm1f(2.0f * la), 0.f)) * (sigmoidf_(i0[e]) * x0[e]); w0[e] = pk2(la * 1.4426950408889634f, bb);
                la = ls1[e] * sigmoidf_(r1[e]); bb = sqrtf(fmaxf(-expm1f(2.0f * la), 0.f)) * (sigmoidf_(i1[e]) * x1[e]); w1[e] = pk2(la * 1.4426950408889634f, bb);
            }
            *(u32x4*)(AB + o) = w0; *(u32x4*)(AB + o + 4) = w1;
        }
    }
};

__device__ __forceinline__ const float* inp(const Params& P, int i) { i = __builtin_amdgcn_readfirstlane(i); asm volatile("" : "+s"(i)); return P.in[i]; }
enum { MAP_ID = 0, MAP_NSA = 1, MAP_DIL = 2, MAP_RG = 3 };
struct Job { const float* W; int ldw, K; bf16* WT; int ldt, n_begin, n_rows, map, srcoff; };
__device__ __forceinline__ int srccol(int map, int n, int srcoff) {
    if (map == MAP_ID) return n + srcoff;
    if (map == MAP_NSA) {
        if (n < 2048) return (n & ~127) + sigma_d(n & 127);
        if (n < 3072) return n;
        if (n < 3584) return (n & ~127) + sigma_d(n & 127);
        if (n < 4096) return ((n + 512) & ~127) + sigma_d(n & 127);
        if (n < 4144) return 5120 + (n - 4096);
        if (n < 4352) return -1;
        if (n < 4864) return n - 768;
        return n - 256;
    }
    if (map == MAP_DIL) { const int j = (n >> 11) % 3; return j < 2 ? (n & ~127) + sigma_d(n & 127) : n; }
    if (n < DRNN) return n; if (n < RG_XOFF) return -1; if (n < RG_XOFF + DRNN) return n - (RG_XOFF - DRNN); return -1;
}
__device__ __forceinline__ bool is_sigma(int map, int n) {
    if (map == MAP_NSA) return n < 2048 || (n >= 3072 && n < 4096);
    if (map == MAP_DIL) return ((n >> 11) % 3) < 2;
    return false;
}
__device__ __forceinline__ void conv_item(const Job& J, int item, LAS float* scr, int lane) {
    const int nblk = J.n_rows / 32, kb = item / nblk, nb = item % nblk, k0 = 64 * kb, n0 = J.n_begin + 32 * nb, nl0 = n0 - J.n_begin;
    const int ks = lane >> 3, c4 = lane & 7;
    const bool sig = is_sigma(J.map, nl0);
    const int dl0 = sig ? 8 * (c4 & 3) + (c4 >> 2) : 4 * c4, dstep = sig ? 2 : 1;
    const int sc4 = srccol(J.map, nl0 + dl0, J.srcoff);
    f32x4 v[8];
#pragma unroll
    for (int i = 0; i < 8; ++i) v[i] = sc4 >= 0 ? __builtin_nontemporal_load((const f32x4*)(J.W + (size_t)(k0 + 8 * i + ks) * J.ldw + sc4)) : (f32x4){0.f, 0.f, 0.f, 0.f};
#pragma unroll
    for (int i = 0; i < 8; ++i) { LAS float* d = scr + (8 * i + ks) * 33 + dl0; d[0] = v[i][0]; d[dstep] = v[i][1]; d[2 * dstep] = v[i][2]; d[3 * dstep] = v[i][3]; }
    LDS_WAIT();
    const int c = lane & 7;
#pragma unroll
    for (int j = 0; j < 4; ++j) { const int n = (lane >> 3) + 8 * j; const LAS float* sp = scr + (8 * c) * 33 + n;
        u32x4 o; o.x = pk2(sp[0 * 33], sp[1 * 33]); o.y = pk2(sp[2 * 33], sp[3 * 33]); o.z = pk2(sp[4 * 33], sp[5 * 33]); o.w = pk2(sp[6 * 33], sp[7 * 33]);
        *(u32x4*)(J.WT + (size_t)(n0 + n) * J.ldt + k0 + 8 * c) = o; }
    LDS_WAIT();
}
constexpr int NJOBS = 24, NJOBS_FIRST = 6;
__device__ __forceinline__ Job get_job(const Params& P, int jid) {
    bf16* WB = (bf16*)(P.ws + WS_W);
    Job J; J.srcoff = 0; J.map = MAP_ID; J.n_begin = 0;
    if (jid < 12) {
        const int slot = jid / 6, r = jid % 6, bi = slot == 0 ? 2 : 34; bf16* base = WB + (size_t)slot * WE_NSA_SZ;
        if (r == 0) { J.W = inp(P, bi + 3); J.ldw = 5168; J.K = 2048; J.WT = base + WE_NSA_WIN; J.ldt = 2048; J.n_rows = NSA_N; J.map = MAP_NSA; }
        else if (r < 5) { const int kv = (r - 1) >> 1, half = (r - 1) & 1;
            J.W = inp(P, bi + 5) + (size_t)kv * 4096 * 512 + (size_t)half * 2048 * 512; J.ldw = 512; J.K = 2048;
            J.WT = base + WE_NSA_W1 + (size_t)kv * 1024 * 2048; J.ldt = 2048; J.n_begin = half * 512; J.n_rows = 512; }
        else { J.W = inp(P, bi + 7); J.ldw = 2048; J.K = 2048; J.WT = base + WE_NSA_WOUT; J.ldt = 2048; J.n_rows = 2048; }
    } else if (jid == 12) { J.W = inp(P, 13 + 3); J.ldw = DIL_N; J.K = 2048; J.WT = WB + WE_DIL; J.ldt = 2048; J.n_rows = DIL_N; J.map = MAP_DIL; }
    else if (jid == 13) { J.W = inp(P, 13 + 4); J.ldw = 2048; J.K = 2048; J.WT = WB + WE_DIL_WOUT; J.ldt = 2048; J.n_rows = 2048; }
    else if (jid == 14) { J.W = inp(P, 21 + 3); J.ldw = 2 * DRNN; J.K = 2048; J.WT = WB + WE_RG; J.ldt = 2048; J.n_rows = RG_N; J.map = MAP_RG; }
    else if (jid == 15) { J.W = inp(P, 21 + 9); J.ldw = 2048; J.K = DRNN; J.WT = WB + WE_RG_WOUT; J.ldt = DRNN; J.n_rows = 2048; }
    else { const int li = (jid - 16) >> 1, w = (jid - 16) & 1, bi = layer_base(li) + ff_off(li);
        if (w == 0) { J.W = inp(P, bi + 1); J.ldw = DFF; J.K = 2048; J.WT = WB + WE_FF + (size_t)li * 33554432; J.ldt = 2048; J.n_rows = DFF; }
        else { J.W = inp(P, bi + 2); J.ldw = 2048; J.K = DFF; J.WT = WB + WE_FF + (size_t)li * 33554432 + 16777216; J.ldt = DFF; J.n_rows = 2048; } }
    return J;
}

namespace fa {
typedef float f32x16 __attribute__((ext_vector_type(16)));
typedef short bf16x8 __attribute__((ext_vector_type(8)));
constexpr int KROW = 272, VROW = 144, KTILE = 64 * KROW, VTILE = 128 * VROW;
constexpr int KBUF0 = 0, VBUF0 = 3 * KTILE, IMP_OFF = VBUF0 + 2 * VTILE, MSK_OFF = RING_BYTES - 1024;
static_assert(IMP_OFF + 32768 <= MSK_OFF, "attention LDS map");
static_assert(MSK_OFF + 1024 <= RING_BYTES, "attention LDS map");
constexpr float C2 = ATT_SCALE * 1.4426950408889634f;
#define FA_MFMA(a, b, c) __builtin_amdgcn_mfma_f32_32x32x16_bf16(a, b, c, 0, 0, 0)
__device__ __forceinline__ float half_max(float v) { auto rr = __builtin_amdgcn_permlane32_swap(__float_as_uint(v), __float_as_uint(v), false, false); return fmaxf(__uint_as_float(rr[0]), __uint_as_float(rr[1])); }
__device__ __forceinline__ float half_sum(float v) { auto rr = __builtin_amdgcn_permlane32_swap(__float_as_uint(v), __float_as_uint(v), false, false); return __uint_as_float(rr[0]) + __uint_as_float(rr[1]); }
struct Src { const bf16* K0; long ldk; const bf16* V0; long ldv; int tsh; };
struct Stage { u32x4 k0, k1, v0, v1; };
__device__ __forceinline__ void stage_load_k(Stage& s, const Src& src, int T, int tid) {
    const int kr = tid >> 4, kc = tid & 15;
    const char* kb = (const char*)(src.K0 + (long)(64 * (T >> src.tsh)) * src.ldk); const char* kb2 = kb + 64 * src.ldk;
    unsigned ko = (unsigned)(kr * (int)src.ldk + kc * 8) * 2u; asm volatile("" : "+v"(ko));
    s.k0 = *(const u32x4*)(kb + ko); s.k1 = *(const u32x4*)(kb2 + ko);
}
__device__ __forceinline__ void stage_load_v(Stage& s, const Src& src, int T, int tid) {
    const int vr = tid >> 3, vp = tid & 7;
    const char* vb = (const char*)(src.V0 + 64 * (T >> src.tsh)); const char* vb2 = vb + 128 * src.ldv;
    unsigned vo = (unsigned)(vr * (int)src.ldv + vp * 8) * 2u; asm volatile("" : "+v"(vo));
    s.v0 = *(const u32x4*)(vb + vo); s.v1 = *(const u32x4*)(vb2 + vo);
}
__device__ __forceinline__ void stage_load(Stage& s, const Src& src, int T, int tid, bool withV) { stage_load_k(s, src, T, tid); if (withV) stage_load_v(s, src, T, tid); }
__device__ __forceinline__ void stage_write_k_at(const Stage& s, LAS unsigned char* ktile, int tid) {
    const int kr = tid >> 4, kc = tid & 15;
    LAS unsigned char* kb = ktile + kr * KROW + kc * 16;
    *(LAS u32x4*)kb = s.k0; *(LAS u32x4*)(kb + 32 * KROW) = s.k1;
}
__device__ __forceinline__ void stage_write_k(const Stage& s, LAS unsigned char* lds, int kbuf, int tid) { stage_write_k_at(s, lds + KBUF0 + kbuf * KTILE, tid); }
__device__ __forceinline__ void stage_write_v_at(const Stage& s, LAS unsigned char* vtile, int tid);
__device__ __forceinline__ void stage_write_v(const Stage& s, LAS unsigned char* lds, int vbuf, int tid) { stage_write_v_at(s, lds + VBUF0 + vbuf * VTILE, tid); }
__device__ __forceinline__ void stage_write_v_at(const Stage& s, LAS unsigned char* vtile, int tid) {
    const int vr = tid >> 3, vp = tid & 7, g16 = vp >> 1, half = vp & 1;
    LAS unsigned char* vb = vtile + vr * VROW + g16 * 32 + half * 8;
    *(LAS u32x2*)(vb) = (u32x2){s.v0.x, s.v0.y}; *(LAS u32x2*)(vb + 16) = (u32x2){s.v0.z, s.v0.w};
    *(LAS u32x2*)(vb + 64 * VROW) = (u32x2){s.v1.x, s.v1.y}; *(LAS u32x2*)(vb + 64 * VROW + 16) = (u32x2){s.v1.z, s.v1.w};
}
__device__ __forceinline__ void stage_write(const Stage& s, LAS unsigned char* lds, int buf, int tid, bool withV) { stage_write_k(s, lds, buf, tid); if (withV) stage_write_v(s, lds, buf, tid); }
__device__ __forceinline__ void load_q(bf16x8 (&qf)[8], const bf16* qrow, int hi) {
#pragma unroll
    for (int kk = 0; kk < 8; ++kk) qf[kk] = *(const bf16x8*)(qrow + kk * 16 + hi * 8);
}
#define FA_PIPE_16() do { __builtin_amdgcn_sched_group_barrier(0x100, 4, 0); \
    _Pragma("unroll") for (int i_ = 0; i_ < 12; ++i_) { __builtin_amdgcn_sched_group_barrier(0x008, 1, 0); __builtin_amdgcn_sched_group_barrier(0x100, 1, 0); } \
    __builtin_amdgcn_sched_group_barrier(0x008, 4, 0); } while (0)
__device__ __forceinline__ void qk_tile_at(f32x16& p0, f32x16& p1, const LAS unsigned char* ktile, const bf16x8 (&qf)[8], int c32, int hi);
__device__ __forceinline__ void qk_tile(f32x16& p0, f32x16& p1, const LAS unsigned char* lds, int buf, const bf16x8 (&qf)[8], int c32, int hi) { qk_tile_at(p0, p1, lds + KBUF0 + buf * KTILE, qf, c32, hi); }
__device__ __forceinline__ void qk_tile_at(f32x16& p0, f32x16& p1, const LAS unsigned char* ktile, const bf16x8 (&qf)[8], int c32, int hi) {
#pragma unroll
    for (int r = 0; r < 16; ++r) { p0[r] = 0.f; p1[r] = 0.f; }
    const LAS unsigned char* kb = ktile + c32 * KROW + hi * 16;
    bf16x8 a[16];
#pragma unroll
    for (int kk = 0; kk < 8; ++kk) { a[2 * kk] = *(const LAS bf16x8*)(kb + 32 * kk); a[2 * kk + 1] = *(const LAS bf16x8*)(kb + 32 * KROW + 32 * kk); }
#pragma unroll
    for (int kk = 0; kk < 8; ++kk) { p0 = FA_MFMA(a[2 * kk], qf[kk], p0); p1 = FA_MFMA(a[2 * kk + 1], qf[kk], p1); }
    FA_PIPE_16();
}
__device__ __forceinline__ void pv_tile_at(f32x16 (&o)[4], const LAS unsigned char* vtile, const bf16x8 (&pa)[4], int c32, int hi);
__device__ __forceinline__ void pv_tile(f32x16 (&o)[4], const LAS unsigned char* lds, int buf, const bf16x8 (&pa)[4], int c32, int hi) { pv_tile_at(o, lds + VBUF0 + buf * VTILE, pa, c32, hi); }
__device__ __forceinline__ void pv_tile_at(f32x16 (&o)[4], const LAS unsigned char* vtile, const bf16x8 (&pa)[4], int c32, int hi) {
    const LAS unsigned char* vb = vtile + c32 * VROW + hi * 16;
    bf16x8 a[16];
#pragma unroll
    for (int S = 0; S < 4; ++S)
#pragma unroll
        for (int db = 0; db < 4; ++db) a[4 * S + db] = *(const LAS bf16x8*)(vb + db * 32 * VROW + 32 * S);
#pragma unroll
    for (int S = 0; S < 4; ++S)
#pragma unroll
        for (int db = 0; db < 4; ++db) o[db] = FA_MFMA(a[4 * S + db], pa[S], o[db]);
    FA_PIPE_16();
}
__device__ __forceinline__ void mask_range(f32x16& p0, f32x16& p1, int lo, int hi_, int hi) {
    const int lo4 = lo - 4 * hi, hi4 = hi_ - 4 * hi;
#pragma unroll
    for (int r = 0; r < 16; ++r) { const int c = (r & 3) + 8 * (r >> 2);
        if (c < lo4 || c > hi4) p0[r] = -INFINITY;
        if (c + 32 < lo4 || c + 32 > hi4) p1[r] = -INFINITY; }
}
template <int B_> __device__ __forceinline__ bf16x8 pack8r(const f32x16& p) {
    u32x4 w; w.x = pk2(p[B_ + 0], p[B_ + 1]); w.y = pk2(p[B_ + 2], p[B_ + 3]); w.z = pk2(p[B_ + 4], p[B_ + 5]); w.w = pk2(p[B_ + 6], p[B_ + 7]);
    return __builtin_bit_cast(bf16x8, w); }
constexpr float THR = 8.0f;
__device__ __forceinline__ void softmax_step(f32x16& p0, f32x16& p1, bool rowoff, float& m, float& l, f32x16 (&o)[4], bf16x8 (&pa)[4]) {
    float mx = fmaxf(fmaxf(p0[0], p0[1]), p0[2]);
#pragma unroll
    for (int r = 3; r < 15; r += 2) mx = fmaxf(fmaxf(mx, p0[r]), p0[r + 1]);
    mx = fmaxf(mx, p0[15]);
#pragma unroll
    for (int r = 0; r < 16; r += 2) mx = fmaxf(fmaxf(mx, p1[r]), p1[r + 1]);
    mx = half_max(mx);
    if (rowoff) mx = -INFINITY;
    if (!__all((mx - m) * C2 <= THR)) {
        const float mn = fmaxf(m, mx), alpha = __builtin_amdgcn_exp2f((m - mn) * C2); m = mn; l *= alpha;
#pragma unroll
        for (int db = 0; db < 4; ++db) o[db] = o[db] * alpha;
    }
    const float mnL = rowoff ? -INFINITY : -m * C2;
    p0 = p0 * C2 + mnL; p1 = p1 * C2 + mnL;
#pragma unroll
    for (int r = 0; r < 16; ++r) { p0[r] = __builtin_amdgcn_exp2f(p0[r]); p1[r] = __builtin_amdgcn_exp2f(p1[r]); }
    f32x16 sv = p0 + p1;
    const float ps = ((sv[0] + sv[1]) + (sv[2] + sv[3])) + ((sv[4] + sv[5]) + (sv[6] + sv[7])) + (((sv[8] + sv[9]) + (sv[10] + sv[11])) + ((sv[12] + sv[13]) + (sv[14] + sv[15])));
    l += half_sum(ps);
    pa[0] = pack8r<0>(p0); pa[1] = pack8r<8>(p0); pa[2] = pack8r<0>(p1); pa[3] = pack8r<8>(p1);
}
struct Msk { int qlo, qhi; const LAS unsigned* sel; };
#define FA_PIPE_8() do { __builtin_amdgcn_sched_group_barrier(0x100, 4, 0); \
    _Pragma("unroll") for (int i_ = 0; i_ < 4; ++i_) { __builtin_amdgcn_sched_group_barrier(0x008, 1, 0); __builtin_amdgcn_sched_group_barrier(0x100, 1, 0); } \
    __builtin_amdgcn_sched_group_barrier(0x008, 4, 0); } while (0)
__device__ __forceinline__ void qk_half(f32x16& p, const LAS unsigned char* lds, int kbuf, int half, const bf16x8 (&qf)[8], int c32, int hi) {
#pragma unroll
    for (int r = 0; r < 16; ++r) p[r] = 0.f;
    const LAS unsigned char* kb = lds + KBUF0 + kbuf * KTILE + half * 32 * KROW + c32 * KROW + hi * 16;
    bf16x8 a[8];
#pragma unroll
    for (int kk = 0; kk < 8; ++kk) a[kk] = *(const LAS bf16x8*)(kb + 32 * kk);
#pragma unroll
    for (int kk = 0; kk < 8; ++kk) p = FA_MFMA(a[kk], qf[kk], p);
    FA_PIPE_8();
}
__device__ __forceinline__ void pv_half(f32x16 (&o)[4], const LAS unsigned char* lds, int vbuf, int half, const bf16x8 (&pa)[2], int c32, int hi) {
    const LAS unsigned char* vb = lds + VBUF0 + vbuf * VTILE + c32 * VROW + hi * 16 + half * 64;
    bf16x8 a[8];
#pragma unroll
    for (int s2 = 0; s2 < 2; ++s2)
#pragma unroll
        for (int db = 0; db < 4; ++db) a[4 * s2 + db] = *(const LAS bf16x8*)(vb + db * 32 * VROW + 32 * s2);
#pragma unroll
    for (int s2 = 0; s2 < 2; ++s2)
#pragma unroll
        for (int db = 0; db < 4; ++db) o[db] = FA_MFMA(a[4 * s2 + db], pa[s2], o[db]);
    FA_PIPE_8();
}
__device__ __forceinline__ void softmax_half(f32x16& p, int half, bool needrange, int lo, int hi_, int hi, bool rowoff, float& m, float& l, f32x16 (&o)[4], bf16x8 (&pa)[2]) {
    if (needrange) { const int lo4 = lo - 4 * hi - 32 * half, hi4 = hi_ - 4 * hi - 32 * half;
#pragma unroll
        for (int r = 0; r < 16; ++r) { const int c = (r & 3) + 8 * (r >> 2); if (c < lo4 || c > hi4) p[r] = -INFINITY; } }
    float mx = fmaxf(fmaxf(p[0], p[1]), p[2]);
#pragma unroll
    for (int r = 3; r < 15; r += 2) mx = fmaxf(fmaxf(mx, p[r]), p[r + 1]);
    mx = half_max(fmaxf(mx, p[15]));
    if (rowoff) mx = -INFINITY;
    if (!__all((mx - m) * C2 <= THR)) {
        const float mn = fmaxf(m, mx), alpha = __builtin_amdgcn_exp2f((m - mn) * C2); m = mn; l *= alpha;
#pragma unroll
        for (int db = 0; db < 4; ++db) o[db] = o[db] * alpha;
    }
    const float mnL = rowoff ? -INFINITY : -m * C2;
#pragma unroll
    for (int r = 0; r < 16; ++r) p[r] = __builtin_amdgcn_exp2f(fmaf(p[r], C2, mnL));
    const float ps = (((p[0] + p[1]) + (p[2] + p[3])) + ((p[4] + p[5]) + (p[6] + p[7]))) + (((p[8] + p[9]) + (p[10] + p[11])) + ((p[12] + p[13]) + (p[14] + p[15])));
    l += half_sum(ps);
    pa[0] = pack8r<0>(p); pa[1] = pack8r<8>(p);
}
__device__ __forceinline__ void flash_flags(const Msk& mk, int Tt, int tsh, int& lo, int& hi_, bool& rowoff) {
    const int T = Tt >> tsh;
    lo = mk.qlo - 64 * T; hi_ = mk.qhi - 64 * T;
    rowoff = !(hi_ >= 0 && lo <= 63);
    if (mk.sel) { const unsigned w = mk.sel[T >> 5]; rowoff = rowoff || (((w >> (T & 31)) & 1u) == 0u); }
}
__device__ __forceinline__ void flash_pass(LAS unsigned char* lds, int tid, int c32, int hi, int T0, int T1, const Src& src, const Msk& mk, const bf16x8 (&qf)[8],
                                           float& m, float& l, f32x16 (&o)[4]) {
    Stage st; f32x16 sA, sB;
    const int n = T1 - T0 + 1; const bool lateqk = __builtin_amdgcn_readfirstlane(tid >> 8) != 0;
    __syncthreads();
    {   Stage st1;
        stage_load(st, src, T0, tid, true); if (n > 1) stage_load_k(st1, src, T0 + 1, tid);
        stage_write(st, lds, 0, tid, true); if (n > 1) stage_write_k(st1, lds, 1, tid); }
    if (n > 2) stage_load_k(st, src, T0 + 2, tid);
    if (n > 1) stage_load_v(st, src, T0 + 1, tid);
    __syncthreads();
    int lo, hi_; bool rowoff; flash_flags(mk, T0, src.tsh, lo, hi_, rowoff);
    bool act = !__all(rowoff);
    if (act) qk_half(sA, lds, 0, 0, qf, c32, hi);
#pragma unroll 1
    for (int i = 0; i < n; ++i) {
        if (i > 0) __syncthreads();
        if (i + 2 < n) stage_write_k(st, lds, (i + 2) % 3, tid);
        if (i + 1 < n) stage_write_v(st, lds, (i + 1) & 1, tid);
        if (i + 3 < n) stage_load_k(st, src, T0 + i + 3, tid);
        if (i + 2 < n) stage_load_v(st, src, T0 + i + 2, tid);
        const bool needrange = __any(!rowoff && !(lo <= 0 && hi_ >= 63));
        bf16x8 pa[2];
        if (act) { if (!lateqk) qk_half(sB, lds, i % 3, 1, qf, c32, hi);
                   softmax_half(sA, 0, needrange, lo, hi_, hi, rowoff, m, l, o, pa); pv_half(o, lds, i & 1, 0, pa, c32, hi);
                   if (lateqk) qk_half(sB, lds, i % 3, 1, qf, c32, hi); }
        int lo2 = 0, hi2 = 0; bool off2 = true, act2 = false;
        if (i + 1 < n) { flash_flags(mk, T0 + i + 1, src.tsh, lo2, hi2, off2); act2 = !__all(off2); }
        if (act2 && !lateqk) qk_half(sA, lds, (i + 1) % 3, 0, qf, c32, hi);
        if (act) { softmax_half(sB, 1, needrange, lo, hi_, hi, rowoff, m, l, o, pa); pv_half(o, lds, i & 1, 1, pa, c32, hi); }
        if (act2 && lateqk) qk_half(sA, lds, (i + 1) % 3, 0, qf, c32, hi);
        lo = lo2; hi_ = hi2; rowoff = off2; act = act2;
    }
}

constexpr int ASLOT = KTILE + VTILE;
constexpr int ANSLOT = 4;
static_assert(ANSLOT * ASLOT <= MSK_OFF, "async ring must not reach the selection masks");
__device__ __forceinline__ void lds_signal(volatile LAS unsigned* w, int lane) {
    asm volatile("s_waitcnt lgkmcnt(0)" ::: "memory");
    if (lane == 0) (void)__hip_atomic_fetch_add((LAS unsigned*)w, 1u, __ATOMIC_RELAXED, __HIP_MEMORY_SCOPE_WORKGROUP);
}
__device__ __forceinline__ void lds_wait(volatile LAS unsigned* w, unsigned target) {
    unsigned spins = 0;
    while ((unsigned)__builtin_amdgcn_readfirstlane(*w) < target) { __builtin_amdgcn_s_sleep(1); if (++spins > (1u << 22)) break; }
    asm volatile("" ::: "memory");
}
__device__ __forceinline__ void flash_pass_async(LAS unsigned char* lds, int tid, int lane, int c32, int hi, int T0, int T1, const Src& src, const Msk& mk, const bf16x8 (&qf)[8],
                                                 float& m, float& l, f32x16 (&o)[4]) {
    volatile LAS unsigned* fill = (volatile LAS unsigned*)(lds + RING_BYTES + 2048); volatile LAS unsigned* done = fill + 8;
    const int n = T1 - T0 + 1;
    Stage st;
    __syncthreads();
    if (tid < 16) fill[tid] = 0u;
    stage_load(st, src, T0, tid, true);
    __syncthreads();
    stage_write_k_at(st, lds, tid); stage_write_v_at(st, lds + KTILE, tid); lds_signal(fill + 0, lane);
    if (n > 1) stage_load(st, src, T0 + 1, tid, true);
#pragma unroll 1
    for (int i = 0; i < n; ++i) {
        const int s0 = i % ANSLOT;
        if (i + 1 < n) { const int s1 = (i + 1) % ANSLOT;
            lds_wait(done + s1, 8u * (unsigned)((i + 1) / ANSLOT));
            stage_write_k_at(st, lds + s1 * ASLOT, tid); stage_write_v_at(st, lds + s1 * ASLOT + KTILE, tid); lds_signal(fill + s1, lane);
            if (i + 2 < n) stage_load(st, src, T0 + i + 2, tid, true); }
        int lo, hi_; bool rowoff; flash_flags(mk, T0 + i, src.tsh, lo, hi_, rowoff);
        if (!__all(rowoff)) {
            lds_wait(fill + s0, 8u * (unsigned)(i / ANSLOT + 1));
            f32x16 p0, p1; bf16x8 pa[4];
            qk_tile_at(p0, p1, lds + s0 * ASLOT, qf, c32, hi);
            if (__any(!rowoff && !(lo <= 0 && hi_ >= 63))) mask_range(p0, p1, lo, hi_, hi);
            softmax_step(p0, p1, rowoff, m, l, o, pa);
            pv_tile_at(o, lds + s0 * ASLOT + KTILE, pa, c32, hi);
        }
        lds_signal(done + s0, lane);
    }
}
}

__device__ __forceinline__ void nsa_item(LAS unsigned char* lds, int wave, int lane, int b, int g, int c, const bf16* Q, const bf16* QR, const bf16* KCB, const bf16* VCT,
                                         const bf16* KS, const bf16* KW, const bf16* VT, const float* GT, float* OACC, bf16* ATT) {
    using namespace fa;
    const int tid = wave * 64 + lane, c32 = lane & 31, hi = lane >> 5;
    const int tl = wave * 8 + (c32 >> 2), head = c32 & 3, t = c * 64 + tl, mrow = b * SEQ + t, hq = g * 4 + head, bg = b * 4 + g;
    LAS float* IMP = (LAS float*)(lds + IMP_OFF); LAS unsigned* MSK = (LAS unsigned*)(lds + MSK_OFF);
    bf16x8 qf[8]; f32x16 o[4]; float m, l; u32x4 pk[8];
#define NSA_PTRS() int mr_ = mrow, hq_ = hq; asm volatile("" : "+v"(mr_), "+v"(hq_)); const float* gp = GT + (size_t)(mr_ * 48 + hq_ * 3); float* oacc = OACC + (size_t)mr_ * 2048 + (unsigned)(hq_ * 128); (void)gp; (void)oacc
    {
        { int mr_ = mrow, hq_ = hq; asm volatile("" : "+v"(mr_), "+v"(hq_)); load_q(qf, Q + (size_t)mr_ * 2048 + (unsigned)(hq_ * 128), hi); }
        const int NTc = (4 * c + 3 + 63) >> 6;
        const int qhi = (t - 31) >> 4;
        const Src src{KCB + (size_t)bg * 512 * 128, 128, VCT + (size_t)bg * 128 * 512, 512, 0};
        m = -1e30f; l = 0.f;
        Stage st;
        __syncthreads();
        stage_load(st, src, 0, tid, false);
#pragma unroll 1
        for (int T = 0; T < NTc; ++T) {
            const int buf = T & 1;
            stage_write(st, lds, buf, tid, false);
            __syncthreads();
            if (T + 1 < NTc) stage_load(st, src, T + 1, tid, false);
            f32x16 p0, p1;
            qk_tile(p0, p1, lds, buf, qf, c32, hi);
            mask_range(p0, p1, 0, qhi - 64 * T, hi);
            float mx = p0[0];
#pragma unroll
            for (int r = 1; r < 16; ++r) mx = fmaxf(mx, p0[r]);
#pragma unroll
            for (int r = 0; r < 16; ++r) mx = fmaxf(mx, p1[r]);
            mx = half_max(mx);
            const float mn = fmaxf(m, mx), alpha = __builtin_amdgcn_exp2f((m - mn) * C2), mnL = -mn * C2; m = mn;
            float ps = 0.f;
#pragma unroll
            for (int r = 0; r < 16; ++r) ps += __builtin_amdgcn_exp2f(fmaf(p0[r], C2, mnL)) + __builtin_amdgcn_exp2f(fmaf(p1[r], C2, mnL));
            l = l * alpha + half_sum(ps);
        }
        const float inv = l > 0.f ? 1.0f / l : 0.f, mnL = -m * C2;
#pragma unroll
        for (int db = 0; db < 4; ++db)
#pragma unroll
            for (int r = 0; r < 16; ++r) o[db][r] = 0.f;
        float carry = 0.f;
        __syncthreads();
        stage_load(st, src, 0, tid, true);
#pragma unroll 1
        for (int T = 0; T < NTc; ++T) {
            const int buf = T & 1;
            stage_write(st, lds, buf, tid, true);
            __syncthreads();
            if (T + 1 < NTc) stage_load(st, src, T + 1, tid, true);
            f32x16 p0, p1; bf16x8 pa[4];
            qk_tile(p0, p1, lds, buf, qf, c32, hi);
            mask_range(p0, p1, 0, qhi - 64 * T, hi);
#pragma unroll
            for (int r = 0; r < 16; ++r) { p0[r] = __builtin_amdgcn_exp2f(fmaf(p0[r], C2, mnL)) * inv; p1[r] = __builtin_amdgcn_exp2f(fmaf(p1[r], C2, mnL)) * inv; }
#pragma unroll
            for (int hf = 0; hf < 2; ++hf) {
                float qs[4], flo[4], fhi[4];
#pragma unroll
                for (int q4 = 0; q4 < 4; ++q4) {
                    const float e0 = hf ? p1[4 * q4] : p0[4 * q4], e1 = hf ? p1[4 * q4 + 1] : p0[4 * q4 + 1], e2 = hf ? p1[4 * q4 + 2] : p0[4 * q4 + 2], e3 = hf ? p1[4 * q4 + 3] : p0[4 * q4 + 3];
                    qs[q4] = (e0 + e1) + (e2 + e3);
                    auto rr = __builtin_amdgcn_permlane32_swap(__float_as_uint(e3), __float_as_uint(e3), false, false);
                    flo[q4] = __uint_as_float(rr[0]); fhi[q4] = __uint_as_float(rr[1]);
                }
#pragma unroll
                for (int q4 = 0; q4 < 4; ++q4) {
                    const float cin = hi ? flo[q4] : (q4 == 0 ? carry : fhi[q4 == 0 ? 0 : q4 - 1]);
                    float v = qs[q4] + cin; v += __shfl_xor(v, 1); v += __shfl_xor(v, 2);
                    if (head == 0) IMP[tl * 128 + 16 * T + 8 * hf + 2 * q4 + hi] = v;
                }
                carry = fhi[3];
            }
            pa[0] = pack8r<0>(p0); pa[1] = pack8r<8>(p0); pa[2] = pack8r<0>(p1); pa[3] = pack8r<8>(p1);
            pv_tile(o, lds, buf, pa, c32, hi);
        }
        NSA_PTRS();
        const float g0 = gp[0];
#pragma unroll
        for (int db = 0; db < 4; ++db)
#pragma unroll
            for (int q4 = 0; q4 < 4; ++q4) { pk[2 * db + (q4 >> 1)][2 * (q4 & 1)] = pk2(o[db][4 * q4] * g0, o[db][4 * q4 + 1] * g0); pk[2 * db + (q4 >> 1)][2 * (q4 & 1) + 1] = pk2(o[db][4 * q4 + 2] * g0, o[db][4 * q4 + 3] * g0); }
    }
    LDS_WAIT();
#ifndef REP_TOPK
#define REP_TOPK 1
#endif
#pragma unroll 1
    for (int rep_ = 0; rep_ < fresh_s(REP_TOPK); ++rep_)
#pragma unroll 1
    for (int tk = 0; tk < 8; ++tk) {
        LAS float* row = IMP + (wave * 8 + tk) * 128;
        const int j0 = lane, j1 = lane + 64;
        const float v0 = row[j0], v1 = row[j1];
        const float val0 = j0 > c ? -INFINITY : ((j0 == 0 || j0 == c || j0 == c - 1) ? 3.0e38f : v0);
        const float val1 = j1 > c ? -INFINITY : ((j1 == c || j1 == c - 1) ? 3.0e38f : v1);
        LDS_WAIT();
        row[j0] = val0; row[j1] = val1;
        LDS_WAIT();
        int cnt0 = 0, cnt1 = 0;
#pragma unroll 4
        for (int i4 = 0; i4 <= (c >> 2); ++i4) {
            const f32x4 x = *(const LAS f32x4*)(row + 4 * i4);
#pragma unroll
            for (int e = 0; e < 4; ++e) { const int i = 4 * i4 + e; cnt0 += (x[e] > val0 || (x[e] == val0 && i < j0)) ? 1 : 0; cnt1 += (x[e] > val1 || (x[e] == val1 && i < j1)) ? 1 : 0; } }
        const unsigned long long m0 = __ballot(j0 <= c && cnt0 < 16), m1 = __ballot(j1 <= c && cnt1 < 16);
        if (lane == 0) { LAS unsigned* mp = MSK + (wave * 8 + tk) * 4; mp[0] = (unsigned)m0; mp[1] = (unsigned)(m0 >> 32); mp[2] = (unsigned)m1; mp[3] = (unsigned)(m1 >> 32); }
    }
    LDS_WAIT();
    { int mr_ = mrow, hq_ = hq; asm volatile("" : "+v"(mr_), "+v"(hq_)); load_q(qf, QR + (size_t)mr_ * 2048 + (unsigned)(hq_ * 128), hi); }
    {
        Msk mk; mk.qlo = 0; mk.qhi = t; mk.sel = MSK + tl * 4;
        #ifdef PROBE_SEL2
        const Src src{KS + (size_t)b * SEQ * 512 + g * 128, 512, VT + (size_t)(g * 128) * LDV + (size_t)b * SEQ, LDV, 1};
#else
        const Src src{KS + (size_t)b * SEQ * 512 + g * 128, 512, VT + (size_t)(g * 128) * LDV + (size_t)b * SEQ, LDV, 0};
#endif
#ifndef REP_SEL
#define REP_SEL 1
#endif
        m = -1e30f; l = 0.f;
#pragma unroll
        for (int db = 0; db < 4; ++db)
#pragma unroll
            for (int r = 0; r < 16; ++r) o[db][r] = 0.f;
#ifdef PROBE_SEL2
        flash_pass(lds, tid, c32, hi, 0, 2 * c + 1, src, mk, qf, m, l, o);
#else
        flash_pass_async(lds, tid, lane, c32, hi, 0, c, src, mk, qf, m, l, o);
#endif
        NSA_PTRS();
        const float sc = gp[1] / l;
#pragma unroll
        for (int db = 0; db < 4; ++db)
#pragma unroll
            for (int q4 = 0; q4 < 4; ++q4) { const unsigned w0 = pk[2 * db + (q4 >> 1)][2 * (q4 & 1)], w1 = pk[2 * db + (q4 >> 1)][2 * (q4 & 1) + 1];
                pk[2 * db + (q4 >> 1)][2 * (q4 & 1)] = pk2(lo_bf(w0) + o[db][4 * q4] * sc, hi_bf(w0) + o[db][4 * q4 + 1] * sc);
                pk[2 * db + (q4 >> 1)][2 * (q4 & 1) + 1] = pk2(lo_bf(w1) + o[db][4 * q4 + 2] * sc, hi_bf(w1) + o[db][4 * q4 + 3] * sc); }
    }
    {
        Msk mk; mk.qlo = t - 511; mk.qhi = t; mk.sel = nullptr;
        const Src src{KW + (size_t)b * SEQ * 512 + g * 128, 512, VT + (size_t)(512 + g * 128) * LDV + (size_t)b * SEQ, LDV, 0};
        m = -1e30f; l = 0.f;
#pragma unroll
        for (int db = 0; db < 4; ++db)
#pragma unroll
            for (int r = 0; r < 16; ++r) o[db][r] = 0.f;
        flash_pass(lds, tid, c32, hi, c >= 8 ? c - 8 : 0, c, src, mk, qf, m, l, o);
        NSA_PTRS();
        const float sc = gp[2] / l;
        bf16* arow = ATT + (size_t)mr_ * 2048 + (unsigned)(hq_ * 128);
#pragma unroll
        for (int db = 0; db < 4; ++db)
#pragma unroll
            for (int qp = 0; qp < 2; ++qp) {
                unsigned f[2][2];
#pragma unroll
                for (int e = 0; e < 2; ++e) { const int q4 = 2 * qp + e; const unsigned w0 = pk[2 * db + qp][2 * e], w1 = pk[2 * db + qp][2 * e + 1];
                    f[e][0] = pk2(lo_bf(w0) + o[db][4 * q4] * sc, hi_bf(w0) + o[db][4 * q4 + 1] * sc); f[e][1] = pk2(lo_bf(w1) + o[db][4 * q4 + 2] * sc, hi_bf(w1) + o[db][4 * q4 + 3] * sc); }
                auto r0 = __builtin_amdgcn_permlane32_swap(f[0][0], f[1][0], false, false); auto r1 = __builtin_amdgcn_permlane32_swap(f[0][1], f[1][1], false, false);
                u32x4 w; w.x = r0[0]; w.y = r1[0]; w.z = r0[1]; w.w = r1[1];
                *(u32x4*)(arow + 32 * db + 16 * qp + 8 * hi) = w; }
    }
#undef NSA_PTRS
}

__device__ __forceinline__ void dil_item(LAS unsigned char* lds, int wave, int lane, int p, int sq, int h, int qb, const bf16* QK, const bf16* VT, bf16* OB, float* ML, bf16* ATT) {
    using namespace fa;
    const int tid = wave * 64 + lane, c32 = lane & 31, hi = lane >> 5, dsh = 2 * p, L = SEQ >> dsh;
    const int b = sq >> dsh, r = sq & ((1 << dsh) - 1), q = qb * 256 + wave * 32 + c32, mrow = b * SEQ + (q << dsh) + r;
    const size_t seqbase = (size_t)sq * L;
    bf16x8 qf[8]; f32x16 o[4]; float m = -1e30f, l = 0.f;
    load_q(qf, QK + (seqbase + q) * 4096 + h * 128, hi);
#pragma unroll
    for (int db = 0; db < 4; ++db)
#pragma unroll
        for (int rr = 0; rr < 16; ++rr) o[db][rr] = 0.f;
    Msk mk; mk.qlo = q - 128; mk.qhi = q; mk.sel = nullptr;
    const Src src{QK + seqbase * 4096 + 2048 + h * 128, 4096, VT + (size_t)(h * 128) * LDV + seqbase, LDV, 0};
    flash_pass(lds, tid, c32, hi, qb * 4 >= 2 ? qb * 4 - 2 : 0, qb * 4 + 3, src, mk, qf, m, l, o);
    int mr_ = mrow; asm volatile("" : "+v"(mr_));
    float sc2 = 1.0f / l, u0 = 0.f, u1 = 0.f;
    const bf16* ob0 = OB + (size_t)mr_ * 2048 + h * 128; const bf16* ob1 = ob0 + (size_t)M * 2048;
    if (p == 2) {
        const f32x2 ml0 = *(const f32x2*)(ML + ((size_t)mr_ * 16 + h) * 2), ml1 = *(const f32x2*)(ML + (size_t)M * 32 + ((size_t)mr_ * 16 + h) * 2);
        const float Mx = fmaxf(fmaxf(ml0[0], ml1[0]), m);
        u0 = ml0[1] * __builtin_amdgcn_exp2f((ml0[0] - Mx) * C2); u1 = ml1[1] * __builtin_amdgcn_exp2f((ml1[0] - Mx) * C2);
        const float e2 = __builtin_amdgcn_exp2f((m - Mx) * C2), iw = 1.0f / (u0 + u1 + l * e2);
        sc2 = e2 * iw; u0 *= iw; u1 *= iw;
    }
    bf16* orow = (p == 2 ? ATT : OB + (size_t)p * M * 2048) + (size_t)mr_ * 2048 + h * 128;
#pragma unroll
    for (int db = 0; db < 4; ++db)
#pragma unroll
        for (int qp = 0; qp < 2; ++qp) {
            f32x4 v[2];
#pragma unroll
            for (int e = 0; e < 2; ++e) { const int q4 = 2 * qp + e; v[e] = (f32x4){o[db][4 * q4] * sc2, o[db][4 * q4 + 1] * sc2, o[db][4 * q4 + 2] * sc2, o[db][4 * q4 + 3] * sc2}; }
            if (p == 2) {
                const u32x4 w0 = *(const u32x4*)(ob0 + 32 * db + 16 * qp + 8 * hi), w1 = *(const u32x4*)(ob1 + 32 * db + 16 * qp + 8 * hi);
                auto a0 = __builtin_amdgcn_permlane32_swap(w0.x, w0.z, false, false); auto a1 = __builtin_amdgcn_permlane32_swap(w0.y, w0.w, false, false);
                auto b0 = __builtin_amdgcn_permlane32_swap(w1.x, w1.z, false, false); auto b1 = __builtin_amdgcn_permlane32_swap(w1.y, w1.w, false, false);
#pragma unroll
                for (int e = 0; e < 2; ++e) {
                    v[e][0] += u0 * lo_bf(a0[e]) + u1 * lo_bf(b0[e]); v[e][1] += u0 * hi_bf(a0[e]) + u1 * hi_bf(b0[e]);
                    v[e][2] += u0 * lo_bf(a1[e]) + u1 * lo_bf(b1[e]); v[e][3] += u0 * hi_bf(a1[e]) + u1 * hi_bf(b1[e]); }
            }
            unsigned f[2][2];
#pragma unroll
            for (int e = 0; e < 2; ++e) { f[e][0] = pk2(v[e][0], v[e][1]); f[e][1] = pk2(v[e][2], v[e][3]); }
            auto r0 = __builtin_amdgcn_permlane32_swap(f[0][0], f[1][0], false, false); auto r1 = __builtin_amdgcn_permlane32_swap(f[0][1], f[1][1], false, false);
            u32x4 w; w.x = r0[0]; w.y = r1[0]; w.z = r0[1]; w.w = r1[1];
            *(u32x4*)(orow + 32 * db + 16 * qp + 8 * hi) = w; }
    if (p < 2 && hi == 0) *(f32x2*)(ML + (size_t)p * M * 32 + ((size_t)mr_ * 16 + h) * 2) = (f32x2){m, l};
}

__device__ __forceinline__ void modulate_row(const float* x32, const bf16* x16, const float* gain, const float* shift, const float* scale, bf16* orow, float* frow, int lane) {
    f32x4 v[8]; float ss = 0.f;
    if (x32) {
#pragma unroll
        for (int j = 0; j < 8; ++j) v[j] = *(const f32x4*)(x32 + 4 * lane + 256 * j);
    } else {
        u32x2 w[8];
#pragma unroll
        for (int j = 0; j < 8; ++j) w[j] = *(const u32x2*)(x16 + 4 * lane + 256 * j);
#pragma unroll
        for (int j = 0; j < 8; ++j) v[j] = (f32x4){lo_bf(w[j].x), hi_bf(w[j].x), lo_bf(w[j].y), hi_bf(w[j].y)};
    }
#pragma unroll
    for (int j = 0; j < 8; ++j) ss += (v[j][0] * v[j][0] + v[j][1] * v[j][1]) + (v[j][2] * v[j][2] + v[j][3] * v[j][3]);
    const float rinv = rsqrtf(wave_sum(ss) * (1.0f / D) + NORM_EPS);
#pragma unroll
    for (int j = 0; j < 8; ++j) {
        const int col = 4 * lane + 256 * j;
        const f32x4 gn = *(const f32x4*)(gain + col);
        f32x4 r = v[j] * rinv * gn;
        if (shift) { const f32x4 sh = *(const f32x4*)(shift + col), sc = *(const f32x4*)(scale + col); r = r * (1.0f + sc) + sh;
            u32x2 w; w.x = pk2(r[0], r[1]); w.y = pk2(r[2], r[3]); *(u32x2*)(orow + col) = w; }
        else *(f32x4*)(frow + col) = r;
    }
}

__device__ __forceinline__ unsigned char* wsp_(unsigned char* ws, size_t off) { asm volatile("" : "+s"(off)); return ws + off; }
#define FRESH_IDS() const int wave = fresh_s(wave_s), lane = lane_id_asm(), tid = wave * 64 + lane; (void)tid; \
    const int Gf_ = fresh_s(G), bx_ = fresh_s((int)blockIdx.x); const int gw = bx_ * NWAVES + wave, NGW = Gf_ * NWAVES, gtid = bx_ * NTHREADS + tid, NGT = Gf_ * NTHREADS; \
    LAS float* wl = (LAS float*)(lds + wave * 16384); (void)lane; (void)gw; (void)NGW; (void)gtid; (void)NGT; (void)wl
__global__ void __launch_bounds__(NTHREADS, 2) mega_fwd(Params P) {
    extern __shared__ __attribute__((aligned(16))) unsigned char lds_raw[];
    LAS unsigned char* lds = (LAS unsigned char*)lds_raw;
    volatile LAS unsigned* MISC = (volatile LAS unsigned*)(lds + MISC_OFF);
    const int G = gridDim.x;
    unsigned char* ws = P.ws;
    for (int u = threadIdx.x; u < (LDS_BYTES - RING_BYTES) / 4; u += NTHREADS) ((LAS unsigned*)(lds + RING_BYTES))[u] = 0u;
    __syncthreads();
    const int wave_s = __builtin_amdgcn_readfirstlane(threadIdx.x >> 6);
    XcdBarrier bar = xcd_barrier_post((unsigned*)(ws + WS_CTL) + 4096, MISC + 8); bar.wave = wave_s;
#define GRID_BAR() xcd_barrier(bar)
#define WSP(T, off) ((T*)wsp_(ws, (off)))
#define CONVERT_JOBS(j0, j1) do { _Pragma("unroll 1") for (int jid = (j0); jid < (j1); ++jid) { const Job J = get_job(P, jid); const int nitems = (J.K / 64) * (J.n_rows / 32); \
        for (int it = gw; it < nitems; it += NGW) conv_item(J, it, wl, lane); } } while (0)

    {
        FRESH_IDS();
        float* MODP = WSP(float, WS_MODP); float* COS = WSP(float, WS_COS); float* SIN = WSP(float, WS_SIN); float* BPEP = WSP(float, WS_BPEP); float* LSP = WSP(float, WS_LSP);
        const float* cv = inp(P, IN_C);
        for (int task = gw; task < 4 * 48 * 8; task += NGW) {
            const int kc = task & 7, cg = (task >> 3) % 48, l = task / (8 * 48);
            const float* w = inp(P, layer_base(l)) + (size_t)cg * 256 + lane * 4;
            f32x4 a0 = {0.f, 0.f, 0.f, 0.f}, a1 = {0.f, 0.f, 0.f, 0.f};
#pragma unroll 8
            for (int k = kc * 256; k < kc * 256 + 256; ++k) {
                const float c0 = cv[k], c1 = cv[2048 + k];
                const float s0 = c0 / (1.0f + __expf(-c0)), s1 = c1 / (1.0f + __expf(-c1));
                const f32x4 wv = __builtin_nontemporal_load((const f32x4*)(w + (size_t)k * 12288));
                a0 += s0 * wv; a1 += s1 * wv;
            }
            *(f32x4*)(MODP + ((size_t)((kc * 4 + l) * 2 + 0)) * 12288 + cg * 256 + lane * 4) = a0;
            *(f32x4*)(MODP + ((size_t)((kc * 4 + l) * 2 + 1)) * 12288 + cg * 256 + lane * 4) = a1;
        }
        for (int i = gtid; i < SEQ * 64; i += NGT) {
            const int t = i >> 6, f = i & 63;
            const double invf = exp2(-(double)f * (13.287712379549449 / 64.0));
            const double ang = (double)t * invf;
            const double n = rint(ang * 0.15915494309189535);
            const double r = (ang - n * 6.283185307179586) - n * 2.4492935982947064e-16;
            COS[i] = (float)cos(r); SIN[i] = (float)sin(r);
        }
        for (int task = gw; task < 2 * 2 * 2 * 16; task += NGW) {
            const int kc = task & 15, cg = (task >> 4) & 1, kv = (task >> 5) & 1, slot = task >> 6;
            const int bi = slot == 0 ? 2 : 34;
            const float* pe = inp(P, bi + 4) + kv * 4096; const float* w = inp(P, bi + 5) + (size_t)kv * 4096 * 512 + cg * 256 + lane * 4;
            f32x4 a = {0.f, 0.f, 0.f, 0.f};
#pragma unroll 8
            for (int k = kc * 256; k < kc * 256 + 256; ++k) a += pe[k] * *(const f32x4*)(w + (size_t)k * 512);
            *(f32x4*)(BPEP + (size_t)((kc * 2 + slot) * 2 + kv) * 512 + cg * 256 + lane * 4) = a;
        }
        { const float* lamp = inp(P, 21 + 8);
          for (int i = gtid; i < DRNN; i += NGT) { const double lam = (double)lamp[i]; LSP[i] = (float)(-8.0 * log1p(exp(-lam))); } }
    }
    GRID_BAR();
    {
        FRESH_IDS();
        CONVERT_JOBS(0, NJOBS_FIRST);
        {
            const float* wg = inp(P, 21 + 6); bf16* WG = WSP(bf16, WS_W) + WE_RG_WG;
            for (long i = gtid; i < (long)5376 * (DRNN / 8); i += NGT) {
                const int row = (int)(i / (DRNN / 8)), k8 = (int)(i % (DRNN / 8)) * 8;
                const int gate = (row >> 7) & 1, ch = (row >> 8) * 128 + (row & 127), nb = ch / 168, dd = ch % 168;
                float v[8];
#pragma unroll
                for (int e = 0; e < 8; ++e) { const int k = k8 + e; v[e] = (k / 168 == nb) ? wg[((size_t)(gate * 16 + nb) * 168 + (k % 168)) * 168 + dd] : 0.f; }
                u32x4 o; o.x = pk2(v[0], v[1]); o.y = pk2(v[2], v[3]); o.z = pk2(v[4], v[5]); o.w = pk2(v[6], v[7]);
                *(u32x4*)(WG + (size_t)row * DRNN + k8) = o;
            }
        }
        {   const float* MODP = WSP(float, WS_MODP); float* MOD = WSP(float, WS_MOD);
#pragma unroll 1
            for (int l = 0; l < 4; ++l) { const float* bias = inp(P, layer_base(l) + 1);
                for (int i = gtid; i < 2 * 12288; i += NGT) {
                    const int col = i % 12288, lb = l * 2 + i / 12288;
                    float a = bias[col];
#pragma unroll
                    for (int kc = 0; kc < 8; ++kc) a += MODP[(size_t)(kc * 8 + lb) * 12288 + col];
                    MOD[(size_t)lb * 12288 + col] = a;
                } }
            const float* BPEP = WSP(float, WS_BPEP); float* BPE = WSP(float, WS_BPE);
            for (int i = gtid; i < 2 * 2 * 512; i += NGT) { float a = 0.f;
#pragma unroll
                for (int kc = 0; kc < 16; ++kc) a += BPEP[(size_t)kc * 2048 + i];
                BPE[i] = a; }
        }
    }
    GRID_BAR();

#pragma unroll 1
    for (int li = 0; li < 4; ++li) {
        const int kind = li % 3, bi = layer_base(li);
        {   FRESH_IDS();
            const float* x32 = li == 0 ? inp(P, IN_X) : (const float*)nullptr; const bf16* XR = WSP(bf16, WS_XR); const float* gain = inp(P, bi + 2);
            const float* modl = WSP(float, WS_MOD) + (size_t)li * 2 * 12288; bf16* HN = WSP(bf16, WS_HN);
            for (int r = gw; r < M; r += NGW) { const int b = r >> 13;
                modulate_row(x32 ? x32 + (size_t)r * D : (const float*)nullptr, XR + (size_t)r * D, gain, modl + (size_t)b * 12288, modl + (size_t)b * 12288 + 2048, HN + (size_t)r * D, nullptr, lane); } }
        GRID_BAR();
        if (kind == 0) {
            const int slot = li == 0 ? 0 : 1;
            {   bf16* wbase = WSP(bf16, WS_W) + (size_t)slot * WE_NSA_SZ;
                pg8::Gemm g{WSP(bf16, WS_HN), wbase + WE_NSA_WIN, M, NSA_N1, D}; pg8::StaticOrder S; S.init(M, NSA_N1, fresh_s(G), fresh_s((int)blockIdx.x));
                EpiNsaIn E{WSP(bf16, NS_Q), WSP(bf16, NS_QR), WSP(bf16, NS_PK), WSP(bf16, NS_PV), WSP(bf16, NS_KS), WSP(bf16, NS_KW), WSP(float, NS_GT), WSP(float, WS_COS), WSP(float, WS_SIN)};
                pg8::gemm_phase<EpiNsaIn, pg8::StaticOrder, true, true>(lds, g, S, E, wave_s); }
            {
                bf16* wbase = WSP(bf16, WS_W) + (size_t)slot * WE_NSA_SZ;
                pg8::Gemm g{wbase + WE_NSA_WIN + (size_t)4352 * D, WSP(bf16, WS_HN), 1024, M, D}; pg8::StaticOrder S; S.init(1024, M, fresh_s(G), fresh_s((int)blockIdx.x));
                EpiBf16<0> E{WSP(bf16, NS_VT), LDV, 0};
                pg8::gemm_phase<EpiBf16<0>, pg8::StaticOrder, true, true>(lds, g, S, E, wave_s); }
            GRID_BAR();
#pragma unroll 1
            for (int kv = 0; kv < 2; ++kv) {
                bf16* wbase = WSP(bf16, WS_W) + (size_t)slot * WE_NSA_SZ;
                pg8::Gemm g{kv ? WSP(bf16, NS_PV) : WSP(bf16, NS_PK), wbase + WE_NSA_W1 + (size_t)kv * 1024 * 2048, 4096, 1024, 2048}; pg8::StaticOrder S; S.init(4096, 1024, fresh_s(G), fresh_s((int)((blockIdx.x + 128 * kv) % G)));
                EpiF32 E{WSP(float, NS_HC) + (size_t)kv * 4096 * 1024, 1024};
                pg8::gemm_phase<EpiF32, pg8::StaticOrder, true, true>(lds, g, S, E, wave_s); }
            {
                bf16* wbase = WSP(bf16, WS_W) + (size_t)slot * WE_NSA_SZ;
                pg8::Gemm g{WSP(bf16, WS_HN), wbase + WE_NSA_WIN + (size_t)4096 * D, M, 256, D}; pg8::StaticOrder S; S.init(M, 256, fresh_s(G), fresh_s((int)((blockIdx.x + 192) % G)));
                EpiGates E{WSP(float, NS_GT)};
                pg8::gemm_phase<EpiGates, pg8::StaticOrder, true, true>(lds, g, S, E, wave_s); }
            GRID_BAR();
            {
                FRESH_IDS();
                const float* w2 = inp(P, bi + 6); const float* bpe = WSP(float, WS_BPE) + slot * 1024; const float* HCb = WSP(float, NS_HC); bf16* KCb = WSP(bf16, NS_KC); bf16* VCt = WSP(bf16, NS_VCT);
                for (int task = gw; task < 2 * 8 * 128; task += NGW) {
                    const int n0 = (task & 127) * 4, bg = (task >> 7) & 7, kv = task >> 10;
                    const float* hrow = HCb + ((size_t)kv * 4096 + bg * 512 + n0) * 1024;
#pragma unroll
                    for (int q = 0; q < 2; ++q) { const int c = lane * 8 + q * 4; const f32x4 pb = *(const f32x4*)(bpe + kv * 512 + c);
                        f32x4 hv[4];
#pragma unroll
                        for (int r = 0; r < 4; ++r) { const f32x4 a = *(const f32x4*)(hrow + (size_t)r * 1024 + c), bb = n0 + r < 511 ? *(const f32x4*)(hrow + (size_t)(r + 1) * 1024 + 512 + c) : (f32x4){0.f, 0.f, 0.f, 0.f};
#pragma unroll
                            for (int e = 0; e < 4; ++e) hv[r][e] = n0 + r < 511 ? gelu_tanh(a[e] + bb[e] + pb[e]) : 0.f; }
#pragma unroll
                        for (int e = 0; e < 4; ++e) *(LAS f32x4*)(wl + (c + e) * 4) = (f32x4){hv[0][e], hv[1][e], hv[2][e], hv[3][e]}; }
                    LDS_WAIT();
                    const float* wp = w2 + (size_t)kv * 512 * 128 + 2 * lane; f32x4 o0 = {0.f, 0.f, 0.f, 0.f}, o1 = {0.f, 0.f, 0.f, 0.f};
#pragma unroll 16
                    for (int c = 0; c < 512; ++c) { const f32x2 wv = *(const f32x2*)(wp + (size_t)c * 128); const f32x4 hv = *(const LAS f32x4*)(wl + c * 4); o0 += hv * wv[0]; o1 += hv * wv[1]; }
                    const int d0 = 2 * lane, d1 = 2 * lane + 1;
                    if (kv == 0) {
#pragma unroll
                        for (int r = 0; r < 4; ++r) { bf16* dst = KCb + ((size_t)bg * 512 + n0 + r) * 128; dst[(d0 & 63) * 2 + (d0 >> 6)] = (bf16)(pk2(o0[r], 0.f) & 0xffffu); dst[(d1 & 63) * 2 + (d1 >> 6)] = (bf16)(pk2(o1[r], 0.f) & 0xffffu); } }
                    else { bf16* dst = VCt + (size_t)bg * 128 * 512 + n0;
                        u32x2 w0; w0.x = pk2(o0[0], o0[1]); w0.y = pk2(o0[2], o0[3]); *(u32x2*)(dst + (size_t)d0 * 512) = w0;
                        u32x2 w1; w1.x = pk2(o1[0], o1[1]); w1.y = pk2(o1[2], o1[3]); *(u32x2*)(dst + (size_t)d1 * 512) = w1; }
                    LDS_WAIT();
                }
            }
            GRID_BAR();
#ifndef REP_NSA
#define REP_NSA 1
#endif
#pragma unroll 1
            for (int rep = 0; rep < fresh_s(REP_NSA); ++rep)
            {   FRESH_IDS();
#pragma unroll 1
                for (int pi = bx_; pi < 512; pi += Gf_) {
                    const int bg = Gf_ == 256 ? (pi & 7) : (pi >> 6), cc = Gf_ == 256 ? ((pi & 255) >> 3) + 32 * (pi >> 8) : (pi & 63);
#pragma unroll 1
                    for (int e = 0; e < 2; ++e) {
                        if (li == 0 && (Gf_ == 256 ? (pi >> 8) * 2 + e == ((bx_ >> 3) & 3) : (pi == bx_ && e == 0))) { __syncthreads(); { FRESH_IDS(); CONVERT_JOBS(NJOBS_FIRST, NJOBS); } }
                        nsa_item(lds, wave, lane, bg >> 2, bg & 3, e ? cc : 127 - cc, WSP(bf16, NS_Q), WSP(bf16, NS_QR), WSP(bf16, NS_KC), WSP(bf16, NS_VCT), WSP(bf16, NS_KS), WSP(bf16, NS_KW),
                                 WSP(bf16, NS_VT), WSP(float, NS_GT), P.out, WSP(bf16, WS_ATT));
                    }
                }
                __syncthreads();
                if (li == 0 && bx_ >= 512) { FRESH_IDS(); CONVERT_JOBS(NJOBS_FIRST, NJOBS); }
            }
            GRID_BAR();
        } else if (kind == 1) {
#pragma unroll 1
            for (int st = 0; st < 4; ++st) {
                if (st >= 1) {
                    const int p = st - 1;
                    FRESH_IDS();
                    const int dsh = 2 * p, nqb = (SEQ >> dsh) >> 8;
#pragma unroll 1
                    for (int it = bx_; it < 1024; it += Gf_) {
                        const int qb = it % nqb, h = (it / nqb) & 15, sq = it / (nqb * 16);
                        dil_item(lds, wave, lane, p, sq, h, qb, WSP(bf16, DL_QK) + (size_t)p * M * 4096, (const bf16*)(WSP(unsigned char, DL_VT) + (size_t)p * DL_VT_STRIDE), (bf16*)P.out, WSP(float, DL_ML), WSP(bf16, WS_ATT));
                    }
                    __syncthreads();
                }
                if (st < 3) {
                    const int p = st;
                    {   pg8::Gemm g{WSP(bf16, WS_HN), WSP(bf16, WS_W) + WE_DIL + (size_t)p * 6144 * D, M, 4096, D, 2 * p, 0}; pg8::StaticOrder S; S.init(M, 4096, fresh_s(G), fresh_s((int)blockIdx.x));
                        EpiDilQK E{WSP(bf16, DL_QK) + (size_t)p * M * 4096, WSP(float, WS_COS), WSP(float, WS_SIN), 2 * p};
                        pg8::gemm_phase<EpiDilQK, pg8::StaticOrder, true, true>(lds, g, S, E, wave_s); }
                    {   pg8::Gemm g{WSP(bf16, WS_W) + WE_DIL + ((size_t)p * 6144 + 4096) * D, WSP(bf16, WS_HN), 2048, M, D, 0, 2 * p}; pg8::StaticOrder S; S.init(2048, M, fresh_s(G), fresh_s((int)blockIdx.x));
                        EpiBf16<0> E{(bf16*)(WSP(unsigned char, DL_VT) + (size_t)p * DL_VT_STRIDE), LDV, 0};
                        pg8::gemm_phase<EpiBf16<0>, pg8::StaticOrder, true, true>(lds, g, S, E, wave_s); }
                }
                GRID_BAR();
            }
        } else {
            {   pg8::Gemm g{WSP(bf16, WS_HN), WSP(bf16, WS_W) + WE_RG, M, RG_N, D}; pg8::StaticOrder S; S.init(M, RG_N, fresh_s(G), fresh_s((int)blockIdx.x));
                EpiBf16<2> E{WSP(bf16, RG_YX), RG_N, 11};
                pg8::gemm_phase<EpiBf16<2>, pg8::StaticOrder, true, true>(lds, g, S, E, wave_s); }
            GRID_BAR();
            {
                FRESH_IDS();
                const float* cw = inp(P, bi + 4); const float* cb = inp(P, bi + 5); const bf16* YX = WSP(bf16, RG_YX); bf16* Xc = WSP(bf16, RG_X);
                for (long i = gtid; i < (long)(M / 4) * (DRNN / 8); i += NGT) {
                    const int r4 = (int)(i / (DRNN / 8)) * 4, c8 = (int)(i % (DRNN / 8)) * 8, t0 = r4 & (SEQ - 1);
                    u32x4 xr[7];
#pragma unroll
                    for (int j = 0; j < 7; ++j) xr[j] = (t0 - 3 + j >= 0) ? *(const u32x4*)(YX + (size_t)(r4 - 3 + j) * RG_N + RG_XOFF + c8) : (u32x4){0u, 0u, 0u, 0u};
                    f32x4 w0[4], w1[4];
#pragma unroll
                    for (int j = 0; j < 4; ++j) { w0[j] = *(const f32x4*)(cw + j * DRNN + c8); w1[j] = *(const f32x4*)(cw + j * DRNN + c8 + 4); }
                    const f32x4 b0 = *(const f32x4*)(cb + c8), b1 = *(const f32x4*)(cb + c8 + 4);
#pragma unroll
                    for (int rr = 0; rr < 4; ++rr) {
                        f32x4 a0 = b0, a1 = b1;
#pragma unroll
                        for (int j = 0; j < 4; ++j) { const u32x4 xw = xr[rr + j];
                            a0 += w0[j] * (f32x4){lo_bf(xw.x), hi_bf(xw.x), lo_bf(xw.y), hi_bf(xw.y)}; a1 += w1[j] * (f32x4){lo_bf(xw.z), hi_bf(xw.z), lo_bf(xw.w), hi_bf(xw.w)}; }
                        u32x4 o; o.x = pk2(a0[0], a0[1]); o.y = pk2(a0[2], a0[3]); o.z = pk2(a1[0], a1[1]); o.w = pk2(a1[2], a1[3]);
                        *(u32x4*)(Xc + (size_t)(r4 + rr) * DRNN + c8) = o;
                    }
                }
            }
            GRID_BAR();
            {   pg8::Gemm g{WSP(bf16, RG_X), WSP(bf16, WS_W) + WE_RG_WG, M, 5376, DRNN}; pg8::GateOrder S; S.init(M, 5376, fresh_s(G), fresh_s((int)blockIdx.x));
                EpiRgGate E{WSP(bf16, RG_X), inp(P, bi + 7), WSP(float, WS_LSP), WSP(unsigned, RG_A)};
                pg8::gemm_phase<EpiRgGate, pg8::GateOrder, true, true>(lds, g, S, E, wave_s); }
            GRID_BAR();
            {
                FRESH_IDS();
                const unsigned* AB = WSP(unsigned, RG_A); float* CA = WSP(float, RG_CA); float* CB = WSP(float, RG_CB);
                for (int task = gw; task < 2 * 128 * 21; task += NGW) {
                    const int cg = task % 21, k = (task / 21) & 127, b = task / (21 * 128), ch = cg * 128 + 2 * lane;
                    const size_t o = (size_t)(b * SEQ + k * 64) * DRNN + ch; f32x2 pa = {1.f, 1.f}, hb = {0.f, 0.f};
#pragma unroll 16
                    for (int s = 0; s < 64; ++s) { const u32x2 w = *(const u32x2*)(AB + o + (size_t)s * DRNN);
                        const f32x2 a = {__builtin_amdgcn_exp2f(lo_bf(w.x)), __builtin_amdgcn_exp2f(lo_bf(w.y))}, bv = {hi_bf(w.x), hi_bf(w.y)}; hb = a * hb + bv; pa = pa * a; }
                    *(f32x2*)(CA + (size_t)(b * 128 + k) * DRNN + ch) = pa; *(f32x2*)(CB + (size_t)(b * 128 + k) * DRNN + ch) = hb;
                } }
            GRID_BAR();
            {   FRESH_IDS();
                const unsigned* AB = WSP(unsigned, RG_A); const float* CA = WSP(float, RG_CA); const float* CB = WSP(float, RG_CB);
                const bf16* YX = WSP(bf16, RG_YX); bf16* ATT = WSP(bf16, WS_ATT);
                for (int task = gw; task < 2 * 128 * 21; task += NGW) {
                    const int cg = task % 21, k = (task / 21) & 127, b = task / (21 * 128), ch = cg * 128 + 2 * lane;
                    f32x2 h = {0.f, 0.f};
                    { const size_t co = (size_t)(b * 128) * DRNN + ch;
#pragma unroll 8
                      for (int kk = 0; kk < k; ++kk) { const f32x2 ca = *(const f32x2*)(CA + co + (size_t)kk * DRNN), cb = *(const f32x2*)(CB + co + (size_t)kk * DRNN); h = ca * h + cb; } }
                    const size_t o = (size_t)(b * SEQ + k * 64) * DRNN + ch; const size_t yo = (size_t)(b * SEQ + k * 64) * RG_N + ch;
#pragma unroll 16
                    for (int s = 0; s < 64; ++s) { const u32x2 w = *(const u32x2*)(AB + o + (size_t)s * DRNN);
                        const f32x2 a = {__builtin_amdgcn_exp2f(lo_bf(w.x)), __builtin_amdgcn_exp2f(lo_bf(w.y))}, bv = {hi_bf(w.x), hi_bf(w.y)};
                        const unsigned yw = *(const unsigned*)(YX + yo + (size_t)s * RG_N);
                        h = a * h + bv;
                        *(unsigned*)(ATT + o + (size_t)s * DRNN) = pk2(h[0] * lo_bf(yw), h[1] * hi_bf(yw)); }
                } }
            GRID_BAR();
        }
        {   const int Kd = kind == 2 ? DRNN : D;
            const bf16* wt = kind == 0 ? WSP(bf16, WS_W) + (size_t)(li == 0 ? 0 : 1) * WE_NSA_SZ + WE_NSA_WOUT : kind == 1 ? WSP(bf16, WS_W) + WE_DIL_WOUT : WSP(bf16, WS_W) + WE_RG_WOUT;
            const float* x32 = li == 0 ? inp(P, IN_X) : (const float*)nullptr;
            pg8::Gemm g{WSP(bf16, WS_ATT), wt, M, D, Kd}; pg8::StaticOrder S; S.init(M, D, fresh_s(G), fresh_s((int)blockIdx.x));
            EpiRes E{x32, WSP(bf16, WS_XR), WSP(bf16, WS_XR), WSP(float, WS_MOD) + (size_t)li * 2 * 12288 + 2 * 2048};
            pg8::gemm_phase<EpiRes, pg8::StaticOrder, true, true>(lds, g, S, E, wave_s); }
        GRID_BAR();
        {   FRESH_IDS();
            const float* gain = inp(P, bi + ff_off(li)); const float* modl = WSP(float, WS_MOD) + (size_t)li * 2 * 12288; bf16* HN = WSP(bf16, WS_HN); const bf16* XR = WSP(bf16, WS_XR);
            for (int r = gw; r < M; r += NGW) { const int b = r >> 13;
                modulate_row(nullptr, XR + (size_t)r * D, gain, modl + (size_t)b * 12288 + 3 * 2048, modl + (size_t)b * 12288 + 4 * 2048, HN + (size_t)r * D, nullptr, lane); } }
        GRID_BAR();
#pragma unroll 1
        for (int hfm = 0; hfm < 2; ++hfm) {
            {   pg8::Gemm g{WSP(bf16, WS_HN) + (size_t)hfm * 8192 * D, WSP(bf16, WS_W) + WE_FF + (size_t)li * 33554432, M / 2, DFF, D}; pg8::StaticOrder S; S.init(M / 2, DFF, fresh_s(G), fresh_s((int)blockIdx.x));
                EpiBf16<1> E{WSP(bf16, WS_BIG), DFF, 0};
                pg8::gemm_phase<EpiBf16<1>, pg8::StaticOrder, true, true>(lds, g, S, E, wave_s); }
            GRID_BAR();
            {   pg8::Gemm g{WSP(bf16, WS_BIG), WSP(bf16, WS_W) + WE_FF + (size_t)li * 33554432 + 16777216, M / 2, D, DFF}; pg8::StaticOrder S; S.init(M / 2, D, fresh_s(G), fresh_s((int)blockIdx.x));
                EpiRes E{nullptr, WSP(bf16, WS_XR) + (size_t)hfm * 8192 * D, WSP(bf16, WS_XR) + (size_t)hfm * 8192 * D, WSP(float, WS_MOD) + (size_t)li * 2 * 12288 + 5 * 2048 + (size_t)hfm * 12288};
                pg8::gemm_phase<EpiRes, pg8::StaticOrder, true, true>(lds, g, S, E, wave_s); }
            GRID_BAR();
        }
    }
    {   FRESH_IDS();
        const float* gain = inp(P, IN_NORMF); const bf16* XR = WSP(bf16, WS_XR); float* OUT = P.out;
        for (int r = gw; r < M; r += NGW) modulate_row(nullptr, XR + (size_t)r * D, gain, nullptr, nullptr, nullptr, OUT + (size_t)r * D, lane); }
}

extern "C" void kernel_launch(void* const* d_in, const int* in_sizes, int n_in, void* d_out, int out_size, void* d_ws, size_t ws_size, hipStream_t stream) {
    static int grid = 0;
    if (grid == 0) {
        if (n_in != 46 || out_size != M * D || ws_size < WS_END) { fprintf(stderr, "kernel_launch: unexpected shapes (n_in %d out %d ws %zu need %zu)\n", n_in, out_size, ws_size, (size_t)WS_END); grid = -1; return; }
        int dev = 0, cus = 0, per_cu = 0;
        if (hipGetDevice(&dev) != hipSuccess || hipDeviceGetAttribute(&cus, hipDeviceAttributeMultiprocessorCount, dev) != hipSuccess) { grid = -1; return; }
        if (hipFuncSetAttribute((const void*)mega_fwd, hipFuncAttributeMaxDynamicSharedMemorySize, LDS_BYTES) != hipSuccess) { fprintf(stderr, "kernel_launch: hipFuncSetAttribute failed\n"); grid = -1; return; }
        if (hipOccupancyMaxActiveBlocksPerMultiprocessor(&per_cu, (const void*)mega_fwd, NTHREADS, LDS_BYTES) != hipSuccess || per_cu < 1) { fprintf(stderr, "kernel_launch: occupancy query says %d\n", per_cu); }
        (void)hipGetLastError();
        grid = cus;
    }
    if (grid < 0) return;
    if (hipMemsetAsync((char*)d_ws + WS_CTL, 0, CTL_ZERO_BYTES, stream) != hipSuccess) return;
    Params p{};
    for (int i = 0; i < 46; ++i) p.in[i] = (const float*)d_in[i];
    p.out = (float*)d_out; p.ws = (unsigned char*)d_ws;
    hipLaunchKernelGGL(mega_fwd, dim3(grid), dim3(NTHREADS), LDS_BYTES, stream, p);
}
```

```cpp
#include <hip/hip_runtime.h>
#include <cstdio>
#include <cstdint>

#define GAS __attribute__((address_space(1)))
#define LAS __attribute__((address_space(3)))
typedef unsigned short bf16;
typedef float f32x4 __attribute__((ext_vector_type(4)));
typedef float f32x2 __attribute__((ext_vector_type(2)));
typedef unsigned u32x4 __attribute__((ext_vector_type(4)));
typedef unsigned u32x2 __attribute__((ext_vector_type(2)));
#define LDS_WAIT() asm volatile("s_waitcnt lgkmcnt(0)" ::: "memory")
__device__ __forceinline__ int fresh_s(int v) { asm volatile("" : "+s"(v)); return v; }
__device__ __forceinline__ int lane_id_asm() { int l; asm volatile("v_mbcnt_lo_u32_b32 %0, -1, 0\n\tv_mbcnt_hi_u32_b32 %0, -1, %0" : "=v"(l)); return l; }

namespace pg8 {
#define PG8_LAS __attribute__((address_space(3)))
typedef unsigned short bf16_t;
typedef short bf16x8 __attribute__((ext_vector_type(8)));
constexpr int BM = 256, BK = 64, HALF = 128, HTB = HALF * BK * 2, STAGE_BYTES = 8 * HTB, NXCD = 8, WGM = 8;
__host__ __device__ __forceinline__ int lds_byte(int r, int c) { const int st = (r >> 4) * 2 + (c >> 5), rr = r & 15, cc = c & 31, ob = rr * 64 + cc * 2; return st * 1024 + (ob ^ (((ob >> 9) & 1) << 5)); }
__host__ __device__ __forceinline__ void stage_rc(int b, int& R, int& C) { const int st = b / 1024, sb = b % 1024, swz = sb ^ (((sb >> 9) & 1) << 5); R = (st >> 1) * 16 + swz / 64; C = (st & 1) * 32 + (swz % 64) / 2; }
__host__ __device__ __forceinline__ int perm32(int rho) { const int n = rho >> 4, i = rho & 15; return 8 * (i >> 2) + 4 * n + (i & 3); }
struct Unit { int pm, pn; };
struct Gemm { const bf16_t* A; const bf16_t* Bt; int M, N, K; int dshA, dshB; };
__device__ __forceinline__ long rowbase(int p, int dsh) { const int i0 = p * 256; if (dsh == 0) return i0; const int b = i0 >> 13, rem = i0 & 8191, sh = 13 - dsh; return (long)(b << 13) + ((rem & ((1 << sh) - 1)) << dsh) + (rem >> sh); }
struct StaticOrder {
    int nM, nN, nwg, G, c;
    __host__ __device__ void init(int M, int N, int G_, int c_) { nM = M / BM; nN = N / BM; nwg = nM * nN; G = G_; c = c_; }
    __host__ __device__ bool next(int i, Unit& u) const {
        const long L = (long)i * G + c; if (L >= nwg) return false;
        int wgid = (int)L; { const int q = nwg / NXCD, r = nwg % NXCD, xcd = wgid % NXCD, off = wgid / NXCD; wgid = (xcd < r ? xcd * (q + 1) : r * (q + 1) + (xcd - r) * q) + off; }
        const int nig = WGM * nN, gid = wgid / nig, fm = gid * WGM, gsz = (nM - fm) < WGM ? (nM - fm) : WGM;
        u.pm = fm + ((wgid % nig) % gsz); u.pn = (wgid % nig) / gsz; return true;
    }
    __device__ __forceinline__ void a_ready(const Unit&) const {}
    __device__ __forceinline__ void done(const Unit&) const {}
    __device__ __forceinline__ void krange(const Unit&, int K, int& kbeg, int& nt) const { kbeg = 0; nt = K / BK; }
};
struct GateOrder : StaticOrder {
    __device__ __forceinline__ void krange(const Unit& u, int K, int& kbeg, int& nt) const {
        const int c0 = u.pn * 128, nb0 = c0 / 168, nb1 = (c0 + 127) / 168;
        kbeg = (nb0 * 168) & ~127; int kend = ((nb1 + 1) * 168 + 127) & ~127; if (kend > K) kend = K;
        nt = (kend - kbeg) / BK; }
};
__device__ __forceinline__ unsigned cvt_pk_bf16(float lo, float hi) { unsigned r; asm volatile("v_cvt_pk_bf16_f32 %0, %1, %2" : "=v"(r) : "v"(lo), "v"(hi)); return r; }

template <class Epi, class Sched, bool ALIGN_EPI = false, bool SP2 = false>
__device__ __forceinline__ void gemm_phase(PG8_LAS unsigned char* lds, const Gemm g, const Sched& S, const Epi& E, int wid_in) {
    int wid = wid_in; asm volatile("" : "+s"(wid));
    const int lane = lane_id_asm(), tid = wid * 64 + lane, wr = wid >> 2, wc = wid & 3, fr = lane & 15, fq = lane >> 4;
    const int K = g.K;
    unsigned voffA[2], voffB[2];
#pragma unroll
    for (int i = 0; i < 2; ++i) { int R, C; stage_rc(tid * 16 + i * 8192, R, C); const int Rb = Epi::PERM ? ((R & ~31) + perm32(R & 31)) : R;
        voffA[i] = (unsigned)((R << g.dshA) * K + C) * 2u; voffB[i] = (unsigned)((Rb << g.dshB) * K + C) * 2u; }
    const size_t kstep = (size_t)(BK * 2);
    const size_t hstepA = (size_t)(HALF << g.dshA) * K * 2, hstepB = (size_t)(HALF << g.dshB) * K * 2;
#define PG8_BASEA(u) ((const char*)g.A + (size_t)rowbase((u).pm, g.dshA) * K * 2)
#define PG8_BASEB(u) ((const char*)g.Bt + (size_t)rowbase((u).pn, g.dshB) * K * 2)
    const unsigned ldsw = (unsigned)wid * 1024u;
    const int aoff = lds_byte(wr * 64 + fr, fq * 8), boff = lds_byte(wc * 32 + fr, fq * 8);
#define PG8_SA(b, h) (((b) * 2 + (h)) * HTB)
#define PG8_SB(b, h) ((4 + (b) * 2 + (h)) * HTB)
#define PG8_STAGE(bufoff, gbase, voff) do { _Pragma("unroll") for (int _i = 0; _i < 2; ++_i) \
        __builtin_amdgcn_global_load_lds((const unsigned*)((const char*)(gbase) + (voff)[_i]), (PG8_LAS unsigned*)(lds + (bufoff) + ldsw + _i * 8192), 16, 0, 0); } while (0)
#define PG8_LDA(dst, b, h) do { _Pragma("unroll") for (int m = 0; m < 4; ++m) _Pragma("unroll") for (int k = 0; k < 2; ++k) dst[m][k] = *(const PG8_LAS bf16x8*)(lds + PG8_SA(b, h) + aoff + m * 2048 + k * 1024); } while (0)
#define PG8_LDB(dst, b, h) do { _Pragma("unroll") for (int n = 0; n < 2; ++n) _Pragma("unroll") for (int k = 0; k < 2; ++k) dst[n][k] = *(const PG8_LAS bf16x8*)(lds + PG8_SB(b, h) + boff + n * 2048 + k * 1024); } while (0)
#define PG8_MMA(ai, bj, At, Bt) do { __builtin_amdgcn_s_setprio(1); _Pragma("unroll") for (int m = 0; m < 4; ++m) _Pragma("unroll") for (int n = 0; n < 2; ++n) _Pragma("unroll") for (int k = 0; k < 2; ++k) \
        acc[ai][bj][m][n] = __builtin_amdgcn_mfma_f32_16x16x32_bf16(Bt[n][k], At[m][k], acc[ai][bj][m][n], 0, 0, 0); __builtin_amdgcn_s_setprio(0); } while (0)
#define PG8_WAIT_V(n) asm volatile("s_waitcnt vmcnt(" #n ")" ::: "memory")
#define PG8_WAIT_L(n) asm volatile("s_waitcnt lgkmcnt(" #n ")" ::: "memory")
#define PG8_BAR __builtin_amdgcn_s_barrier()
#define PG8_SCHED __builtin_amdgcn_sched_barrier(0)
    Unit cur, nxt; int ui = 0;
    if (!S.next(0, cur)) return;
    f32x4 acc[2][2][4][2];
#pragma unroll
    for (int a = 0; a < 2; ++a)
#pragma unroll
        for (int b = 0; b < 2; ++b)
#pragma unroll
            for (int m = 0; m < 4; ++m)
#pragma unroll
                for (int n = 0; n < 2; ++n) acc[a][b][m][n] = (f32x4){0.f, 0.f, 0.f, 0.f};
    bf16x8 At[4][2], B0[2][2], B1[2][2];
    int kb_cur, nt; S.krange(cur, K, kb_cur, nt);
    const char* cA = PG8_BASEA(cur) + (size_t)kb_cur * 2; const char* cB = PG8_BASEB(cur) + (size_t)kb_cur * 2;
    S.a_ready(cur);
    if constexpr (SP2) {
        PG8_STAGE(PG8_SB(0, 0), cB, voffB); PG8_STAGE(PG8_SB(0, 1), cB + hstepB, voffB); PG8_STAGE(PG8_SA(0, 0), cA, voffA); PG8_STAGE(PG8_SA(0, 1), cA + hstepA, voffA);
        if (wr == 1) PG8_BAR;
        PG8_WAIT_V(2); PG8_BAR;
        PG8_STAGE(PG8_SB(1, 0), cB + kstep, voffB); PG8_STAGE(PG8_SA(1, 0), cA + kstep, voffA); PG8_STAGE(PG8_SB(1, 1), cB + hstepB + kstep, voffB);
        PG8_WAIT_V(6); PG8_BAR;
    } else {
        PG8_STAGE(PG8_SB(0, 0), cB, voffB); PG8_STAGE(PG8_SA(0, 0), cA, voffA); PG8_STAGE(PG8_SB(0, 1), cB + hstepB, voffB); PG8_STAGE(PG8_SA(0, 1), cA + hstepA, voffA);
        if (wr == 1) PG8_BAR;
        PG8_WAIT_V(4); PG8_BAR;
        PG8_STAGE(PG8_SB(1, 0), cB + kstep, voffB); PG8_STAGE(PG8_SA(1, 0), cA + kstep, voffA); PG8_STAGE(PG8_SB(1, 1), cB + hstepB + kstep, voffB);
        PG8_WAIT_V(6); PG8_BAR;
    }
    for (;;) {
        const bool has_next = S.next(ui + 1, nxt);
        int kb_nxt = 0, nt_nxt = nt; if (has_next) S.krange(nxt, K, kb_nxt, nt_nxt);
        const char* nA = has_next ? PG8_BASEA(nxt) + (size_t)kb_nxt * 2 : cA; const char* nB = has_next ? PG8_BASEB(nxt) + (size_t)kb_nxt * 2 : cB;
        for (int t = 0; t < nt; t += 2) {
            const bool last = (t == nt - 2);
            const char* a1 = cA + (size_t)(t + 1) * kstep;
            const char* a2 = last ? nA : cA + (size_t)(t + 2) * kstep; const char* b2 = last ? nB : cB + (size_t)(t + 2) * kstep;
            const char* a3 = a2 + kstep; const char* b3 = b2 + kstep;
            if (last && has_next) S.a_ready(nxt);
            if constexpr (SP2) {
            PG8_LDB(B0, 0, 0); PG8_LDB(B1, 0, 1); PG8_SCHED; PG8_LDA(At, 0, 0); PG8_STAGE(PG8_SA(1, 1), a1 + hstepA, voffA);
            PG8_WAIT_V(8); PG8_WAIT_L(0); PG8_BAR; PG8_MMA(0, 0, At, B0); PG8_MMA(0, 1, At, B1); PG8_BAR; PG8_SCHED;
            PG8_LDA(At, 0, 1); PG8_STAGE(PG8_SB(0, 0), b2, voffB); PG8_STAGE(PG8_SB(0, 1), b2 + hstepB, voffB); PG8_STAGE(PG8_SA(0, 0), a2, voffA);
            PG8_WAIT_V(8); PG8_WAIT_L(0); PG8_BAR; PG8_MMA(1, 0, At, B0); PG8_MMA(1, 1, At, B1); PG8_BAR; PG8_SCHED;
            PG8_LDB(B0, 1, 0); PG8_LDB(B1, 1, 1); PG8_SCHED; PG8_LDA(At, 1, 0); PG8_STAGE(PG8_SA(0, 1), a2 + hstepA, voffA);
            PG8_WAIT_V(8); PG8_WAIT_L(0); PG8_BAR; PG8_MMA(0, 0, At, B0); PG8_MMA(0, 1, At, B1); PG8_BAR; PG8_SCHED;
            PG8_LDA(At, 1, 1); PG8_STAGE(PG8_SB(1, 0), b3, voffB); PG8_STAGE(PG8_SB(1, 1), b3 + hstepB, voffB); PG8_STAGE(PG8_SA(1, 0), a3, voffA);
            PG8_WAIT_V(8); PG8_WAIT_L(0); PG8_BAR; PG8_MMA(1, 0, At, B0); PG8_MMA(1, 1, At, B1); PG8_BAR; PG8_SCHED;
            } else {
            PG8_LDB(B0, 0, 0); PG8_SCHED; PG8_LDA(At, 0, 0); PG8_STAGE(PG8_SA(1, 1), a1 + hstepA, voffA);
            PG8_WAIT_L(8); PG8_BAR; PG8_WAIT_L(0); PG8_MMA(0, 0, At, B0); PG8_BAR; PG8_SCHED;
            PG8_LDB(B1, 0, 1); PG8_STAGE(PG8_SB(0, 0), b2, voffB);
            PG8_BAR; PG8_WAIT_L(0); PG8_MMA(0, 1, At, B1); PG8_BAR;
            PG8_LDA(At, 0, 1); PG8_STAGE(PG8_SA(0, 0), a2, voffA);
            PG8_BAR; PG8_WAIT_L(0); PG8_MMA(1, 0, At, B0); PG8_BAR; PG8_SCHED;
            PG8_STAGE(PG8_SB(0, 1), b2 + hstepB, voffB);
            PG8_WAIT_V(6); PG8_BAR; PG8_MMA(1, 1, At, B1); PG8_BAR;
            PG8_LDB(B0, 1, 0); PG8_SCHED; PG8_LDA(At, 1, 0); PG8_STAGE(PG8_SA(0, 1), a2 + hstepA, voffA);
            PG8_WAIT_L(8); PG8_BAR; PG8_WAIT_L(0); PG8_MMA(0, 0, At, B0); PG8_BAR; PG8_SCHED;
            PG8_LDB(B1, 1, 1); PG8_STAGE(PG8_SB(1, 0), b3, voffB);
            PG8_BAR; PG8_WAIT_L(0); PG8_MMA(0, 1, At, B1); PG8_BAR;
            PG8_LDA(At, 1, 1); PG8_STAGE(PG8_SA(1, 0), a3, voffA);
            PG8_BAR; PG8_WAIT_L(0); PG8_MMA(1, 0, At, B0); PG8_BAR; PG8_SCHED;
            PG8_STAGE(PG8_SB(1, 1), b3 + hstepB, voffB);
            PG8_WAIT_V(6); PG8_BAR; PG8_MMA(1, 1, At, B1); PG8_BAR;
            }
        }
        if constexpr (ALIGN_EPI) { if (wr == 0) PG8_BAR; }
        E(acc, cur, wr, wc, fr, fq); S.done(cur);
        if (!has_next) break;
#pragma unroll
        for (int a = 0; a < 2; ++a)
#pragma unroll
            for (int b = 0; b < 2; ++b)
#pragma unroll
                for (int m = 0; m < 4; ++m)
#pragma unroll
                    for (int n = 0; n < 2; ++n) acc[a][b][m][n] = (f32x4){0.f, 0.f, 0.f, 0.f};
        cur = nxt; cA = nA; cB = nB; nt = nt_nxt; ++ui;
        if constexpr (ALIGN_EPI) { if (wr == 1) PG8_BAR; }
    }
    PG8_WAIT_V(0);
    if constexpr (!ALIGN_EPI) { if (wr == 0) PG8_BAR; }
    PG8_BAR;
#undef PG8_BASEA
#undef PG8_BASEB
#undef PG8_SA
#undef PG8_SB
#undef PG8_STAGE
#undef PG8_LDA
#undef PG8_LDB
#undef PG8_MMA
#undef PG8_WAIT_V
#undef PG8_WAIT_L
#undef PG8_BAR
#undef PG8_SCHED
}
}

#define XB_TMO      128
#define XB_XCNT(j)  (256  + 64 * (j))
#define XB_XSUB(j)  (1280 + 64 * (j))
#define XB_XGEN(j)  (2304 + 64 * (j))
#define XB_TOP      3328
#define XB_TOPGEN   3392
#define XCD_BAR_WORDS 3456
#define XB_SPIN_CAP (1u << 22)
__device__ __forceinline__ unsigned xb_ld(unsigned* p)              { return __hip_atomic_load(p, __ATOMIC_RELAXED, __HIP_MEMORY_SCOPE_AGENT); }
__device__ __forceinline__ unsigned xb_add(unsigned* p, unsigned v) { return __hip_atomic_fetch_add(p, v, __ATOMIC_RELAXED, __HIP_MEMORY_SCOPE_AGENT); }
__device__ __forceinline__ unsigned xb_xcc_id() { return (unsigned)__builtin_amdgcn_s_getreg((3 << 11) | 20) & 0xFu; }
#define XB_SPIN(cond, bar) do { unsigned _sp = 0; while (cond) { __builtin_amdgcn_s_sleep(1); \
    if ((++_sp & 255u) == 0u) { if (xb_ld(&(bar)[XB_TMO])) break; if (_sp > XB_SPIN_CAP) { atomicAdd(&(bar)[XB_TMO], 1u); break; } } } } while (0)
struct XcdBarrier { unsigned* bar; unsigned x; volatile LAS unsigned* st; int wave; };
__device__ __forceinline__ XcdBarrier xcd_barrier_post(unsigned* bar, volatile LAS unsigned* st) {
    XcdBarrier b; b.bar = bar; b.x = xb_xcc_id(); b.st = st;
    if (threadIdx.x == 0) (void)xb_add(&bar[XB_XCNT(b.x)], 1u);
    return b;
}
__device__ __forceinline__ void xcd_barrier_complete(unsigned* bar, unsigned x, unsigned& nloc, unsigned& nx) {
    const unsigned G = gridDim.x * gridDim.y * gridDim.z;
    unsigned sum, cnt, mine, sp = 0u;
    for (;;) {
        sum = 0u; cnt = 0u; mine = 0u;
#pragma unroll
        for (unsigned j = 0; j < 16; ++j) { const unsigned c = xb_ld(&bar[XB_XCNT(j)]); sum += c; cnt += (c > 0u) ? 1u : 0u; mine = (j == x) ? c : mine; }
        if (sum == G) break;
        __builtin_amdgcn_s_sleep(1);
        if ((++sp & 255u) == 0u) { if (xb_ld(&bar[XB_TMO])) break; if (sp > XB_SPIN_CAP) { atomicAdd(&bar[XB_TMO], 1u); break; } }
    }
    nloc = mine > 0u ? mine : 1u; nx = cnt > 0u ? cnt : 1u;
}
__device__ __forceinline__ void xcd_barrier(const XcdBarrier& b) {
    asm volatile("s_waitcnt vmcnt(0)" ::: "memory");
    __syncthreads();
    if (b.wave == 0 && lane_id_asm() == 0) {
        unsigned* bar = b.bar; unsigned bx = b.x;
        asm volatile("" : "+s"(bar), "+s"(bx));
        __builtin_amdgcn_s_waitcnt(0);
        unsigned nloc = b.st[0], nx = b.st[1];
        if (nloc == 0u) { xcd_barrier_complete(bar, bx, nloc, nx); b.st[0] = nloc; b.st[1] = nx; }
        const unsigned old = xb_add(&bar[XB_XSUB(bx)], 1u);
        const unsigned gen = old / nloc;
        if (old + 1u == (gen + 1u) * nloc) {
            __builtin_amdgcn_fence(__ATOMIC_RELEASE, "agent");
            asm volatile("s_waitcnt vmcnt(0)" ::: "memory");
            const unsigned og = xb_add(&bar[XB_TOP], 1u);
            const unsigned tg = og / nx;
            if (og + 1u == (tg + 1u) * nx) xb_add(&bar[XB_TOPGEN], 1u);
            else XB_SPIN(xb_ld(&bar[XB_TOPGEN]) == tg, bar);
            __builtin_amdgcn_fence(__ATOMIC_ACQUIRE, "agent");
            xb_add(&bar[XB_XGEN(bx)], 1u);
            asm volatile("s_waitcnt vmcnt(0)" ::: "memory");
        } else {
            XB_SPIN(xb_ld(&bar[XB_XGEN(bx)]) == gen, bar);
            __builtin_amdgcn_fence(__ATOMIC_ACQUIRE, "agent");
            asm volatile("s_waitcnt vmcnt(0)" ::: "memory");
        }
    }
    __syncthreads();
}

constexpr int D = 2048, SEQ = 8192, M = 16384, DFF = 8192;
constexpr int NSA_N = 5376;
constexpr int NSA_N1 = 4096;
constexpr int DIL_N = 18432;
constexpr int DRNN = 2688, RG_N = 5632;
constexpr int RG_XOFF = 2816;
constexpr int NWAVES = 8, NTHREADS = 512;
constexpr int LDV = M + 64;
constexpr float ATT_SCALE = 0.08838834764831845f;
constexpr float NORM_EPS = 1e-6f;

constexpr int IN_X = 0, IN_C = 1, IN_NORMF = 45;
__host__ __device__ __forceinline__ constexpr int layer_base(int li) { return li == 0 ? 2 : li == 1 ? 13 : li == 2 ? 21 : 34; }
__host__ __device__ __forceinline__ constexpr int ff_off(int li) { return li == 1 ? 5 : li == 2 ? 10 : 8; }
__host__ __device__ __forceinline__ constexpr int wout_off(int li) { return li == 1 ? 4 : li == 2 ? 9 : 7; }

constexpr size_t MiB = 1u << 20;
constexpr size_t WS_CTL = 0, CTL_ZERO_BYTES = 1 * MiB;
constexpr size_t WS_MODP = 1 * MiB;
constexpr size_t WS_MOD = 4 * MiB;
constexpr size_t WS_COS = 5 * MiB, WS_SIN = 7 * MiB;
constexpr size_t WS_BPEP = 9 * MiB;
constexpr size_t WS_BPE = 9 * MiB + 512 * 1024;
constexpr size_t WS_LSP = 9 * MiB + 768 * 1024;
constexpr size_t WS_W = 10 * MiB;
constexpr size_t WE_NSA_WIN = 0, WE_NSA_W1 = 11010048, WE_NSA_WOUT = 11010048 + 4194304, WE_NSA_SZ = 19398656;
constexpr size_t WE_DIL = 2 * WE_NSA_SZ, WE_DIL_WOUT = WE_DIL + 37748736;
constexpr size_t WE_RG = WE_DIL + 41943040, WE_RG_WG = WE_RG + 11534336, WE_RG_WOUT = WE_RG_WG + 14450688;
constexpr size_t WE_FF = WE_RG + 31490048;
constexpr size_t WE_END = WE_FF + 4 * (size_t)33554432;
static_assert(WE_END == 246448128, "weight map");
constexpr size_t WS_HN = 482 * MiB;
constexpr size_t WS_ATT = 546 * MiB;
constexpr size_t WS_XR = 630 * MiB;
constexpr size_t WS_BIG = 694 * MiB;
static_assert(WS_W + WE_END * 2 <= WS_HN, "ws map");
constexpr size_t NS_Q = WS_BIG, NS_QR = NS_Q + 64 * MiB, NS_PK = NS_QR + 64 * MiB, NS_PV = NS_PK + 16 * MiB, NS_KS = NS_PV + 16 * MiB, NS_KW = NS_KS + 16 * MiB,
                 NS_VT = NS_KW + 16 * MiB  , NS_GT = NS_VT + 34 * MiB, NS_HC = NS_GT + 4 * MiB, NS_KC = NS_HC + 32 * MiB  ,
                 NS_VCT = NS_KC + 1 * MiB  , NS_END = NS_VCT + 1 * MiB;
constexpr size_t RG_YX = WS_BIG, RG_X = RG_YX + 176 * MiB, RG_A = RG_X + 84 * MiB, RG_B = RG_A + 168 * MiB, RG_CA = RG_B + 168 * MiB, RG_CB = RG_CA + 3 * MiB;
constexpr size_t DL_QK = WS_BIG, DL_VT = WS_BIG + 384 * MiB, DL_VT_STRIDE = 66 * MiB, DL_ML = WS_BIG + 582 * MiB;
constexpr size_t WS_END = WS_BIG + 610 * MiB;
static_assert(RG_CB + 3 * MiB <= WS_END && NS_END <= WS_END && DL_ML + 2 * MiB <= WS_END && WS_END <= (size_t)1396 * MiB, "ws map");

constexpr int RING_BYTES = 147456, MISC_OFF = RING_BYTES + 320, LDS_BYTES = 163840;

struct Params { const float* in[46]; float* out; unsigned char* ws; };

__device__ __forceinline__ float lo_bf(unsigned w) { return __uint_as_float(w << 16); }
__device__ __forceinline__ float hi_bf(unsigned w) { return __uint_as_float(w & 0xffff0000u); }
__device__ __forceinline__ unsigned pk2(float lo, float hi) { return pg8::cvt_pk_bf16(lo, hi); }
__device__ __forceinline__ float wave_sum(float v) {
#pragma unroll
    for (int o = 1; o < 64; o <<= 1) v += __shfl_xor(v, o);
    return v;
}
__device__ __forceinline__ float wave_max(float v) {
#pragma unroll
    for (int o = 1; o < 64; o <<= 1) v = fmaxf(v, __shfl_xor(v, o));
    return v;
}
__device__ __forceinline__ float sigmoidf_(float x) { return 1.0f / (1.0f + __expf(-x)); }
__device__ __forceinline__ float gelu_tanh(float x) { const float u = 0.7978845608028654f * (x + 0.044715f * x * x * x); const float e = __expf(2.0f * u); return 0.5f * x * (2.0f - 2.0f / (e + 1.0f)); }
__device__ __forceinline__ int sigma_d(int pos) { return (pos & 1) * 64 + (pos >> 1); }
__device__ __forceinline__ void store8_bf16(bf16* p, const f32x4 v0, const f32x4 v1) {
    u32x4 w; w.x = pk2(v0[0], v0[1]); w.y = pk2(v0[2], v0[3]); w.z = pk2(v1[0], v1[1]); w.w = pk2(v1[2], v1[3]); *(u32x4*)p = w; }
__device__ __forceinline__ void rope8(f32x4& v0, f32x4& v1, const float* cosr, const float* sinr, int i0) {
    const f32x4 cs = *(const f32x4*)(cosr + i0), sn = *(const f32x4*)(sinr + i0);
    const f32x4 a = v0, b = v1;
    v0[0] = a[0] * cs[0] - a[1] * sn[0]; v0[1] = a[0] * sn[0] + a[1] * cs[0];
    v0[2] = a[2] * cs[1] - a[3] * sn[1]; v0[3] = a[2] * sn[1] + a[3] * cs[1];
    v1[0] = b[0] * cs[2] - b[1] * sn[2]; v1[1] = b[0] * sn[2] + b[1] * cs[2];
    v1[2] = b[2] * cs[3] - b[3] * sn[3]; v1[3] = b[2] * sn[3] + b[3] * cs[3];
}

__device__ __forceinline__ void rope8v(f32x4& v0, f32x4& v1, const f32x4 cs, const f32x4 sn) {
    const f32x4 a = v0, b = v1;
    v0[0] = a[0] * cs[0] - a[1] * sn[0]; v0[1] = a[0] * sn[0] + a[1] * cs[0];
    v0[2] = a[2] * cs[1] - a[3] * sn[1]; v0[3] = a[2] * sn[1] + a[3] * cs[1];
    v1[0] = b[0] * cs[2] - b[1] * sn[2]; v1[1] = b[0] * sn[2] + b[1] * cs[2];
    v1[2] = b[2] * cs[3] - b[3] * sn[3]; v1[3] = b[2] * sn[3] + b[3] * cs[3];
}
#define EPI_LOOP_ROWS for (int ai = 0; ai < 2; ++ai) _Pragma("unroll") for (int m = 0; m < 4; ++m)
struct EpiNsaIn {
    static constexpr bool PERM = true, AFTER_DRAIN = false;
    bf16 *Q, *QR, *PK, *PV, *KS, *KW; float* GT; const float *COS, *SIN;
    __device__ __forceinline__ void operator()(const f32x4 (&acc)[2][2][4][2], const pg8::Unit& u, int wr, int wc, int fr, int fq) const {
        const int pn = u.pn, row0 = u.pm * 256 + wr * 64 + fr, cl = wc * 32 + 8 * fq;
        const bool rot = pn < 8 || pn >= 12;
#pragma unroll
        for (int ai = 0; ai < 2; ++ai) {
            f32x4 cs[4], sn[4];
            if (rot) {
#pragma unroll
                for (int m = 0; m < 4; ++m) { const int t = (row0 + ai * 128 + m * 16) & (SEQ - 1); cs[m] = *(const f32x4*)(COS + (size_t)t * 64 + (cl >> 1)); sn[m] = *(const f32x4*)(SIN + (size_t)t * 64 + (cl >> 1)); } }
#pragma unroll
            for (int m = 0; m < 4; ++m) {
                const int row = row0 + ai * 128 + m * 16, t = row & (SEQ - 1), b = row >> 13;
#pragma unroll
                for (int bj = 0; bj < 2; ++bj) {
                    f32x4 v0 = acc[ai][bj][m][0], v1 = acc[ai][bj][m][1];
                    const int hh = (pn & 1) * 2 + bj;
                    if (pn < 8) {
                        const size_t o = (size_t)row * 2048 + pn * 256 + bj * 128 + cl;
                        store8_bf16(Q + o, v0, v1);
                        rope8v(v0, v1, cs[m], sn[m]);
                        store8_bf16(QR + o, v0, v1);
                    } else if (pn < 12) {
                        bf16* P = pn < 10 ? PK : PV;
                        const size_t o = ((size_t)((b * 4 + hh) * 512 + (t >> 4))) * 2048 + (t & 15) * 128 + cl;
                        store8_bf16(P + o, v0, v1);
                    } else {
                        bf16* P = pn < 14 ? KS : KW;
                        rope8v(v0, v1, cs[m], sn[m]);
                        store8_bf16(P + (size_t)row * 512 + hh * 128 + cl, v0, v1);
                    }
                }
            }
        }
    }
};
struct EpiGates {
    static constexpr bool PERM = true, AFTER_DRAIN = false;
    float* GT;
    __device__ __forceinline__ void operator()(const f32x4 (&acc)[2][2][4][2], const pg8::Unit& u, int wr, int wc, int fr, int fq) const {
        const int row0 = u.pm * 256 + wr * 64 + fr, cl = wc * 32 + 8 * fq;
        if (cl < 48) {
#pragma unroll
            EPI_LOOP_ROWS { const int row = row0 + ai * 128 + m * 16; const f32x4 v0 = acc[ai][0][m][0], v1 = acc[ai][0][m][1];
#pragma unroll
                for (int e = 0; e < 4; ++e) { GT[(size_t)row * 48 + cl + e] = sigmoidf_(v0[e]); GT[(size_t)row * 48 + cl + 4 + e] = sigmoidf_(v1[e]); } }
        }
    }
};
struct EpiDilQK {
    static constexpr bool PERM = true, AFTER_DRAIN = false;
    bf16* O; const float *COS, *SIN; int dsh;
    __device__ __forceinline__ void operator()(const f32x4 (&acc)[2][2][4][2], const pg8::Unit& u, int wr, int wc, int fr, int fq) const {
        const int pn = u.pn, row0 = u.pm * 256 + wr * 64 + fr, cl = wc * 32 + 8 * fq, sh = 13 - dsh;
#pragma unroll
        for (int ai = 0; ai < 2; ++ai) {
            f32x4 cs[4], sn[4];
#pragma unroll
            for (int m = 0; m < 4; ++m) { const int row = row0 + ai * 128 + m * 16, rem = row & (SEQ - 1), t = ((rem & ((1 << sh) - 1)) << dsh) + (rem >> sh);
                cs[m] = *(const f32x4*)(COS + (size_t)t * 64 + (cl >> 1)); sn[m] = *(const f32x4*)(SIN + (size_t)t * 64 + (cl >> 1)); }
#pragma unroll
            for (int m = 0; m < 4; ++m) { const int row = row0 + ai * 128 + m * 16;
#pragma unroll
                for (int bj = 0; bj < 2; ++bj) {
                    f32x4 v0 = acc[ai][bj][m][0], v1 = acc[ai][bj][m][1];
                    rope8v(v0, v1, cs[m], sn[m]);
                    store8_bf16(O + (size_t)row * 4096 + pn * 256 + bj * 128 + cl, v0, v1);
                } }
        }
    }
};
template <int ACT> struct EpiBf16 {
    static constexpr bool PERM = true, AFTER_DRAIN = false;
    bf16* O; int ldc; int act_tiles;
    __device__ __forceinline__ void operator()(const f32x4 (&acc)[2][2][4][2], const pg8::Unit& u, int wr, int wc, int fr, int fq) const {
        const int pn = u.pn, row0 = u.pm * 256 + wr * 64 + fr, cl = wc * 32 + 8 * fq;
        const bool act = pn < act_tiles;
#pragma unroll
        EPI_LOOP_ROWS {
            const int row = row0 + ai * 128 + m * 16;
#pragma unroll
            for (int bj = 0; bj < 2; ++bj) {
                f32x4 v0 = acc[ai][bj][m][0], v1 = acc[ai][bj][m][1];
                if (ACT == 1) {
#pragma unroll
                    for (int e = 0; e < 4; ++e) { const float a = fmaxf(v0[e], 0.f), c = fmaxf(v1[e], 0.f); v0[e] = a * a; v1[e] = c * c; }
                }
                if (ACT == 2) { if (act) {
#pragma unroll
                    for (int e = 0; e < 4; ++e) { v0[e] = gelu_tanh(v0[e]); v1[e] = gelu_tanh(v1[e]); } } }
                store8_bf16(O + (size_t)row * ldc + pn * 256 + bj * 128 + cl, v0, v1);
            }
        }
    }
};
struct EpiF32 {
    static constexpr bool PERM = false, AFTER_DRAIN = false;
    float* C; int ldc;
    __device__ __forceinline__ void operator()(const f32x4 (&acc)[2][2][4][2], const pg8::Unit& u, int wr, int wc, int fr, int fq) const {
        const int row0 = u.pm * 256 + wr * 64 + fr, col0 = u.pn * 256 + wc * 32 + 4 * fq;
#pragma unroll
        EPI_LOOP_ROWS {
            float* rowp = C + (size_t)(row0 + ai * 128 + m * 16) * ldc + col0;
#pragma unroll
            for (int bj = 0; bj < 2; ++bj)
#pragma unroll
                for (int n = 0; n < 2; ++n) *(f32x4*)(rowp + bj * 128 + n * 16) = acc[ai][bj][m][n];
        }
    }
};
struct EpiRes {
    static constexpr bool PERM = true, AFTER_DRAIN = false;
    const float* xin32; const bf16* xin16; bf16* out; const float* gate;
    __device__ __forceinline__ void operator()(const f32x4 (&acc)[2][2][4][2], const pg8::Unit& u, int wr, int wc, int fr, int fq) const {
        const int row0 = u.pm * 256 + wr * 64 + fr, cl = wc * 32 + 8 * fq, b = (u.pm * 256) >> 13;
        f32x4 g0[2], g1[2];
#pragma unroll
        for (int bj = 0; bj < 2; ++bj) { const float* gp = gate + (size_t)b * 12288 + u.pn * 256 + bj * 128 + cl; g0[bj] = *(const f32x4*)gp; g1[bj] = *(const f32x4*)(gp + 4); }
#pragma unroll
        for (int ai = 0; ai < 2; ++ai) {
            f32x4 x0[4][2], x1[4][2];
#pragma unroll
            for (int m = 0; m < 4; ++m)
#pragma unroll
                for (int bj = 0; bj < 2; ++bj) { const size_t o = (size_t)(row0 + ai * 128 + m * 16) * D + u.pn * 256 + bj * 128 + cl;
                    if (xin32) { x0[m][bj] = *(const f32x4*)(xin32 + o); x1[m][bj] = *(const f32x4*)(xin32 + o + 4); }
                    else { const u32x4 w = *(const u32x4*)(xin16 + o); x0[m][bj] = (f32x4){lo_bf(w.x), hi_bf(w.x), lo_bf(w.y), hi_bf(w.y)}; x1[m][bj] = (f32x4){lo_bf(w.z), hi_bf(w.z), lo_bf(w.w), hi_bf(w.w)}; } }
#pragma unroll
            for (int m = 0; m < 4; ++m)
#pragma unroll
                for (int bj = 0; bj < 2; ++bj) store8_bf16(out + (size_t)(row0 + ai * 128 + m * 16) * D + u.pn * 256 + bj * 128 + cl, x0[m][bj] + g0[bj] * acc[ai][bj][m][0], x1[m][bj] + g1[bj] * acc[ai][bj][m][1]);
        }
    }
};
struct EpiRgGate {
    static constexpr bool PERM = true, AFTER_DRAIN = false;
    const bf16* X; const float *bgate, *LSP; unsigned* AB;
    __device__ __forceinline__ void operator()(const f32x4 (&acc)[2][2][4][2], const pg8::Unit& u, int wr, int wc, int fr, int fq) const {
        const int row0 = u.pm * 256 + wr * 64 + fr, ch0 = u.pn * 128 + wc * 32 + 8 * fq;
        u32x4 xw[2][4];
#pragma unroll
        for (int ai = 0; ai < 2; ++ai)
#pragma unroll
            for (int m = 0; m < 4; ++m) xw[ai][m] = *(const u32x4*)(X + (size_t)(row0 + ai * 128 + m * 16) * DRNN + ch0);
        const f32x4 br0 = *(const f32x4*)(bgate + ch0), br1 = *(const f32x4*)(bgate + ch0 + 4);
        const f32x4 bi0 = *(const f32x4*)(bgate + DRNN + ch0), bi1 = *(const f32x4*)(bgate + DRNN + ch0 + 4);
        const f32x4 ls0 = *(const f32x4*)(LSP + ch0), ls1 = *(const f32x4*)(LSP + ch0 + 4);
#pragma unroll
        EPI_LOOP_ROWS {
            const size_t o = (size_t)(row0 + ai * 128 + m * 16) * DRNN + ch0;
            const u32x4 xv = xw[ai][m];
            const f32x4 x0 = (f32x4){lo_bf(xv.x), hi_bf(xv.x), lo_bf(xv.y), hi_bf(xv.y)}, x1 = (f32x4){lo_bf(xv.z), hi_bf(xv.z), lo_bf(xv.w), hi_bf(xv.w)};
            const f32x4 r0 = acc[ai][0][m][0] + br0, r1 = acc[ai][0][m][1] + br1, i0 = acc[ai][1][m][0] + bi0, i1 = acc[ai][1][m][1] + bi1;
            u32x4 w0, w1;
#pragma unroll
            for (int e = 0; e < 4; ++e) {
                float la = ls0[e] * sigmoidf_(r0[e]); float bb = sqrtf(fmaxf(-expm1f(2.0f * la), 0.f)) * (sigmoidf_(i0[e]) * x0[e]); w0[e] = pk2(la * 1.4426950408889634f, bb);
                la = ls1[e] * sigmoidf_(r1[e]); bb = sqrtf(fmaxf(-expm1f(2.0f * la), 0.f)) * (sigmoidf_(i1[e]) * x1[e]); w1[e] = pk2(la * 1.4426950408889634f, bb);
            }
            *(u32x4*)(AB + o) = w0; *(u32x4*)(AB + o + 4) = w1;
        }
    }
};

__device__ __forceinline__ const float* inp(const Params& P, int i) { i = __builtin_amdgcn_readfirstlane(i); asm volatile("" : "+s"(i)); return P.in[i]; }
enum { MAP_ID = 0, MAP_NSA = 1, MAP_DIL = 2, MAP_RG = 3 };
struct Job { const float* W; int ldw, K; bf16* WT; int ldt, n_begin, n_rows, map, srcoff; };
__device__ __forceinline__ int srccol(int map, int n, int srcoff) {
    if (map == MAP_ID) return n + srcoff;
    if (map == MAP_NSA) {
        if (n < 2048) return (n & ~127) + sigma_d(n & 127);
        if (n < 3072) return n;
        if (n < 3584) return (n & ~127) + sigma_d(n & 127);
        if (n < 4096) return ((n + 512) & ~127) + sigma_d(n & 127);
        if (n < 4144) return 5120 + (n - 4096);
        if (n < 4352) return -1;
        if (n < 4864) return n - 768;
        return n - 256;
    }
    if (map == MAP_DIL) { const int j = (n >> 11) % 3; return j < 2 ? (n & ~127) + sigma_d(n & 127) : n; }
    if (n < DRNN) return n; if (n < RG_XOFF) return -1; if (n < RG_XOFF + DRNN) return n - (RG_XOFF - DRNN); return -1;
}
__device__ __forceinline__ bool is_sigma(int map, int n) {
    if (map == MAP_NSA) return n < 2048 || (n >= 3072 && n < 4096);
    if (map == MAP_DIL) return ((n >> 11) % 3) < 2;
    return false;
}
struct ConvGeom { int k0, n0, dl0, dstep, sc4; };
__device__ __forceinline__ ConvGeom conv_geom(const Job& J, int item, int lane) {
    const int nblk = J.n_rows / 32, kb = item / nblk, nb = item % nblk, nl0 = 32 * nb, c4 = lane & 7;
    const bool sig = is_sigma(J.map, nl0);
    ConvGeom g; g.k0 = 64 * kb; g.n0 = J.n_begin + nl0; g.dl0 = sig ? 8 * (c4 & 3) + (c4 >> 2) : 4 * c4; g.dstep = sig ? 2 : 1; g.sc4 = srccol(J.map, nl0 + g.dl0, J.srcoff);
    return g;
}
template <int NI>
__device__ __forceinline__ void conv_items(const Job& J, int it0, int stride, int nitems, LAS float* scr, int lane) {
    const int ks = lane >> 3;
    f32x4 v[NI][8];
#pragma unroll
    for (int u = 0; u < NI; ++u) { const int item = it0 + u * stride;
        if (item < nitems) { const ConvGeom g = conv_geom(J, item, lane);
#pragma unroll
            for (int i = 0; i < 8; ++i) v[u][i] = g.sc4 >= 0 ? __builtin_nontemporal_load((const f32x4*)(J.W + (size_t)(g.k0 + 8 * i + ks) * J.ldw + g.sc4)) : (f32x4){0.f, 0.f, 0.f, 0.f}; } }
#pragma unroll
    for (int u = 0; u < NI; ++u) { const int item = it0 + u * stride;
        if (item < nitems) { const ConvGeom g = conv_geom(J, item, lane);
#pragma unroll
            for (int i = 0; i < 8; ++i) { LAS float* d = scr + (8 * i + ks) * 33 + g.dl0; d[0] = v[u][i][0]; d[g.dstep] = v[u][i][1]; d[2 * g.dstep] = v[u][i][2]; d[3 * g.dstep] = v[u][i][3]; }
            LDS_WAIT();
            const int c = lane & 7;
#pragma unroll
            for (int j = 0; j < 4; ++j) { const int n = (lane >> 3) + 8 * j; const LAS float* sp = scr + (8 * c) * 33 + n;
                u32x4 o; o.x = pk2(sp[0 * 33], sp[1 * 33]); o.y = pk2(sp[2 * 33], sp[3 * 33]); o.z = pk2(sp[4 * 33], sp[5 * 33]); o.w = pk2(sp[6 * 33], sp[7 * 33]);
                *(u32x4*)(J.WT + (size_t)(g.n0 + n) * J.ldt + g.k0 + 8 * c) = o; }
            LDS_WAIT(); } }
}
constexpr int CONV_NI = 4;
constexpr int NJOBS = 24, NJOBS_FIRST = 6;
__device__ __forceinline__ Job get_job(const Params& P, int jid) {
    bf16* WB = (bf16*)(P.ws + WS_W);
    Job J; J.srcoff = 0; J.map = MAP_ID; J.n_begin = 0;
    if (jid < 12) {
        const int slot = jid / 6, r = jid % 6, bi = slot == 0 ? 2 : 34; bf16* base = WB + (size_t)slot * WE_NSA_SZ;
        if (r == 0) { J.W = inp(P, bi + 3); J.ldw = 5168; J.K = 2048; J.WT = base + WE_NSA_WIN; J.ldt = 2048; J.n_rows = NSA_N; J.map = MAP_NSA; }
        else if (r < 5) { const int kv = (r - 1) >> 1, half = (r - 1) & 1;
            J.W = inp(P, bi + 5) + (size_t)kv * 4096 * 512 + (size_t)half * 2048 * 512; J.ldw = 512; J.K = 2048;
            J.WT = base + WE_NSA_W1 + (size_t)kv * 1024 * 2048; J.ldt = 2048; J.n_begin = half * 512; J.n_rows = 512; }
        else { J.W = inp(P, bi + 7); J.ldw = 2048; J.K = 2048; J.WT = base + WE_NSA_WOUT; J.ldt = 2048; J.n_rows = 2048; }
    } else if (jid == 12) { J.W = inp(P, 13 + 3); J.ldw = DIL_N; J.K = 2048; J.WT = WB + WE_DIL; J.ldt = 2048; J.n_rows = DIL_N; J.map = MAP_DIL; }
    else if (jid == 13) { J.W = inp(P, 13 + 4); J.ldw = 2048; J.K = 2048; J.WT = WB + WE_DIL_WOUT; J.ldt = 2048; J.n_rows = 2048; }
    else if (jid == 14) { J.W = inp(P, 21 + 3); J.ldw = 2 * DRNN; J.K = 2048; J.WT = WB + WE_RG; J.ldt = 2048; J.n_rows = RG_N; J.map = MAP_RG; }
    else if (jid == 15) { J.W = inp(P, 21 + 9); J.ldw = 2048; J.K = DRNN; J.WT = WB + WE_RG_WOUT; J.ldt = DRNN; J.n_rows = 2048; }
    else { const int li = (jid - 16) >> 1, w = (jid - 16) & 1, bi = layer_base(li) + ff_off(li);
        if (w == 0) { J.W = inp(P, bi + 1); J.ldw = DFF; J.K = 2048; J.WT = WB + WE_FF + (size_t)li * 33554432; J.ldt = 2048; J.n_rows = DFF; }
        else { J.W = inp(P, bi + 2); J.ldw = 2048; J.K = DFF; J.WT = WB + WE_FF + (size_t)li * 33554432 + 16777216; J.ldt = DFF; J.n_rows = 2048; } }
    return J;
}

namespace fa {
typedef float f32x16 __attribute__((ext_vector_type(16)));
typedef short bf16x8 __attribute__((ext_vector_type(8)));
constexpr int KROW = 272, VROW = 144, KTILE = 64 * KROW, VTILE = 128 * VROW;
constexpr int KBUF0 = 0, VBUF0 = 3 * KTILE, IMP_OFF = VBUF0 + 2 * VTILE, MSK_OFF = RING_BYTES - 1024;
static_assert(IMP_OFF + 32768 <= MSK_OFF, "attention LDS map");
static_assert(MSK_OFF + 1024 <= RING_BYTES, "attention LDS map");
constexpr float C2 = ATT_SCALE * 1.4426950408889634f;
#define FA_MFMA(a, b, c) __builtin_amdgcn_mfma_f32_32x32x16_bf16(a, b, c, 0, 0, 0)
__device__ __forceinline__ float half_max(float v) { auto rr = __builtin_amdgcn_permlane32_swap(__float_as_uint(v), __float_as_uint(v), false, false); return fmaxf(__uint_as_float(rr[0]), __uint_as_float(rr[1])); }
__device__ __forceinline__ float half_sum(float v) { auto rr = __builtin_amdgcn_permlane32_swap(__float_as_uint(v), __float_as_uint(v), false, false); return __uint_as_float(rr[0]) + __uint_as_float(rr[1]); }
struct Src { const bf16* K0; long ldk; const bf16* V0; long ldv; int tsh; };
struct Stage { u32x4 k0, k1, v0, v1; };
__device__ __forceinline__ void stage_load_k(Stage& s, const Src& src, int T, int tid) {
    const int kr = tid >> 4, kc = tid & 15;
    const char* kb = (const char*)(src.K0 + (long)(64 * (T >> src.tsh)) * src.ldk); const char* kb2 = kb + 64 * src.ldk;
    unsigned ko = (unsigned)(kr * (int)src.ldk + kc * 8) * 2u; asm volatile("" : "+v"(ko));
    s.k0 = *(const u32x4*)(kb + ko); s.k1 = *(const u32x4*)(kb2 + ko);
}
__device__ __forceinline__ void stage_load_v(Stage& s, const Src& src, int T, int tid) {
    const int vr = tid >> 3, vp = tid & 7;
    const char* vb = (const char*)(src.V0 + 64 * (T >> src.tsh)); const char* vb2 = vb + 128 * src.ldv;
    unsigned vo = (unsigned)(vr * (int)src.ldv + vp * 8) * 2u; asm volatile("" : "+v"(vo));
    s.v0 = *(const u32x4*)(vb + vo); s.v1 = *(const u32x4*)(vb2 + vo);
}
__device__ __forceinline__ void stage_load(Stage& s, const Src& src, int T, int tid, bool withV) { stage_load_k(s, src, T, tid); if (withV) stage_load_v(s, src, T, tid); }
__device__ __forceinline__ void stage_write_k_at(const Stage& s, LAS unsigned char* ktile, int tid) {
    const int kr = tid >> 4, kc = tid & 15;
    LAS unsigned char* kb = ktile + kr * KROW + kc * 16;
    *(LAS u32x4*)kb = s.k0; *(LAS u32x4*)(kb + 32 * KROW) = s.k1;
}
__device__ __forceinline__ void stage_write_k(const Stage& s, LAS unsigned char* lds, int kbuf, int tid) { stage_write_k_at(s, lds + KBUF0 + kbuf * KTILE, tid); }
__device__ __forceinline__ void stage_write_v_at(const Stage& s, LAS unsigned char* vtile, int tid);
__device__ __forceinline__ void stage_write_v(const Stage& s, LAS unsigned char* lds, int vbuf, int tid) { stage_write_v_at(s, lds + VBUF0 + vbuf * VTILE, tid); }
__device__ __forceinline__ void stage_write_v_at(const Stage& s, LAS unsigned char* vtile, int tid) {
    const int vr = tid >> 3, vp = tid & 7, g16 = vp >> 1, half = vp & 1;
    LAS unsigned char* vb = vtile + vr * VROW + g16 * 32 + half * 8;
    *(LAS u32x2*)(vb) = (u32x2){s.v0.x, s.v0.y}; *(LAS u32x2*)(vb + 16) = (u32x2){s.v0.z, s.v0.w};
    *(LAS u32x2*)(vb + 64 * VROW) = (u32x2){s.v1.x, s.v1.y}; *(LAS u32x2*)(vb + 64 * VROW + 16) = (u32x2){s.v1.z, s.v1.w};
}
__device__ __forceinline__ void stage_write(const Stage& s, LAS unsigned char* lds, int buf, int tid, bool withV) { stage_write_k(s, lds, buf, tid); if (withV) stage_write_v(s, lds, buf, tid); }
__device__ __forceinline__ void load_q(bf16x8 (&qf)[8], const bf16* qrow, int hi) {
#pragma unroll
    for (int kk = 0; kk < 8; ++kk) qf[kk] = *(const bf16x8*)(qrow + kk * 16 + hi * 8);
}
#define FA_PIPE_16() do { __builtin_amdgcn_sched_group_barrier(0x100, 4, 0); \
    _Pragma("unroll") for (int i_ = 0; i_ < 12; ++i_) { __builtin_amdgcn_sched_group_barrier(0x008, 1, 0); __builtin_amdgcn_sched_group_barrier(0x100, 1, 0); } \
    __builtin_amdgcn_sched_group_barrier(0x008, 4, 0); } while (0)
__device__ __forceinline__ void qk_tile_at(f32x16& p0, f32x16& p1, const LAS unsigned char* ktile, const bf16x8 (&qf)[8], int c32, int hi);
__device__ __forceinline__ void qk_tile(f32x16& p0, f32x16& p1, const LAS unsigned char* lds, int buf, const bf16x8 (&qf)[8], int c32, int hi) { qk_tile_at(p0, p1, lds + KBUF0 + buf * KTILE, qf, c32, hi); }
__device__ __forceinline__ void qk_tile_at(f32x16& p0, f32x16& p1, const LAS unsigned char* ktile, const bf16x8 (&qf)[8], int c32, int hi) {
#pragma unroll
    for (int r = 0; r < 16; ++r) { p0[r] = 0.f; p1[r] = 0.f; }
    const LAS unsigned char* kb = ktile + c32 * KROW + hi * 16;
    bf16x8 a[16];
#pragma unroll
    for (int kk = 0; kk < 8; ++kk) { a[2 * kk] = *(const LAS bf16x8*)(kb + 32 * kk); a[2 * kk + 1] = *(const LAS bf16x8*)(kb + 32 * KROW + 32 * kk); }
#pragma unroll
    for (int kk = 0; kk < 8; ++kk) { p0 = FA_MFMA(a[2 * kk], qf[kk], p0); p1 = FA_MFMA(a[2 * kk + 1], qf[kk], p1); }
    FA_PIPE_16();
}
__device__ __forceinline__ void pv_tile_at(f32x16 (&o)[4], const LAS unsigned char* vtile, const bf16x8 (&pa)[4], int c32, int hi);
__device__ __forceinline__ void pv_tile(f32x16 (&o)[4], const LAS unsigned char* lds, int buf, const bf16x8 (&pa)[4], int c32, int hi) { pv_tile_at(o, lds + VBUF0 + buf * VTILE, pa, c32, hi); }
__device__ __forceinline__ void pv_tile_at(f32x16 (&o)[4], const LAS unsigned char* vtile, const bf16x8 (&pa)[4], int c32, int hi) {
    const LAS unsigned char* vb = vtile + c32 * VROW + hi * 16;
    bf16x8 a[16];
#pragma unroll
    for (int S = 0; S < 4; ++S)
#pragma unroll
        for (int db = 0; db < 4; ++db) a[4 * S + db] = *(const LAS bf16x8*)(vb + db * 32 * VROW + 32 * S);
#pragma unroll
    for (int S = 0; S < 4; ++S)
#pragma unroll
        for (int db = 0; db < 4; ++db) o[db] = FA_MFMA(a[4 * S + db], pa[S], o[db]);
    FA_PIPE_16();
}
__device__ __forceinline__ void mask_range(f32x16& p0, f32x16& p1, int lo, int hi_, int hi) {
    const int lo4 = lo - 4 * hi, hi4 = hi_ - 4 * hi;
#pragma unroll
    for (int r = 0; r < 16; ++r) { const int c = (r & 3) + 8 * (r >> 2);
        if (c < lo4 || c > hi4) p0[r] = -INFINITY;
        if (c + 32 < lo4 || c + 32 > hi4) p1[r] = -INFINITY; }
}
template <int B_> __device__ __forceinline__ bf16x8 pack8r(const f32x16& p) {
    u32x4 w; w.x = pk2(p[B_ + 0], p[B_ + 1]); w.y = pk2(p[B_ + 2], p[B_ + 3]); w.z = pk2(p[B_ + 4], p[B_ + 5]); w.w = pk2(p[B_ + 6], p[B_ + 7]);
    return __builtin_bit_cast(bf16x8, w); }
constexpr float THR = 8.0f;
__device__ __forceinline__ void softmax_step(f32x16& p0, f32x16& p1, bool rowoff, float& m, float& l, f32x16 (&o)[4], bf16x8 (&pa)[4]) {
    float mx = fmaxf(fmaxf(p0[0], p0[1]), p0[2]);
#pragma unroll
    for (int r = 3; r < 15; r += 2) mx = fmaxf(fmaxf(mx, p0[r]), p0[r + 1]);
    mx = fmaxf(mx, p0[15]);
#pragma unroll
    for (int r = 0; r < 16; r += 2) mx = fmaxf(fmaxf(mx, p1[r]), p1[r + 1]);
    mx = half_max(mx);
    if (rowoff) mx = -INFINITY;
    if (!__all((mx - m) * C2 <= THR)) {
        const float mn = fmaxf(m, mx), alpha = __builtin_amdgcn_exp2f((m - mn) * C2); m = mn; l *= alpha;
#pragma unroll
        for (int db = 0; db < 4; ++db) o[db] = o[db] * alpha;
    }
    const float mnL = rowoff ? -INFINITY : -m * C2;
    p0 = p0 * C2 + mnL; p1 = p1 * C2 + mnL;
#pragma unroll
    for (int r = 0; r < 16; ++r) { p0[r] = __builtin_amdgcn_exp2f(p0[r]); p1[r] = __builtin_amdgcn_exp2f(p1[r]); }
    f32x16 sv = p0 + p1;
    const float ps = ((sv[0] + sv[1]) + (sv[2] + sv[3])) + ((sv[4] + sv[5]) + (sv[6] + sv[7])) + (((sv[8] + sv[9]) + (sv[10] + sv[11])) + ((sv[12] + sv[13]) + (sv[14] + sv[15])));
    l += half_sum(ps);
    pa[0] = pack8r<0>(p0); pa[1] = pack8r<8>(p0); pa[2] = pack8r<0>(p1); pa[3] = pack8r<8>(p1);
}
struct Msk { int qlo, qhi; const LAS unsigned* sel; };
#define FA_PIPE_8() do { __builtin_amdgcn_sched_group_barrier(0x100, 4, 0); \
    _Pragma("unroll") for (int i_ = 0; i_ < 4; ++i_) { __builtin_amdgcn_sched_group_barrier(0x008, 1, 0); __builtin_amdgcn_sched_group_barrier(0x100, 1, 0); } \
    __builtin_amdgcn_sched_group_barrier(0x008, 4, 0); } while (0)
__device__ __forceinline__ void qk_half(f32x16& p, const LAS unsigned char* lds, int kbuf, int half, const bf16x8 (&qf)[8], int c32, int hi) {
#pragma unroll
    for (int r = 0; r < 16; ++r) p[r] = 0.f;
    const LAS unsigned char* kb = lds + KBUF0 + kbuf * KTILE + half * 32 * KROW + c32 * KROW + hi * 16;
    bf16x8 a[8];
#pragma unroll
    for (int kk = 0; kk < 8; ++kk) a[kk] = *(const LAS bf16x8*)(kb + 32 * kk);
#pragma unroll
    for (int kk = 0; kk < 8; ++kk) p = FA_MFMA(a[kk], qf[kk], p);
    FA_PIPE_8();
}
__device__ __forceinline__ void pv_half(f32x16 (&o)[4], const LAS unsigned char* lds, int vbuf, int half, const bf16x8 (&pa)[2], int c32, int hi) {
    const LAS unsigned char* vb = lds + VBUF0 + vbuf * VTILE + c32 * VROW + hi * 16 + half * 64;
    bf16x8 a[8];
#pragma unroll
    for (int s2 = 0; s2 < 2; ++s2)
#pragma unroll
        for (int db = 0; db < 4; ++db) a[4 * s2 + db] = *(const LAS bf16x8*)(vb + db * 32 * VROW + 32 * s2);
#pragma unroll
    for (int s2 = 0; s2 < 2; ++s2)
#pragma unroll
        for (int db = 0; db < 4; ++db) o[db] = FA_MFMA(a[4 * s2 + db], pa[s2], o[db]);
    FA_PIPE_8();
}
__device__ __forceinline__ void softmax_half(f32x16& p, int half, bool needrange, int lo, int hi_, int hi, bool rowoff, float& m, float& l, f32x16 (&o)[4], bf16x8 (&pa)[2]) {
    if (needrange) { const int lo4 = lo - 4 * hi - 32 * half, hi4 = hi_ - 4 * hi - 32 * half;
#pragma unroll
        for (int r = 0; r < 16; ++r) { const int c = (r & 3) + 8 * (r >> 2); if (c < lo4 || c > hi4) p[r] = -INFINITY; } }
    float mx = fmaxf(fmaxf(p[0], p[1]), p[2]);
#pragma unroll
    for (int r = 3; r < 15; r += 2) mx = fmaxf(fmaxf(mx, p[r]), p[r + 1]);
    mx = half_max(fmaxf(mx, p[15]));
    if (rowoff) mx = -INFINITY;
    if (!__all((mx - m) * C2 <= THR)) {
        const float mn = fmaxf(m, mx), alpha = __builtin_amdgcn_exp2f((m - mn) * C2); m = mn; l *= alpha;
#pragma unroll
        for (int db = 0; db < 4; ++db) o[db] = o[db] * alpha;
    }
    const float mnL = rowoff ? -INFINITY : -m * C2;
#pragma unroll
    for (int r = 0; r < 16; ++r) p[r] = __builtin_amdgcn_exp2f(fmaf(p[r], C2, mnL));
    const float ps = (((p[0] + p[1]) + (p[2] + p[3])) + ((p[4] + p[5]) + (p[6] + p[7]))) + (((p[8] + p[9]) + (p[10] + p[11])) + ((p[12] + p[13]) + (p[14] + p[15])));
    l += half_sum(ps);
    pa[0] = pack8r<0>(p); pa[1] = pack8r<8>(p);
}
__device__ __forceinline__ void flash_flags(const Msk& mk, int Tt, int tsh, int& lo, int& hi_, bool& rowoff) {
    const int T = Tt >> tsh;
    lo = mk.qlo - 64 * T; hi_ = mk.qhi - 64 * T;
    rowoff = !(hi_ >= 0 && lo <= 63);
    if (mk.sel) { const unsigned w = mk.sel[T >> 5]; rowoff = rowoff || (((w >> (T & 31)) & 1u) == 0u); }
}
__device__ __forceinline__ void flash_pass(LAS unsigned char* lds, int tid, int c32, int hi, int T0, int T1, const Src& src, const Msk& mk, const bf16x8 (&qf)[8],
                                           float& m, float& l, f32x16 (&o)[4]) {
    Stage st; f32x16 sA, sB;
    const int n = T1 - T0 + 1; const bool lateqk = __builtin_amdgcn_readfirstlane(tid >> 8) != 0;
    __syncthreads();
    {   Stage st1;
        stage_load(st, src, T0, tid, true); if (n > 1) stage_load_k(st1, src, T0 + 1, tid);
        stage_write(st, lds, 0, tid, true); if (n > 1) stage_write_k(st1, lds, 1, tid); }
    if (n > 2) stage_load_k(st, src, T0 + 2, tid);
    if (n > 1) stage_load_v(st, src, T0 + 1, tid);
    __syncthreads();
    int lo, hi_; bool rowoff; flash_flags(mk, T0, src.tsh, lo, hi_, rowoff);
    bool act = !__all(rowoff);
    if (act) qk_half(sA, lds, 0, 0, qf, c32, hi);
#pragma unroll 1
    for (int i = 0; i < n; ++i) {
        if (i > 0) __syncthreads();
        if (i + 2 < n) stage_write_k(st, lds, (i + 2) % 3, tid);
        if (i + 1 < n) stage_write_v(st, lds, (i + 1) & 1, tid);
        if (i + 3 < n) stage_load_k(st, src, T0 + i + 3, tid);
        if (i + 2 < n) stage_load_v(st, src, T0 + i + 2, tid);
        const bool needrange = __any(!rowoff && !(lo <= 0 && hi_ >= 63));
        bf16x8 pa[2];
        if (act) { if (!lateqk) qk_half(sB, lds, i % 3, 1, qf, c32, hi);
                   softmax_half(sA, 0, needrange, lo, hi_, hi, rowoff, m, l, o, pa); pv_half(o, lds, i & 1, 0, pa, c32, hi);
                   if (lateqk) qk_half(sB, lds, i % 3, 1, qf, c32, hi); }
        int lo2 = 0, hi2 = 0; bool off2 = true, act2 = false;
        if (i + 1 < n) { flash_flags(mk, T0 + i + 1, src.tsh, lo2, hi2, off2); act2 = !__all(off2); }
        if (act2 && !lateqk) qk_half(sA, lds, (i + 1) % 3, 0, qf, c32, hi);
        if (act) { softmax_half(sB, 1, needrange, lo, hi_, hi, rowoff, m, l, o, pa); pv_half(o, lds, i & 1, 1, pa, c32, hi); }
        if (act2 && lateqk) qk_half(sA, lds, (i + 1) % 3, 0, qf, c32, hi);
        lo = lo2; hi_ = hi2; rowoff = off2; act = act2;
    }
}

constexpr int ASLOT = KTILE + VTILE;
constexpr int ANSLOT = 4;
static_assert(ANSLOT * ASLOT <= MSK_OFF, "async ring must not reach the selection masks");
__device__ __forceinline__ void lds_signal(volatile LAS unsigned* w, int lane) {
    asm volatile("s_waitcnt lgkmcnt(0)" ::: "memory");
    if (lane == 0) (void)__hip_atomic_fetch_add((LAS unsigned*)w, 1u, __ATOMIC_RELAXED, __HIP_MEMORY_SCOPE_WORKGROUP);
}
__device__ __forceinline__ void lds_wait(volatile LAS unsigned* w, unsigned target) {
    unsigned spins = 0;
    while ((unsigned)__builtin_amdgcn_readfirstlane(*w) < target) { __builtin_amdgcn_s_sleep(1); if (++spins > (1u << 22)) break; }
    asm volatile("" ::: "memory");
}
__device__ __forceinline__ void flash_pass_async(LAS unsigned char* lds, int tid, int lane, int c32, int hi, int T0, int T1, const Src& src, const Msk& mk, const bf16x8 (&qf)[8],
                                                 float& m, float& l, f32x16 (&o)[4]) {
    volatile LAS unsigned* fill = (volatile LAS unsigned*)(lds + RING_BYTES + 2048); volatile LAS unsigned* done = fill + 8;
    const int n = T1 - T0 + 1;
    Stage st;
    __syncthreads();
    if (tid < 16) fill[tid] = 0u;
    stage_load(st, src, T0, tid, true);
    __syncthreads();
    stage_write_k_at(st, lds, tid); stage_write_v_at(st, lds + KTILE, tid); lds_signal(fill + 0, lane);
    if (n > 1) stage_load(st, src, T0 + 1, tid, true);
#pragma unroll 1
    for (int i = 0; i < n; ++i) {
        const int s0 = i % ANSLOT;
        if (i + 1 < n) { const int s1 = (i + 1) % ANSLOT;
            lds_wait(done + s1, 8u * (unsigned)((i + 1) / ANSLOT));
            stage_write_k_at(st, lds + s1 * ASLOT, tid); stage_write_v_at(st, lds + s1 * ASLOT + KTILE, tid); lds_signal(fill + s1, lane);
            if (i + 2 < n) stage_load(st, src, T0 + i + 2, tid, true); }
        int lo, hi_; bool rowoff; flash_flags(mk, T0 + i, src.tsh, lo, hi_, rowoff);
        if (!__all(rowoff)) {
            lds_wait(fill + s0, 8u * (unsigned)(i / ANSLOT + 1));
            f32x16 p0, p1; bf16x8 pa[4];
            qk_tile_at(p0, p1, lds + s0 * ASLOT, qf, c32, hi);
            if (__any(!rowoff && !(lo <= 0 && hi_ >= 63))) mask_range(p0, p1, lo, hi_, hi);
            softmax_step(p0, p1, rowoff, m, l, o, pa);
            pv_tile_at(o, lds + s0 * ASLOT + KTILE, pa, c32, hi);
        }
        lds_signal(done + s0, lane);
    }
}
}

__device__ __forceinline__ void nsa_item(LAS unsigned char* lds, int wave, int lane, int b, int g, int c, const bf16* Q, const bf16* QR, const bf16* KCB, const bf16* VCT,
                                         const bf16* KS, const bf16* KW, const bf16* VT, const float* GT, float* OACC, bf16* ATT) {
    using namespace fa;
    const int tid = wave * 64 + lane, c32 = lane & 31, hi = lane >> 5;
    const int tl = wave * 8 + (c32 >> 2), head = c32 & 3, t = c * 64 + tl, mrow = b * SEQ + t, hq = g * 4 + head, bg = b * 4 + g;
    LAS float* IMP = (LAS float*)(lds + IMP_OFF); LAS unsigned* MSK = (LAS unsigned*)(lds + MSK_OFF);
    bf16x8 qf[8]; f32x16 o[4]; float m, l; u32x4 pk[8];
#define NSA_PTRS() int mr_ = mrow, hq_ = hq; asm volatile("" : "+v"(mr_), "+v"(hq_)); const float* gp = GT + (size_t)(mr_ * 48 + hq_ * 3); float* oacc = OACC + (size_t)mr_ * 2048 + (unsigned)(hq_ * 128); (void)gp; (void)oacc
    {
        { int mr_ = mrow, hq_ = hq; asm volatile("" : "+v"(mr_), "+v"(hq_)); load_q(qf, Q + (size_t)mr_ * 2048 + (unsigned)(hq_ * 128), hi); }
        const int NTc = (4 * c + 3 + 63) >> 6;
        const int qhi = (t - 31) >> 4;
        const Src src{KCB + (size_t)bg * 512 * 128, 128, VCT + (size_t)bg * 128 * 512, 512, 0};
        m = -1e30f; l = 0.f;
        Stage st;
        __syncthreads();
        stage_load(st, src, 0, tid, false);
#pragma unroll 1
        for (int T = 0; T < NTc; ++T) {
            const int buf = T & 1;
            stage_write(st, lds, buf, tid, false);
            __syncthreads();
            if (T + 1 < NTc) stage_load(st, src, T + 1, tid, false);
            f32x16 p0, p1;
            qk_tile(p0, p1, lds, buf, qf, c32, hi);
            mask_range(p0, p1, 0, qhi - 64 * T, hi);
            float mx = p0[0];
#pragma unroll
            for (int r = 1; r < 16; ++r) mx = fmaxf(mx, p0[r]);
#pragma unroll
            for (int r = 0; r < 16; ++r) mx = fmaxf(mx, p1[r]);
            mx = half_max(mx);
            const float mn = fmaxf(m, mx), alpha = __builtin_amdgcn_exp2f((m - mn) * C2), mnL = -mn * C2; m = mn;
            float ps = 0.f;
#pragma unroll
            for (int r = 0; r < 16; ++r) ps += __builtin_amdgcn_exp2f(fmaf(p0[r], C2, mnL)) + __builtin_amdgcn_exp2f(fmaf(p1[r], C2, mnL));
            l = l * alpha + half_sum(ps);
        }
        const float inv = l > 0.f ? 1.0f / l : 0.f, mnL = -m * C2;
#pragma unroll
        for (int db = 0; db < 4; ++db)
#pragma unroll
            for (int r = 0; r < 16; ++r) o[db][r] = 0.f;
        float carry = 0.f;
        __syncthreads();
        stage_load(st, src, 0, tid, true);
#pragma unroll 1
        for (int T = 0; T < NTc; ++T) {
            const int buf = T & 1;
            stage_write(st, lds, buf, tid, true);
            __syncthreads();
            if (T + 1 < NTc) stage_load(st, src, T + 1, tid, true);
            f32x16 p0, p1; bf16x8 pa[4];
            qk_tile(p0, p1, lds, buf, qf, c32, hi);
            mask_range(p0, p1, 0, qhi - 64 * T, hi);
#pragma unroll
            for (int r = 0; r < 16; ++r) { p0[r] = __builtin_amdgcn_exp2f(fmaf(p0[r], C2, mnL)) * inv; p1[r] = __builtin_amdgcn_exp2f(fmaf(p1[r], C2, mnL)) * inv; }
#pragma unroll
            for (int hf = 0; hf < 2; ++hf) {
                float qs[4], flo[4], fhi[4];
#pragma unroll
                for (int q4 = 0; q4 < 4; ++q4) {
                    const float e0 = hf ? p1[4 * q4] : p0[4 * q4], e1 = hf ? p1[4 * q4 + 1] : p0[4 * q4 + 1], e2 = hf ? p1[4 * q4 + 2] : p0[4 * q4 + 2], e3 = hf ? p1[4 * q4 + 3] : p0[4 * q4 + 3];
                    qs[q4] = (e0 + e1) + (e2 + e3);
                    auto rr = __builtin_amdgcn_permlane32_swap(__float_as_uint(e3), __float_as_uint(e3), false, false);
                    flo[q4] = __uint_as_float(rr[0]); fhi[q4] = __uint_as_float(rr[1]);
                }
#pragma unroll
                for (int q4 = 0; q4 < 4; ++q4) {
                    const float cin = hi ? flo[q4] : (q4 == 0 ? carry : fhi[q4 == 0 ? 0 : q4 - 1]);
                    float v = qs[q4] + cin; v += __shfl_xor(v, 1); v += __shfl_xor(v, 2);
                    if (head == 0) IMP[tl * 128 + 16 * T + 8 * hf + 2 * q4 + hi] = v;
                }
                carry = fhi[3];
            }
            pa[0] = pack8r<0>(p0); pa[1] = pack8r<8>(p0); pa[2] = pack8r<0>(p1); pa[3] = pack8r<8>(p1);
            pv_tile(o, lds, buf, pa, c32, hi);
        }
        NSA_PTRS();
        const float g0 = gp[0];
#pragma unroll
        for (int db = 0; db < 4; ++db)
#pragma unroll
            for (int q4 = 0; q4 < 4; ++q4) { pk[2 * db + (q4 >> 1)][2 * (q4 & 1)] = pk2(o[db][4 * q4] * g0, o[db][4 * q4 + 1] * g0); pk[2 * db + (q4 >> 1)][2 * (q4 & 1) + 1] = pk2(o[db][4 * q4 + 2] * g0, o[db][4 * q4 + 3] * g0); }
    }
    LDS_WAIT();
#ifndef REP_TOPK
#define REP_TOPK 1
#endif
#pragma unroll 1
    for (int rep_ = 0; rep_ < fresh_s(REP_TOPK); ++rep_)
#pragma unroll 1
    for (int tk = 0; tk < 8; ++tk) {
        LAS float* row = IMP + (wave * 8 + tk) * 128;
        const int j0 = lane, j1 = lane + 64;
        const float v0 = row[j0], v1 = row[j1];
        const float val0 = j0 > c ? -INFINITY : ((j0 == 0 || j0 == c || j0 == c - 1) ? 3.0e38f : v0);
        const float val1 = j1 > c ? -INFINITY : ((j1 == c || j1 == c - 1) ? 3.0e38f : v1);
        LDS_WAIT();
        row[j0] = val0; row[j1] = val1;
        LDS_WAIT();
        int cnt0 = 0, cnt1 = 0;
#pragma unroll 4
        for (int i4 = 0; i4 <= (c >> 2); ++i4) {
            const f32x4 x = *(const LAS f32x4*)(row + 4 * i4);
#pragma unroll
            for (int e = 0; e < 4; ++e) { const int i = 4 * i4 + e; cnt0 += (x[e] > val0 || (x[e] == val0 && i < j0)) ? 1 : 0; cnt1 += (x[e] > val1 || (x[e] == val1 && i < j1)) ? 1 : 0; } }
        const unsigned long long m0 = __ballot(j0 <= c && cnt0 < 16), m1 = __ballot(j1 <= c && cnt1 < 16);
        if (lane == 0) { LAS unsigned* mp = MSK + (wave * 8 + tk) * 4; mp[0] = (unsigned)m0; mp[1] = (unsigned)(m0 >> 32); mp[2] = (unsigned)m1; mp[3] = (unsigned)(m1 >> 32); }
    }
    LDS_WAIT();
    { int mr_ = mrow, hq_ = hq; asm volatile("" : "+v"(mr_), "+v"(hq_)); load_q(qf, QR + (size_t)mr_ * 2048 + (unsigned)(hq_ * 128), hi); }
    {
        Msk mk; mk.qlo = 0; mk.qhi = t; mk.sel = MSK + tl * 4;
        #ifdef PROBE_SEL2
        const Src src{KS + (size_t)b * SEQ * 512 + g * 128, 512, VT + (size_t)(g * 128) * LDV + (size_t)b * SEQ, LDV, 1};
#else
        const Src src{KS + (size_t)b * SEQ * 512 + g * 128, 512, VT + (size_t)(g * 128) * LDV + (size_t)b * SEQ, LDV, 0};
#endif
#ifndef REP_SEL
#define REP_SEL 1
#endif
        m = -1e30f; l = 0.f;
#pragma unroll
        for (int db = 0; db < 4; ++db)
#pragma unroll
            for (int r = 0; r < 16; ++r) o[db][r] = 0.f;
#ifdef PROBE_SEL2
        flash_pass(lds, tid, c32, hi, 0, 2 * c + 1, src, mk, qf, m, l, o);
#else
        flash_pass_async(lds, tid, lane, c32, hi, 0, c, src, mk, qf, m, l, o);
#endif
        NSA_PTRS();
        const float sc = gp[1] / l;
#pragma unroll
        for (int db = 0; db < 4; ++db)
#pragma unroll
            for (int q4 = 0; q4 < 4; ++q4) { const unsigned w0 = pk[2 * db + (q4 >> 1)][2 * (q4 & 1)], w1 = pk[2 * db + (q4 >> 1)][2 * (q4 & 1) + 1];
                pk[2 * db + (q4 >> 1)][2 * (q4 & 1)] = pk2(lo_bf(w0) + o[db][4 * q4] * sc, hi_bf(w0) + o[db][4 * q4 + 1] * sc);
                pk[2 * db + (q4 >> 1)][2 * (q4 & 1) + 1] = pk2(lo_bf(w1) + o[db][4 * q4 + 2] * sc, hi_bf(w1) + o[db][4 * q4 + 3] * sc); }
    }
    {
        Msk mk; mk.qlo = t - 511; mk.qhi = t; mk.sel = nullptr;
        const Src src{KW + (size_t)b * SEQ * 512 + g * 128, 512, VT + (size_t)(512 + g * 128) * LDV + (size_t)b * SEQ, LDV, 0};
        m = -1e30f; l = 0.f;
#pragma unroll
        for (int db = 0; db < 4; ++db)
#pragma unroll
            for (int r = 0; r < 16; ++r) o[db][r] = 0.f;
        flash_pass(lds, tid, c32, hi, c >= 8 ? c - 8 : 0, c, src, mk, qf, m, l, o);
        NSA_PTRS();
        const float sc = gp[2] / l;
        bf16* arow = ATT + (size_t)mr_ * 2048 + (unsigned)(hq_ * 128);
#pragma unroll
        for (int db = 0; db < 4; ++db)
#pragma unroll
            for (int qp = 0; qp < 2; ++qp) {
                unsigned f[2][2];
#pragma unroll
                for (int e = 0; e < 2; ++e) { const int q4 = 2 * qp + e; const unsigned w0 = pk[2 * db + qp][2 * e], w1 = pk[2 * db + qp][2 * e + 1];
                    f[e][0] = pk2(lo_bf(w0) + o[db][4 * q4] * sc, hi_bf(w0) + o[db][4 * q4 + 1] * sc); f[e][1] = pk2(lo_bf(w1) + o[db][4 * q4 + 2] * sc, hi_bf(w1) + o[db][4 * q4 + 3] * sc); }
                auto r0 = __builtin_amdgcn_permlane32_swap(f[0][0], f[1][0], false, false); auto r1 = __builtin_amdgcn_permlane32_swap(f[0][1], f[1][1], false, false);
                u32x4 w; w.x = r0[0]; w.y = r1[0]; w.z = r0[1]; w.w = r1[1];
                *(u32x4*)(arow + 32 * db + 16 * qp + 8 * hi) = w; }
    }
#undef NSA_PTRS
}

__device__ __forceinline__ void dil_item(LAS unsigned char* lds, int wave, int lane, int p, int sq, int h, int qb, const bf16* QK, const bf16* VT, bf16* OB, float* ML, bf16* ATT) {
    using namespace fa;
    const int tid = wave * 64 + lane, c32 = lane & 31, hi = lane >> 5, dsh = 2 * p, L = SEQ >> dsh;
    const int b = sq >> dsh, r = sq & ((1 << dsh) - 1), q = qb * 256 + wave * 32 + c32, mrow = b * SEQ + (q << dsh) + r;
    const size_t seqbase = (size_t)sq * L;
    bf16x8 qf[8]; f32x16 o[4]; float m = -1e30f, l = 0.f;
    load_q(qf, QK + (seqbase + q) * 4096 + h * 128, hi);
#pragma unroll
    for (int db = 0; db < 4; ++db)
#pragma unroll
        for (int rr = 0; rr < 16; ++rr) o[db][rr] = 0.f;
    Msk mk; mk.qlo = q - 128; mk.qhi = q; mk.sel = nullptr;
    const Src src{QK + seqbase * 4096 + 2048 + h * 128, 4096, VT + (size_t)(h * 128) * LDV + seqbase, LDV, 0};
    flash_pass(lds, tid, c32, hi, qb * 4 >= 2 ? qb * 4 - 2 : 0, qb * 4 + 3, src, mk, qf, m, l, o);
    int mr_ = mrow; asm volatile("" : "+v"(mr_));
    float sc2 = 1.0f / l, u0 = 0.f, u1 = 0.f;
    const bf16* ob0 = OB + (size_t)mr_ * 2048 + h * 128; const bf16* ob1 = ob0 + (size_t)M * 2048;
    if (p == 2) {
        const f32x2 ml0 = *(const f32x2*)(ML + ((size_t)mr_ * 16 + h) * 2), ml1 = *(const f32x2*)(ML + (size_t)M * 32 + ((size_t)mr_ * 16 + h) * 2);
        const float Mx = fmaxf(fmaxf(ml0[0], ml1[0]), m);
        u0 = ml0[1] * __builtin_amdgcn_exp2f((ml0[0] - Mx) * C2); u1 = ml1[1] * __builtin_amdgcn_exp2f((ml1[0] - Mx) * C2);
        const float e2 = __builtin_amdgcn_exp2f((m - Mx) * C2), iw = 1.0f / (u0 + u1 + l * e2);
        sc2 = e2 * iw; u0 *= iw; u1 *= iw;
    }
    bf16* orow = (p == 2 ? ATT : OB + (size_t)p * M * 2048) + (size_t)mr_ * 2048 + h * 128;
#pragma unroll
    for (int db = 0; db < 4; ++db)
#pragma unroll
        for (int qp = 0; qp < 2; ++qp) {
            f32x4 v[2];
#pragma unroll
            for (int e = 0; e < 2; ++e) { const int q4 = 2 * qp + e; v[e] = (f32x4){o[db][4 * q4] * sc2, o[db][4 * q4 + 1] * sc2, o[db][4 * q4 + 2] * sc2, o[db][4 * q4 + 3] * sc2}; }
            if (p == 2) {
                const u32x4 w0 = *(const u32x4*)(ob0 + 32 * db + 16 * qp + 8 * hi), w1 = *(const u32x4*)(ob1 + 32 * db + 16 * qp + 8 * hi);
                auto a0 = __builtin_amdgcn_permlane32_swap(w0.x, w0.z, false, false); auto a1 = __builtin_amdgcn_permlane32_swap(w0.y, w0.w, false, false);
                auto b0 = __builtin_amdgcn_permlane32_swap(w1.x, w1.z, false, false); auto b1 = __builtin_amdgcn_permlane32_swap(w1.y, w1.w, false, false);
#pragma unroll
                for (int e = 0; e < 2; ++e) {
                    v[e][0] += u0 * lo_bf(a0[e]) + u1 * lo_bf(b0[e]); v[e][1] += u0 * hi_bf(a0[e]) + u1 * hi_bf(b0[e]);
                    v[e][2] += u0 * lo_bf(a1[e]) + u1 * lo_bf(b1[e]); v[e][3] += u0 * hi_bf(a1[e]) + u1 * hi_bf(b1[e]); }
            }
            unsigned f[2][2];
#pragma unroll
            for (int e = 0; e < 2; ++e) { f[e][0] = pk2(v[e][0], v[e][1]); f[e][1] = pk2(v[e][2], v[e][3]); }
            auto r0 = __builtin_amdgcn_permlane32_swap(f[0][0], f[1][0], false, false); auto r1 = __builtin_amdgcn_permlane32_swap(f[0][1], f[1][1], false, false);
            u32x4 w; w.x = r0[0]; w.y = r1[0]; w.z = r0[1]; w.w = r1[1];
            *(u32x4*)(orow + 32 * db + 16 * qp + 8 * hi) = w; }
    if (p < 2 && hi == 0) *(f32x2*)(ML + (size_t)p * M * 32 + ((size_t)mr_ * 16 + h) * 2) = (f32x2){m, l};
}

__device__ __forceinline__ void modulate_row(const float* x32, const bf16* x16, const float* gain, const float* shift, const float* scale, bf16* orow, float* frow, int lane) {
    f32x4 v[8]; float ss = 0.f;
    if (x32) {
#pragma unroll
        for (int j = 0; j < 8; ++j) v[j] = *(const f32x4*)(x32 + 4 * lane + 256 * j);
    } else {
        u32x2 w[8];
#pragma unroll
        for (int j = 0; j < 8; ++j) w[j] = *(const u32x2*)(x16 + 4 * lane + 256 * j);
#pragma unroll
        for (int j = 0; j < 8; ++j) v[j] = (f32x4){lo_bf(w[j].x), hi_bf(w[j].x), lo_bf(w[j].y), hi_bf(w[j].y)};
    }
#pragma unroll
    for (int j = 0; j < 8; ++j) ss += (v[j][0] * v[j][0] + v[j][1] * v[j][1]) + (v[j][2] * v[j][2] + v[j][3] * v[j][3]);
    const float rinv = rsqrtf(wave_sum(ss) * (1.0f / D) + NORM_EPS);
#pragma unroll
    for (int j = 0; j < 8; ++j) {
        const int col = 4 * lane + 256 * j;
        const f32x4 gn = *(const f32x4*)(gain + col);
        f32x4 r = v[j] * rinv * gn;
        if (shift) { const f32x4 sh = *(const f32x4*)(shift + col), sc = *(const f32x4*)(scale + col); r = r * (1.0f + sc) + sh;
            u32x2 w; w.x = pk2(r[0], r[1]); w.y = pk2(r[2], r[3]); *(u32x2*)(orow + col) = w; }
        else *(f32x4*)(frow + col) = r;
    }
}

__device__ __forceinline__ unsigned char* wsp_(unsigned char* ws, size_t off) { asm volatile("" : "+s"(off)); return ws + off; }
#define FRESH_IDS() const int wave = fresh_s(wave_s), lane = lane_id_asm(), tid = wave * 64 + lane; (void)tid; \
    const int Gf_ = fresh_s(G), bx_ = fresh_s((int)blockIdx.x); const int gw = bx_ * NWAVES + wave, NGW = Gf_ * NWAVES, gtid = bx_ * NTHREADS + tid, NGT = Gf_ * NTHREADS; \
    LAS float* wl = (LAS float*)(lds + wave * 16384); (void)lane; (void)gw; (void)NGW; (void)gtid; (void)NGT; (void)wl
__global__ void __launch_bounds__(NTHREADS, 2) mega_fwd(Params P) {
    extern __shared__ __attribute__((aligned(16))) unsigned char lds_raw[];
    LAS unsigned char* lds = (LAS unsigned char*)lds_raw;
    volatile LAS unsigned* MISC = (volatile LAS unsigned*)(lds + MISC_OFF);
    const int G = gridDim.x;
    unsigned char* ws = P.ws;
    for (int u = threadIdx.x; u < (LDS_BYTES - RING_BYTES) / 4; u += NTHREADS) ((LAS unsigned*)(lds + RING_BYTES))[u] = 0u;
    __syncthreads();
    const int wave_s = __builtin_amdgcn_readfirstlane(threadIdx.x >> 6);
    XcdBarrier bar = xcd_barrier_post((unsigned*)(ws + WS_CTL) + 4096, MISC + 8); bar.wave = wave_s;
#define GRID_BAR() xcd_barrier(bar)
#define WSP(T, off) ((T*)wsp_(ws, (off)))
#define CONVERT_JOBS(j0, j1) do { _Pragma("unroll 1") for (int jid = (j0); jid < (j1); ++jid) { const Job J = get_job(P, jid); const int nitems = (J.K / 64) * (J.n_rows / 32); \
        for (int it = gw; it < nitems; it += CONV_NI * NGW) conv_items<CONV_NI>(J, it, NGW, nitems, wl, lane); } } while (0)

    {
        FRESH_IDS();
        float* MODP = WSP(float, WS_MODP); float* COS = WSP(float, WS_COS); float* SIN = WSP(float, WS_SIN); float* BPEP = WSP(float, WS_BPEP); float* LSP = WSP(float, WS_LSP);
        const float* cv = inp(P, IN_C);
        for (int task = gw; task < 4 * 48 * 8; task += NGW) {
            const int kc = task & 7, cg = (task >> 3) % 48, l = task / (8 * 48);
            const float* w = inp(P, layer_base(l)) + (size_t)cg * 256 + lane * 4;
            f32x4 a0 = {0.f, 0.f, 0.f, 0.f}, a1 = {0.f, 0.f, 0.f, 0.f};
#pragma unroll 8
            for (int k = kc * 256; k < kc * 256 + 256; ++k) {
                const float c0 = cv[k], c1 = cv[2048 + k];
                const float s0 = c0 / (1.0f + __expf(-c0)), s1 = c1 / (1.0f + __expf(-c1));
                const f32x4 wv = __builtin_nontemporal_load((const f32x4*)(w + (size_t)k * 12288));
                a0 += s0 * wv; a1 += s1 * wv;
            }
            *(f32x4*)(MODP + ((size_t)((kc * 4 + l) * 2 + 0)) * 12288 + cg * 256 + lane * 4) = a0;
            *(f32x4*)(MODP + ((size_t)((kc * 4 + l) * 2 + 1)) * 12288 + cg * 256 + lane * 4) = a1;
        }
        for (int i = gtid; i < SEQ * 64; i += NGT) {
            const int t = i >> 6, f = i & 63;
            const double invf = exp2(-(double)f * (13.287712379549449 / 64.0));
            const double ang = (double)t * invf;
            const double n = rint(ang * 0.15915494309189535);
            const double r = (ang - n * 6.283185307179586) - n * 2.4492935982947064e-16;
            COS[i] = (float)cos(r); SIN[i] = (float)sin(r);
        }
        for (int task = gw; task < 2 * 2 * 2 * 16; task += NGW) {
            const int kc = task & 15, cg = (task >> 4) & 1, kv = (task >> 5) & 1, slot = task >> 6;
            const int bi = slot == 0 ? 2 : 34;
            const float* pe = inp(P, bi + 4) + kv * 4096; const float* w = inp(P, bi + 5) + (size_t)kv * 4096 * 512 + cg * 256 + lane * 4;
            f32x4 a = {0.f, 0.f, 0.f, 0.f};
#pragma unroll 8
            for (int k = kc * 256; k < kc * 256 + 256; ++k) a += pe[k] * *(const f32x4*)(w + (size_t)k * 512);
            *(f32x4*)(BPEP + (size_t)((kc * 2 + slot) * 2 + kv) * 512 + cg * 256 + lane * 4) = a;
        }
        { const float* lamp = inp(P, 21 + 8);
          for (int i = gtid; i < DRNN; i += NGT) { const double lam = (double)lamp[i]; LSP[i] = (float)(-8.0 * log1p(exp(-lam))); } }
    }
    GRID_BAR();
    {
        FRESH_IDS();
        CONVERT_JOBS(0, NJOBS_FIRST);
        {
            const float* wg = inp(P, 21 + 6); bf16* WG = WSP(bf16, WS_W) + WE_RG_WG;
            for (long i = gtid; i < (long)5376 * (DRNN / 8); i += NGT) {
                const int row = (int)(i / (DRNN / 8)), k8 = (int)(i % (DRNN / 8)) * 8;
                const int gate = (row >> 7) & 1, ch = (row >> 8) * 128 + (row & 127), nb = ch / 168, dd = ch % 168;
                float v[8];
#pragma unroll
                for (int e = 0; e < 8; ++e) { const int k = k8 + e; v[e] = (k / 168 == nb) ? wg[((size_t)(gate * 16 + nb) * 168 + (k % 168)) * 168 + dd] : 0.f; }
                u32x4 o; o.x = pk2(v[0], v[1]); o.y = pk2(v[2], v[3]); o.z = pk2(v[4], v[5]); o.w = pk2(v[6], v[7]);
                *(u32x4*)(WG + (size_t)row * DRNN + k8) = o;
            }
        }
        {   const float* MODP = WSP(float, WS_MODP); float* MOD = WSP(float, WS_MOD);
#pragma unroll 1
            for (int l = 0; l < 4; ++l) { const float* bias = inp(P, layer_base(l) + 1);
                for (int i = gtid; i < 2 * 12288; i += NGT) {
                    const int col = i % 12288, lb = l * 2 + i / 12288;
                    float a = bias[col];
#pragma unroll
                    for (int kc = 0; kc < 8; ++kc) a += MODP[(size_t)(kc * 8 + lb) * 12288 + col];
                    MOD[(size_t)lb * 12288 + col] = a;
                } }
            const float* BPEP = WSP(float, WS_BPEP); float* BPE = WSP(float, WS_BPE);
            for (int i = gtid; i < 2 * 2 * 512; i += NGT) { float a = 0.f;
#pragma unroll
                for (int kc = 0; kc < 16; ++kc) a += BPEP[(size_t)kc * 2048 + i];
                BPE[i] = a; }
        }
    }
    GRID_BAR();

#pragma unroll 1
    for (int li = 0; li < 4; ++li) {
        const int kind = li % 3, bi = layer_base(li);
        {   FRESH_IDS();
            const float* x32 = li == 0 ? inp(P, IN_X) : (const float*)nullptr; const bf16* XR = WSP(bf16, WS_XR); const float* gain = inp(P, bi + 2);
            const float* modl = WSP(float, WS_MOD) + (size_t)li * 2 * 12288; bf16* HN = WSP(bf16, WS_HN);
            for (int r = gw; r < M; r += NGW) { const int b = r >> 13;
                modulate_row(x32 ? x32 + (size_t)r * D : (const float*)nullptr, XR + (size_t)r * D, gain, modl + (size_t)b * 12288, modl + (size_t)b * 12288 + 2048, HN + (size_t)r * D, nullptr, lane); } }
        GRID_BAR();
        if (kind == 0) {
            const int slot = li == 0 ? 0 : 1;
            {   bf16* wbase = WSP(bf16, WS_W) + (size_t)slot * WE_NSA_SZ;
                pg8::Gemm g{WSP(bf16, WS_HN), wbase + WE_NSA_WIN, M, NSA_N1, D}; pg8::StaticOrder S; S.init(M, NSA_N1, fresh_s(G), fresh_s((int)blockIdx.x));
                EpiNsaIn E{WSP(bf16, NS_Q), WSP(bf16, NS_QR), WSP(bf16, NS_PK), WSP(bf16, NS_PV), WSP(bf16, NS_KS), WSP(bf16, NS_KW), WSP(float, NS_GT), WSP(float, WS_COS), WSP(float, WS_SIN)};
                pg8::gemm_phase<EpiNsaIn, pg8::StaticOrder, true, true>(lds, g, S, E, wave_s); }
            {
                bf16* wbase = WSP(bf16, WS_W) + (size_t)slot * WE_NSA_SZ;
                pg8::Gemm g{wbase + WE_NSA_WIN + (size_t)4352 * D, WSP(bf16, WS_HN), 1024, M, D}; pg8::StaticOrder S; S.init(1024, M, fresh_s(G), fresh_s((int)blockIdx.x));
                EpiBf16<0> E{WSP(bf16, NS_VT), LDV, 0};
                pg8::gemm_phase<EpiBf16<0>, pg8::StaticOrder, true, true>(lds, g, S, E, wave_s); }
            GRID_BAR();
#pragma unroll 1
            for (int kv = 0; kv < 2; ++kv) {
                bf16* wbase = WSP(bf16, WS_W) + (size_t)slot * WE_NSA_SZ;
                pg8::Gemm g{kv ? WSP(bf16, NS_PV) : WSP(bf16, NS_PK), wbase + WE_NSA_W1 + (size_t)kv * 1024 * 2048, 4096, 1024, 2048}; pg8::StaticOrder S; S.init(4096, 1024, fresh_s(G), fresh_s((int)((blockIdx.x + 128 * kv) % G)));
                EpiF32 E{WSP(float, NS_HC) + (size_t)kv * 4096 * 1024, 1024};
                pg8::gemm_phase<EpiF32, pg8::StaticOrder, true, true>(lds, g, S, E, wave_s); }
            {
                bf16* wbase = WSP(bf16, WS_W) + (size_t)slot * WE_NSA_SZ;
                pg8::Gemm g{WSP(bf16, WS_HN), wbase + WE_NSA_WIN + (size_t)4096 * D, M, 256, D}; pg8::StaticOrder S; S.init(M, 256, fresh_s(G), fresh_s((int)((blockIdx.x + 192) % G)));
                EpiGates E{WSP(float, NS_GT)};
                pg8::gemm_phase<EpiGates, pg8::StaticOrder, true, true>(lds, g, S, E, wave_s); }
            GRID_BAR();
            {
                FRESH_IDS();
                const float* w2 = inp(P, bi + 6); const float* bpe = WSP(float, WS_BPE) + slot * 1024; const float* HCb = WSP(float, NS_HC); bf16* KCb = WSP(bf16, NS_KC); bf16* VCt = WSP(bf16, NS_VCT);
                for (int task = gw; task < 2 * 8 * 128; task += NGW) {
                    const int n0 = (task & 127) * 4, bg = (task >> 7) & 7, kv = task >> 10;
                    const float* hrow = HCb + ((size_t)kv * 4096 + bg * 512 + n0) * 1024;
#pragma unroll
                    for (int q = 0; q < 2; ++q) { const int c = lane * 8 + q * 4; const f32x4 pb = *(const f32x4*)(bpe + kv * 512 + c);
                        f32x4 hv[4];
#pragma unroll
                        for (int r = 0; r < 4; ++r) { const f32x4 a = *(const f32x4*)(hrow + (size_t)r * 1024 + c), bb = n0 + r < 511 ? *(const f32x4*)(hrow + (size_t)(r + 1) * 1024 + 512 + c) : (f32x4){0.f, 0.f, 0.f, 0.f};
#pragma unroll
                            for (int e = 0; e < 4; ++e) hv[r][e] = n0 + r < 511 ? gelu_tanh(a[e] + bb[e] + pb[e]) : 0.f; }
#pragma unroll
                        for (int e = 0; e < 4; ++e) *(LAS f32x4*)(wl + (c + e) * 4) = (f32x4){hv[0][e], hv[1][e], hv[2][e], hv[3][e]}; }
                    LDS_WAIT();
                    const float* wp = w2 + (size_t)kv * 512 * 128 + 2 * lane; f32x4 o0 = {0.f, 0.f, 0.f, 0.f}, o1 = {0.f, 0.f, 0.f, 0.f};
#pragma unroll 16
                    for (int c = 0; c < 512; ++c) { const f32x2 wv = *(const f32x2*)(wp + (size_t)c * 128); const f32x4 hv = *(const LAS f32x4*)(wl + c * 4); o0 += hv * wv[0]; o1 += hv * wv[1]; }
                    const int d0 = 2 * lane, d1 = 2 * lane + 1;
                    if (kv == 0) {
#pragma unroll
                        for (int r = 0; r < 4; ++r) { bf16* dst = KCb + ((size_t)bg * 512 + n0 + r) * 128; dst[(d0 & 63) * 2 + (d0 >> 6)] = (bf16)(pk2(o0[r], 0.f) & 0xffffu); dst[(d1 & 63) * 2 + (d1 >> 6)] = (bf16)(pk2(o1[r], 0.f) & 0xffffu); } }
                    else { bf16* dst = VCt + (size_t)bg * 128 * 512 + n0;
                        u32x2 w0; w0.x = pk2(o0[0], o0[1]); w0.y = pk2(o0[2], o0[3]); *(u32x2*)(dst + (size_t)d0 * 512) = w0;
                        u32x2 w1; w1.x = pk2(o1[0], o1[1]); w1.y = pk2(o1[2], o1[3]); *(u32x2*)(dst + (size_t)d1 * 512) = w1; }
                    LDS_WAIT();
                }
            }
            GRID_BAR();
#ifndef REP_NSA
#define REP_NSA 1
#endif
#pragma unroll 1
            for (int rep = 0; rep < fresh_s(REP_NSA); ++rep)
            {   FRESH_IDS();
#pragma unroll 1
                for (int pi = bx_; pi < 512; pi += Gf_) {
                    const int bg = Gf_ == 256 ? (pi & 7) : (pi >> 6), cc = Gf_ == 256 ? ((pi >> 8) ? 63 - ((pi & 255) >> 3) : ((pi & 255) >> 3)) : (pi & 63);
#pragma unroll 1
                    for (int e = 0; e < 2; ++e) {
                        if (li == 0 && (Gf_ == 256 ? (pi >> 8) * 2 + e == ((bx_ >> 3) & 3) : (pi == bx_ && e == 0))) { __syncthreads(); { FRESH_IDS(); CONVERT_JOBS(NJOBS_FIRST, NJOBS); } }
                        nsa_item(lds, wave, lane, bg >> 2, bg & 3, e ? cc : 127 - cc, WSP(bf16, NS_Q), WSP(bf16, NS_QR), WSP(bf16, NS_KC), WSP(bf16, NS_VCT), WSP(bf16, NS_KS), WSP(bf16, NS_KW),
                                 WSP(bf16, NS_VT), WSP(float, NS_GT), P.out, WSP(bf16, WS_ATT));
                    }
                }
                __syncthreads();
                if (li == 0 && bx_ >= 512) { FRESH_IDS(); CONVERT_JOBS(NJOBS_FIRST, NJOBS); }
            }
            GRID_BAR();
        } else if (kind == 1) {
#pragma unroll 1
            for (int st = 0; st < 4; ++st) {
                if (st >= 1) {
                    const int p = st - 1;
                    FRESH_IDS();
                    const int dsh = 2 * p, nqb = (SEQ >> dsh) >> 8;
#pragma unroll 1
                    for (int it = bx_; it < 1024; it += Gf_) {
                        const int qb = it % nqb, h = (it / nqb) & 15, sq = it / (nqb * 16);
                        dil_item(lds, wave, lane, p, sq, h, qb, WSP(bf16, DL_QK) + (size_t)p * M * 4096, (const bf16*)(WSP(unsigned char, DL_VT) + (size_t)p * DL_VT_STRIDE), (bf16*)P.out, WSP(float, DL_ML), WSP(bf16, WS_ATT));
                    }
                    __syncthreads();
                }
                if (st < 3) {
                    const int p = st;
                    {   pg8::Gemm g{WSP(bf16, WS_HN), WSP(bf16, WS_W) + WE_DIL + (size_t)p * 6144 * D, M, 4096, D, 2 * p, 0}; pg8::StaticOrder S; S.init(M, 4096, fresh_s(G), fresh_s((int)blockIdx.x));
                        EpiDilQK E{WSP(bf16, DL_QK) + (size_t)p * M * 4096, WSP(float, WS_COS), WSP(float, WS_SIN), 2 * p};
                        pg8::gemm_phase<EpiDilQK, pg8::StaticOrder, true, true>(lds, g, S, E, wave_s); }
                    {   pg8::Gemm g{WSP(bf16, WS_W) + WE_DIL + ((size_t)p * 6144 + 4096) * D, WSP(bf16, WS_HN), 2048, M, D, 0, 2 * p}; pg8::StaticOrder S; S.init(2048, M, fresh_s(G), fresh_s((int)blockIdx.x));
                        EpiBf16<0> E{(bf16*)(WSP(unsigned char, DL_VT) + (size_t)p * DL_VT_STRIDE), LDV, 0};
                        pg8::gemm_phase<EpiBf16<0>, pg8::StaticOrder, true, true>(lds, g, S, E, wave_s); }
                }
                GRID_BAR();
            }
        } else {
            {   pg8::Gemm g{WSP(bf16, WS_HN), WSP(bf16, WS_W) + WE_RG, M, RG_N, D}; pg8::StaticOrder S; S.init(M, RG_N, fresh_s(G), fresh_s((int)blockIdx.x));
                EpiBf16<2> E{WSP(bf16, RG_YX), RG_N, 11};
                pg8::gemm_phase<EpiBf16<2>, pg8::StaticOrder, true, true>(lds, g, S, E, wave_s); }
            GRID_BAR();
            {
                FRESH_IDS();
                const float* cw = inp(P, bi + 4); const float* cb = inp(P, bi + 5); const bf16* YX = WSP(bf16, RG_YX); bf16* Xc = WSP(bf16, RG_X);
                for (long i = gtid; i < (long)(M / 4) * (DRNN / 8); i += NGT) {
                    const int r4 = (int)(i / (DRNN / 8)) * 4, c8 = (int)(i % (DRNN / 8)) * 8, t0 = r4 & (SEQ - 1);
                    u32x4 xr[7];
#pragma unroll
                    for (int j = 0; j < 7; ++j) xr[j] = (t0 - 3 + j >= 0) ? *(const u32x4*)(YX + (size_t)(r4 - 3 + j) * RG_N + RG_XOFF + c8) : (u32x4){0u, 0u, 0u, 0u};
                    f32x4 w0[4], w1[4];
#pragma unroll
                    for (int j = 0; j < 4; ++j) { w0[j] = *(const f32x4*)(cw + j * DRNN + c8); w1[j] = *(const f32x4*)(cw + j * DRNN + c8 + 4); }
                    const f32x4 b0 = *(const f32x4*)(cb + c8), b1 = *(const f32x4*)(cb + c8 + 4);
#pragma unroll
                    for (int rr = 0; rr < 4; ++rr) {
                        f32x4 a0 = b0, a1 = b1;
#pragma unroll
                        for (int j = 0; j < 4; ++j) { const u32x4 xw = xr[rr + j];
                            a0 += w0[j] * (f32x4){lo_bf(xw.x), hi_bf(xw.x), lo_bf(xw.y), hi_bf(xw.y)}; a1 += w1[j] * (f32x4){lo_bf(xw.z), hi_bf(xw.z), lo_bf(xw.w), hi_bf(xw.w)}; }
                        u32x4 o; o.x = pk2(a0[0], a0[1]); o.y = pk2(a0[2], a0[3]); o.z = pk2(a1[0], a1[1]); o.w = pk2(a1[2], a1[3]);
                        *(u32x4*)(Xc + (size_t)(r4 + rr) * DRNN + c8) = o;
                    }
                }
            }
            GRID_BAR();
            {   pg8::Gemm g{WSP(bf16, RG_X), WSP(bf16, WS_W) + WE_RG_WG, M, 5376, DRNN}; pg8::GateOrder S; S.init(M, 5376, fresh_s(G), fresh_s((int)blockIdx.x));
                EpiRgGate E{WSP(bf16, RG_X), inp(P, bi + 7), WSP(float, WS_LSP), WSP(unsigned, RG_A)};
                pg8::gemm_phase<EpiRgGate, pg8::GateOrder, true, true>(lds, g, S, E, wave_s); }
            GRID_BAR();
            {
                FRESH_IDS();
                const unsigned* AB = WSP(unsigned, RG_A); float* CA = WSP(float, RG_CA); float* CB = WSP(float, RG_CB);
                for (int task = gw; task < 2 * 128 * 21; task += NGW) {
                    const int cg = task % 21, k = (task / 21) & 127, b = task / (21 * 128), ch = cg * 128 + 2 * lane;
                    const size_t o = (size_t)(b * SEQ + k * 64) * DRNN + ch; f32x2 pa = {1.f, 1.f}, hb = {0.f, 0.f};
#pragma unroll 16
                    for (int s = 0; s < 64; ++s) { const u32x2 w = *(const u32x2*)(AB + o + (size_t)s * DRNN);
                        const f32x2 a = {__builtin_amdgcn_exp2f(lo_bf(w.x)), __builtin_amdgcn_exp2f(lo_bf(w.y))}, bv = {hi_bf(w.x), hi_bf(w.y)}; hb = a * hb + bv; pa = pa * a; }
                    *(f32x2*)(CA + (size_t)(b * 128 + k) * DRNN + ch) = pa; *(f32x2*)(CB + (size_t)(b * 128 + k) * DRNN + ch) = hb;
                } }
            GRID_BAR();
            {   FRESH_IDS();
                const unsigned* AB = WSP(unsigned, RG_A); const float* CA = WSP(float, RG_CA); const float* CB = WSP(float, RG_CB);
                const bf16* YX = WSP(bf16, RG_YX); bf16* ATT = WSP(bf16, WS_ATT);
                for (int task = gw; task < 2 * 128 * 21; task += NGW) {
                    const int cg = task % 21, k = (task / 21) & 127, b = task / (21 * 128), ch = cg * 128 + 2 * lane;
                    f32x2 h = {0.f, 0.f};
                    { const size_t co = (size_t)(b * 128) * DRNN + ch;
#pragma unroll 8
                      for (int kk = 0; kk < k; ++kk) { const f32x2 ca = *(const f32x2*)(CA + co + (size_t)kk * DRNN), cb = *(const f32x2*)(CB + co + (size_t)kk * DRNN); h = ca * h + cb; } }
                    const size_t o = (size_t)(b * SEQ + k * 64) * DRNN + ch; const size_t yo = (size_t)(b * SEQ + k * 64) * RG_N + ch;
#pragma unroll 16
                    for (int s = 0; s < 64; ++s) { const u32x2 w = *(const u32x2*)(AB + o + (size_t)s * DRNN);
                        const f32x2 a = {__builtin_amdgcn_exp2f(lo_bf(w.x)), __builtin_amdgcn_exp2f(lo_bf(w.y))}, bv = {hi_bf(w.x), hi_bf(w.y)};
                        const unsigned yw = *(const unsigned*)(YX + yo + (size_t)s * RG_N);
                        h = a * h + bv;
                        *(unsigned*)(ATT + o + (size_t)s * DRNN) = pk2(h[0] * lo_bf(yw), h[1] * hi_bf(yw)); }
                } }
            GRID_BAR();
        }
        {   const int Kd = kind == 2 ? DRNN : D;
            const bf16* wt = kind == 0 ? WSP(bf16, WS_W) + (size_t)(li == 0 ? 0 : 1) * WE_NSA_SZ + WE_NSA_WOUT : kind == 1 ? WSP(bf16, WS_W) + WE_DIL_WOUT : WSP(bf16, WS_W) + WE_RG_WOUT;
            const float* x32 = li == 0 ? inp(P, IN_X) : (const float*)nullptr;
            pg8::Gemm g{WSP(bf16, WS_ATT), wt, M, D, Kd}; pg8::StaticOrder S; S.init(M, D, fresh_s(G), fresh_s((int)blockIdx.x));
            EpiRes E{x32, WSP(bf16, WS_XR), WSP(bf16, WS_XR), WSP(float, WS_MOD) + (size_t)li * 2 * 12288 + 2 * 2048};
            pg8::gemm_phase<EpiRes, pg8::StaticOrder, true, true>(lds, g, S, E, wave_s); }
        GRID_BAR();
        {   FRESH_IDS();
            const float* gain = inp(P, bi + ff_off(li)); const float* modl = WSP(float, WS_MOD) + (size_t)li * 2 * 12288; bf16* HN = WSP(bf16, WS_HN); const bf16* XR = WSP(bf16, WS_XR);
            for (int r = gw; r < M; r += NGW) { const int b = r >> 13;
                modulate_row(nullptr, XR + (size_t)r * D, gain, modl + (size_t)b * 12288 + 3 * 2048, modl + (size_t)b * 12288 + 4 * 2048, HN + (size_t)r * D, nullptr, lane); } }
        GRID_BAR();
#pragma unroll 1
        for (int hfm = 0; hfm < 2; ++hfm) {
            {   pg8::Gemm g{WSP(bf16, WS_HN) + (size_t)hfm * 8192 * D, WSP(bf16, WS_W) + WE_FF + (size_t)li * 33554432, M / 2, DFF, D}; pg8::StaticOrder S; S.init(M / 2, DFF, fresh_s(G), fresh_s((int)blockIdx.x));
                EpiBf16<1> E{WSP(bf16, WS_BIG), DFF, 0};
                pg8::gemm_phase<EpiBf16<1>, pg8::StaticOrder, true, true>(lds, g, S, E, wave_s); }
            GRID_BAR();
            {   pg8::Gemm g{WSP(bf16, WS_BIG), WSP(bf16, WS_W) + WE_FF + (size_t)li * 33554432 + 16777216, M / 2, D, DFF}; pg8::StaticOrder S; S.init(M / 2, D, fresh_s(G), fresh_s((int)blockIdx.x));
                EpiRes E{nullptr, WSP(bf16, WS_XR) + (size_t)hfm * 8192 * D, WSP(bf16, WS_XR) + (size_t)hfm * 8192 * D, WSP(float, WS_MOD) + (size_t)li * 2 * 12288 + 5 * 2048 + (size_t)hfm * 12288};
                pg8::gemm_phase<EpiRes, pg8::StaticOrder, true, true>(lds, g, S, E, wave_s); }
            GRID_BAR();
        }
    }
    {   FRESH_IDS();
        const float* gain = inp(P, IN_NORMF); const bf16* XR = WSP(bf16, WS_XR); float* OUT = P.out;
        for (int r = gw; r < M; r += NGW) modulate_row(nullptr, XR + (size_t)r * D, gain, nullptr, nullptr, nullptr, OUT + (size_t)r * D, lane); }
}

extern "C" void kernel_launch(void* const* d_in, const int* in_sizes, int n_in, void* d_out, int out_size, void* d_ws, size_t ws_size, hipStream_t stream) {
    static int grid = 0;
    if (grid == 0) {
        if (n_in != 46 || out_size != M * D || ws_size < WS_END) { fprintf(stderr, "kernel_launch: unexpected shapes (n_in %d out %d ws %zu need %zu)\n", n_in, out_size, ws_size, (size_t)WS_END); grid = -1; return; }
        int dev = 0, cus = 0, per_cu = 0;
        if (hipGetDevice(&dev) != hipSuccess || hipDeviceGetAttribute(&cus, hipDeviceAttributeMultiprocessorCount, dev) != hipSuccess) { grid = -1; return; }
        if (hipFuncSetAttribute((const void*)mega_fwd, hipFuncAttributeMaxDynamicSharedMemorySize, LDS_BYTES) != hipSuccess) { fprintf(stderr, "kernel_launch: hipFuncSetAttribute failed\n"); grid = -1; return; }
        if (hipOccupancyMaxActiveBlocksPerMultiprocessor(&per_cu, (const void*)mega_fwd, NTHREADS, LDS_BYTES) != hipSuccess || per_cu < 1) { fprintf(stderr, "kernel_launch: occupancy query says %d\n", per_cu); }
        (void)hipGetLastError();
        grid = cus;
    }
    if (grid < 0) return;
    if (hipMemsetAsync((char*)d_ws + WS_CTL, 0, CTL_ZERO_BYTES, stream) != hipSuccess) return;
    Params p{};
    for (int i = 0; i < 46; ++i) p.in[i] = (const float*)d_in[i];
    p.out = (float*)d_out; p.ws = (unsigned char*)d_ws;
    hipLaunchKernelGGL(mega_fwd, dim3(grid), dim3(NTHREADS), LDS_BYTES, stream, p);
}
```
